# Optimizing an MI355X kernel written in HIP

```python
import math
import jax, jax.numpy as jnp
from jax import lax
import numpy as np

D_MODEL = 1024
BATCH = 8
SEQ = 4096
DEPTH = 2

MEM_LEN = 256
N_BRANCH = 5
BRANCH_W = D_MODEL // 2
CONV_K = 4
EPS = 1e-6
GDN_HEADS = 4
GDN_DK = BRANCH_W // GDN_HEADS
GDN_DV = BRANCH_W // GDN_HEADS
GDN_CHUNK = 64
GDN_QKV = 2 * GDN_HEADS * GDN_DK + GDN_HEADS * GDN_DV
SG_CHUNK = 128
SG_GROUPS = 4
SG_GW = BRANCH_W // SG_GROUPS
DSA_HEADS = 8
DSA_HD = BRANCH_W // DSA_HEADS
IDX_HEADS = 8
IDX_HD = 64
DSA_TOPK_MAX = 256
Q_BLOCK = 128
SSD_HEADS = 8
SSD_HD = BRANCH_W // SSD_HEADS
SSD_GROUPS = 2
SSD_STATE = 128
SSD_CHUNK = 128
SSD_XBC = SSD_HEADS * SSD_HD + 2 * SSD_GROUPS * SSD_STATE
MEM_HEADS = 4
MEM_HD = BRANCH_W // MEM_HEADS

IN_SPLITS = (
    GDN_QKV, GDN_HEADS, GDN_HEADS, BRANCH_W,
    BRANCH_W, BRANCH_W, BRANCH_W,
    DSA_HEADS * DSA_HD, DSA_HD, DSA_HD, IDX_HEADS * IDX_HD, IDX_HD, IDX_HEADS, BRANCH_W,
    BRANCH_W, SSD_XBC, SSD_HEADS,
    MEM_HEADS * MEM_HD, BRANCH_W,
)
IN_COLS = sum(IN_SPLITS)

kernel_name = 'hybrid_gated_parallel_mixer'


def rms_norm(x, g):
    xf = x.astype(jnp.float32)
    y = xf * lax.rsqrt(jnp.mean(xf * xf, axis=-1, keepdims=True) + EPS)
    return (y * g.astype(jnp.float32)).astype(x.dtype)


def l2_norm(x):
    xf = x.astype(jnp.float32)
    return (xf * lax.rsqrt(jnp.sum(xf * xf, axis=-1, keepdims=True) + EPS)).astype(x.dtype)


def layer_norm(x, g, b):
    xf = x.astype(jnp.float32)
    mu = jnp.mean(xf, axis=-1, keepdims=True)
    var = jnp.mean(jnp.square(xf - mu), axis=-1, keepdims=True)
    return ((xf - mu) * lax.rsqrt(var + 1e-5) * g.astype(jnp.float32) + b.astype(jnp.float32)).astype(x.dtype)


def causal_depthwise_conv(x, w, b=None):
    K = w.shape[0]
    L = x.shape[1]
    xp = jnp.pad(x, ((0, 0), (K - 1, 0), (0, 0)))
    y = xp[:, 0:L] * w[0]
    for j in range(1, K):
        y = y + xp[:, j:j + L] * w[j]
    return y if b is None else y + b


def alibi_slopes(n):
    return 2.0 ** (-8.0 * jnp.arange(1, n + 1, dtype=jnp.float32) / n)


def gated_delta_rule(q, k, v, log_decay, beta):
    f32 = jnp.float32
    Bsz, L, H, DK = q.shape
    DV = v.shape[-1]
    C = GDN_CHUNK
    N = L // C

    def chunks(t):
        return jnp.swapaxes(t.astype(f32).reshape(Bsz, N, C, H, *t.shape[3:]), 2, 3)

    q, k, v, gl, beta = map(chunks, (q, k, v, log_decay, beta))
    gc = jnp.cumsum(gl, axis=-1)
    incl = jnp.tril(jnp.ones((C, C), bool))
    strict = jnp.tril(jnp.ones((C, C), bool), -1)
    diff = gc[..., :, None] - gc[..., None, :]
    decay = jnp.where(incl, jnp.exp(jnp.where(incl, diff, 0.0)), 0.0)
    kk = jnp.einsum('bnhcd,bnhsd->bnhcs', k, k)
    a_mat = jnp.eye(C, dtype=f32) + jnp.where(strict, beta[..., :, None] * kk * decay, 0.0)
    rhs = jnp.concatenate([(beta * jnp.exp(gc))[..., None] * k, beta[..., None] * v], axis=-1)
    sol = lax.linalg.triangular_solve(a_mat, rhs, left_side=True, lower=True, unit_diagonal=True)
    w_k, u0 = sol[..., :DK], sol[..., DK:]
    qk = jnp.einsum('bnhcd,bnhsd->bnhcs', q, k) * decay
    q_dec = q * jnp.exp(gc)[..., None]
    k_dec = k * jnp.exp(gc[..., -1:] - gc)[..., None]
    chunk_decay = jnp.exp(gc[..., -1])

    def step(S, inp):
        qd, kd, qkc, wk, u0c, cd = inp
        u = u0c - jnp.einsum('bhcd,bhvd->bhcv', wk, S)
        o = jnp.einsum('bhcd,bhvd->bhcv', qd, S) + jnp.einsum('bhcs,bhsv->bhcv', qkc, u)
        S = cd[..., None, None] * S + jnp.einsum('bhsv,bhsd->bhvd', u, kd)
        return S, o

    xs = tuple(jnp.moveaxis(t, 1, 0) for t in (q_dec, k_dec, qk, w_k, u0, chunk_decay))
    _, o = lax.scan(step, jnp.zeros((Bsz, H, DV, DK), f32), xs)
    return jnp.transpose(o, (1, 0, 3, 2, 4)).reshape(Bsz, L, H, DV)


def gdn_branch(qkv, a_in, b_in, gate, conv_w, a_log, dt_bias, norm_g):
    Bsz, L, _ = qkv.shape
    qkv = jax.nn.silu(causal_depthwise_conv(qkv, conv_w))
    q, k, v = jnp.split(qkv, [GDN_HEADS * GDN_DK, 2 * GDN_HEADS * GDN_DK], axis=-1)
    q = l2_norm(q.reshape(Bsz, L, GDN_HEADS, GDN_DK)) * GDN_DK ** -0.5
    k = l2_norm(k.reshape(Bsz, L, GDN_HEADS, GDN_DK))
    v = v.reshape(Bsz, L, GDN_HEADS, GDN_DV)
    log_decay = -jnp.exp(a_log.astype(jnp.float32)) * jax.nn.softplus(a_in.astype(jnp.float32) + dt_bias)
    beta = jax.nn.sigmoid(b_in.astype(jnp.float32))
    o = gated_delta_rule(q, k, v, log_decay, beta).astype(qkv.dtype)
    o = rms_norm(o, norm_g).reshape(Bsz, L, BRANCH_W)
    return o * jax.nn.silu(gate)


def spatial_gating_branch(u, v, gate, ln_g, ln_b, w_s, b_s):
    Bsz, L, _ = u.shape
    N = L // SG_CHUNK
    u = jax.nn.gelu(u)
    v = layer_norm(jax.nn.gelu(v), ln_g, ln_b).reshape(Bsz, N, SG_CHUNK, SG_GROUPS, SG_GW)
    w_causal = jnp.where(jnp.tril(jnp.ones((SG_CHUNK, SG_CHUNK), bool)), w_s, 0.0)
    mixed = jnp.einsum('gts,bnsgc->bntgc', w_causal, v) + jnp.swapaxes(b_s, 0, 1)[None, None, :, :, None]
    return u * mixed.reshape(Bsz, L, BRANCH_W) * jax.nn.silu(gate)


def dsa_branch(q, k, v, iq, ik, iw, gate, q_norm_g, k_norm_g):
    f32 = jnp.float32
    Bsz, L, _ = q.shape
    top_k = min(DSA_TOPK_MAX, L // 4)
    n_blocks = L // Q_BLOCK
    q = rms_norm(q.reshape(Bsz, L, DSA_HEADS, DSA_HD), q_norm_g)
    k = rms_norm(k, k_norm_g)
    iq = iq.reshape(Bsz, L, IDX_HEADS, IDX_HD)
    iw = iw * (IDX_HEADS ** -0.5 * IDX_HD ** -0.5)
    slopes = alibi_slopes(DSA_HEADS)
    batch_ix = jnp.arange(Bsz)[:, None, None]
    pos_k = jnp.arange(L)

    def block(t0):
        qb = lax.dynamic_slice_in_dim(q, t0, Q_BLOCK, axis=1)
        iqb = lax.dynamic_slice_in_dim(iq, t0, Q_BLOCK, axis=1)
        iwb = lax.dynamic_slice_in_dim(iw, t0, Q_BLOCK, axis=1)
        pos_q = t0 + jnp.arange(Q_BLOCK)
        s_idx = jnp.einsum('bths,bth->bts', jax.nn.relu(jnp.einsum('bthd,bsd->bths', iqb, ik)), iwb).astype(f32)
        s_idx = jnp.where(pos_k[None, :] <= pos_q[:, None], s_idx, -jnp.inf)
        _, sel = lax.top_k(s_idx, top_k)
        valid = sel <= pos_q[None, :, None]
        k_sel = k[batch_ix, sel]
        v_sel = v[batch_ix, sel]
        logits = jnp.einsum('bthd,btkd->bhtk', qb, k_sel).astype(f32) * DSA_HD ** -0.5
        dist = (pos_q[:, None] - sel).astype(f32)
        logits = logits - slopes[None, :, None, None] * dist[:, None]
        logits = jnp.where(valid[:, None], logits, -jnp.inf)
        p = jax.nn.softmax(logits, axis=-1).astype(v.dtype)
        return jnp.einsum('bhtk,btkd->bthd', p, v_sel)

    out = lax.map(block, jnp.arange(n_blocks) * Q_BLOCK)
    out = jnp.swapaxes(out, 0, 1).reshape(Bsz, L, BRANCH_W)
    return out * jax.nn.silu(gate)


def ssd_branch(z, xbc, dt_in, conv_w, conv_b, a_log, dt_bias, d_skip, norm_g):
    f32 = jnp.float32
    Bsz, L, _ = z.shape
    C = SSD_CHUNK
    N = L // C
    G, R, P, DS = SSD_GROUPS, SSD_HEADS // SSD_GROUPS, SSD_HD, SSD_STATE
    xbc = jax.nn.silu(causal_depthwise_conv(xbc, conv_w, conv_b)).astype(f32)
    xs, bm, cm = jnp.split(xbc, [SSD_HEADS * P, SSD_HEADS * P + G * DS], axis=-1)
    xs = xs.reshape(Bsz, N, C, G, R, P)
    bm = bm.reshape(Bsz, N, C, G, DS)
    cm = cm.reshape(Bsz, N, C, G, DS)
    dt = jax.nn.softplus(dt_in.astype(f32) + dt_bias)
    a = -jnp.exp(a_log.astype(f32))
    log_a = jnp.transpose((dt * a).reshape(Bsz, N, C, G, R), (0, 1, 3, 4, 2))
    cs = jnp.cumsum(log_a, axis=-1)
    xdt = xs * dt.reshape(Bsz, N, C, G, R)[..., None]
    incl = jnp.tril(jnp.ones((C, C), bool))
    seg = cs[..., :, None] - cs[..., None, :]
    lmat = jnp.where(incl, jnp.exp(jnp.where(incl, seg, 0.0)), 0.0)
    cb = jnp.einsum('bncgd,bnsgd->bngcs', cm, bm)
    y_diag = jnp.einsum('bngcs,bngrcs,bnsgrp->bncgrp', cb, lmat, xdt)
    decay_states = jnp.exp(cs[..., -1:] - cs)
    states = jnp.einsum('bnsgd,bngrs,bnsgrp->bngrpd', bm, decay_states, xdt)
    chunk_decay = jnp.exp(cs[..., -1])

    def step(S, inp):
        st, cd = inp
        return cd[..., None, None] * S + st, S

    _, s_prev = lax.scan(step, jnp.zeros((Bsz, G, R, P, DS), f32),
                         (jnp.moveaxis(states, 1, 0), jnp.moveaxis(chunk_decay, 1, 0)))
    s_prev = jnp.moveaxis(s_prev, 0, 1)
    y_off = jnp.einsum('bncgd,bngrpd,bngrc->bncgrp', cm, s_prev, jnp.exp(cs))
    y = y_diag + y_off + xs * d_skip.reshape(G, R)[:, :, None]
    y = y.reshape(Bsz, L, BRANCH_W).astype(z.dtype)
    return rms_norm(y * jax.nn.silu(z), norm_g)


def memory_branch(q, gate, mem, mem_norm_g, w_mem_kv, q_norm_g, k_norm_g):
    Bsz, L, _ = q.shape
    M = mem.shape[1]
    q = rms_norm(q.reshape(Bsz, L, MEM_HEADS, MEM_HD), q_norm_g)
    k, v = jnp.split(rms_norm(mem, mem_norm_g) @ w_mem_kv, 2, axis=-1)
    k = rms_norm(k.reshape(Bsz, M, MEM_HEADS, MEM_HD), k_norm_g)
    v = v.reshape(Bsz, M, MEM_HEADS, MEM_HD)
    logits = jnp.einsum('blhd,bmhd->bhlm', q, k).astype(jnp.float32) * MEM_HD ** -0.5
    p = jax.nn.softmax(logits, axis=-1).astype(v.dtype)
    o = jnp.einsum('bhlm,bmhd->blhd', p, v).reshape(Bsz, L, BRANCH_W)
    return o * jax.nn.silu(gate)


def _normal(key, shape, scale):
    return scale * jax.random.normal(key, shape, jnp.float32)


def _gain(key, shape, scale=0.02):
    return 1.0 + scale * jax.random.normal(key, shape, jnp.float32)


def _dt_bias(key, shape):
    dt = jnp.exp(jax.random.uniform(key, shape, jnp.float32, math.log(1e-3), math.log(1e-1)))
    return dt + jnp.log(-jnp.expm1(-dt))


def _a_log(key, shape):
    return jnp.log(jax.random.uniform(key, shape, jnp.float32, 1.0, 16.0))


def setup_inputs(seed: int = 0) -> dict:
    key = jax.random.key(seed)
    ks = jax.random.split(key, 27)
    return {
        'x': _normal(ks[0], (BATCH, SEQ, D_MODEL), 1.0),
        'mem': _normal(ks[1], (BATCH, MEM_LEN, D_MODEL), 1.0),
        'norm_g': _gain(ks[2], (DEPTH, D_MODEL)),
        'w_in': _normal(ks[3], (DEPTH, D_MODEL, IN_COLS), D_MODEL ** -0.5),
        'gdn_conv_w': _normal(ks[4], (DEPTH, CONV_K, GDN_QKV), CONV_K ** -0.5),
        'gdn_a_log': _a_log(ks[5], (DEPTH, GDN_HEADS)),
        'gdn_dt_bias': _dt_bias(ks[6], (DEPTH, GDN_HEADS)),
        'gdn_norm_g': _gain(ks[7], (DEPTH, GDN_DV)),
        'sg_ln_g': _gain(ks[8], (DEPTH, BRANCH_W)),
        'sg_ln_b': _normal(ks[9], (DEPTH, BRANCH_W), 0.02),
        'sg_w': _normal(ks[10], (DEPTH, SG_GROUPS, SG_CHUNK, SG_CHUNK), SG_CHUNK ** -0.5),
        'sg_b': _gain(ks[11], (DEPTH, SG_GROUPS, SG_CHUNK)),
        'dsa_q_norm_g': _gain(ks[12], (DEPTH, DSA_HD)),
        'dsa_k_norm_g': _gain(ks[13], (DEPTH, DSA_HD)),
        'ssd_conv_w': _normal(ks[14], (DEPTH, CONV_K, SSD_XBC), CONV_K ** -0.5),
        'ssd_conv_b': _normal(ks[15], (DEPTH, SSD_XBC), 0.02),
        'ssd_a_log': _a_log(ks[16], (DEPTH, SSD_HEADS)),
        'ssd_dt_bias': _dt_bias(ks[17], (DEPTH, SSD_HEADS)),
        'ssd_d': _gain(ks[18], (DEPTH, SSD_HEADS), 0.1),
        'ssd_norm_g': _gain(ks[19], (DEPTH, BRANCH_W)),
        'mem_norm_g': _gain(ks[20], (DEPTH, D_MODEL)),
        'w_mem_kv': _normal(ks[21], (DEPTH, D_MODEL, 2 * BRANCH_W), D_MODEL ** -0.5),
        'mem_q_norm_g': _gain(ks[22], (DEPTH, MEM_HD)),
        'mem_k_norm_g': _gain(ks[23], (DEPTH, MEM_HD)),
        'w_gate': _normal(ks[24], (DEPTH, N_BRANCH, D_MODEL, D_MODEL), D_MODEL ** -0.5),
        'w_branch': _normal(ks[25], (DEPTH, N_BRANCH, BRANCH_W, D_MODEL), BRANCH_W ** -0.5),
        'w_out': _normal(ks[26], (DEPTH, D_MODEL, D_MODEL), 0.5 * D_MODEL ** -0.5),
    }


def reference(x, mem, norm_g, w_in, gdn_conv_w, gdn_a_log, gdn_dt_bias, gdn_norm_g,
              sg_ln_g, sg_ln_b, sg_w, sg_b, dsa_q_norm_g, dsa_k_norm_g,
              ssd_conv_w, ssd_conv_b, ssd_a_log, ssd_dt_bias, ssd_d, ssd_norm_g,
              mem_norm_g, w_mem_kv, mem_q_norm_g, mem_k_norm_g, w_gate, w_branch, w_out):
    split_at = np.cumsum(IN_SPLITS)[:-1].tolist()
    for i in range(DEPTH):
        h = rms_norm(x, norm_g[i])
        (a_qkv, a_a, a_b, a_gate,
         b_u, b_v, b_gate,
         c_q, c_k, c_v, c_iq, c_ik, c_iw, c_gate,
         d_z, d_xbc, d_dt,
         m_q, m_gate) = jnp.split(h @ w_in[i], split_at, axis=-1)
        ys = (
            gdn_branch(a_qkv, a_a, a_b, a_gate, gdn_conv_w[i], gdn_a_log[i], gdn_dt_bias[i], gdn_norm_g[i]),
            spatial_gating_branch(b_u, b_v, b_gate, sg_ln_g[i], sg_ln_b[i], sg_w[i], sg_b[i]),
            dsa_branch(c_q, c_k, c_v, c_iq, c_ik, c_iw, c_gate, dsa_q_norm_g[i], dsa_k_norm_g[i]),
            ssd_branch(d_z, d_xbc, d_dt, ssd_conv_w[i], ssd_conv_b[i], ssd_a_log[i], ssd_dt_bias[i],
                       ssd_d[i], ssd_norm_g[i]),
            memory_branch(m_q, m_gate, mem, mem_norm_g[i], w_mem_kv[i], mem_q_norm_g[i], mem_k_norm_g[i]),
        )
        merged = jnp.zeros_like(x)
        for p in range(N_BRANCH):
            merged = merged + jax.nn.sigmoid(h @ w_gate[i, p]) * (ys[p] @ w_branch[i, p])
        x = x + merged @ w_out[i]
    return x
```

```cpp
#include <hip/hip_runtime.h>
#include <cstdio>
#include <cstdint>

#define XB_TMO      128
#define XB_XCNT(j)  (256  + 64 * (j))
#define XB_XSUB(j)  (1280 + 64 * (j))
#define XB_XGEN(j)  (2304 + 64 * (j))
#define XB_TOP      3328
#define XB_TOPGEN   3392
#define XCD_BAR_WORDS 3456
#define XB_SPIN_CAP (1u << 18)
#define LAS __attribute__((address_space(3)))

__device__ __forceinline__ unsigned xb_ld(unsigned* p)              { return __hip_atomic_load(p, __ATOMIC_RELAXED, __HIP_MEMORY_SCOPE_AGENT); }
__device__ __forceinline__ unsigned xb_add(unsigned* p, unsigned v) { return __hip_atomic_fetch_add(p, v, __ATOMIC_RELAXED, __HIP_MEMORY_SCOPE_AGENT); }
__device__ __forceinline__ unsigned xb_xcc_id() { return (unsigned)__builtin_amdgcn_s_getreg((3 << 11) | 20) & 0xFu; }
#define XB_SPIN(cond, bar) do { unsigned _sp = 0; while (cond) { __builtin_amdgcn_s_sleep(1); \
    if ((++_sp & 255u) == 0u) { if (xb_ld(&(bar)[XB_TMO])) break; if (_sp > XB_SPIN_CAP) { atomicAdd(&(bar)[XB_TMO], 1u); break; } } } } while (0)

struct XcdBarrier {
    unsigned* bar; unsigned x;
    volatile LAS unsigned* st;
};

__device__ __forceinline__ XcdBarrier xcd_barrier_post(unsigned* bar, volatile LAS unsigned* st) {
    XcdBarrier b; b.bar = bar; b.x = xb_xcc_id(); b.st = st;
    if (threadIdx.x == 0) (void)xb_add(&bar[XB_XCNT(b.x)], 1u);
    return b;
}
__device__ __forceinline__ void xcd_barrier_complete(unsigned* bar, unsigned x, unsigned& nloc, unsigned& nx) {
    const unsigned G = gridDim.x * gridDim.y * gridDim.z;
    unsigned sum, cnt, mine, sp = 0u;
    for (;;) {
        sum = 0u; cnt = 0u; mine = 0u;
#pragma unroll
        for (unsigned j = 0; j < 16; ++j) { const unsigned c = xb_ld(&bar[XB_XCNT(j)]); sum += c; cnt += (c > 0u) ? 1u : 0u; mine = (j == x) ? c : mine; }
        if (sum == G) break;
        __builtin_amdgcn_s_sleep(1);
        if ((++sp & 255u) == 0u) { if (xb_ld(&bar[XB_TMO])) break; if (sp > XB_SPIN_CAP) { atomicAdd(&bar[XB_TMO], 1u); break; } }
    }
    nloc = mine > 0u ? mine : 1u; nx = cnt > 0u ? cnt : 1u;
}

__device__ __forceinline__ void xcd_barrier(const XcdBarrier& b) {
    asm volatile("s_waitcnt vmcnt(0)" ::: "memory");
    __syncthreads();
    if (threadIdx.x == 0) {
        unsigned* bar = b.bar;
        __builtin_amdgcn_s_waitcnt(0);
        unsigned nloc = b.st[0], nx = b.st[1];
        if (nloc == 0u) { xcd_barrier_complete(bar, b.x, nloc, nx); b.st[0] = nloc; b.st[1] = nx; }
        const unsigned old = xb_add(&bar[XB_XSUB(b.x)], 1u);
        const unsigned gen = old / nloc;
        if (old + 1u == (gen + 1u) * nloc) {
            __builtin_amdgcn_fence(__ATOMIC_RELEASE, "agent");
            asm volatile("s_waitcnt vmcnt(0)" ::: "memory");
            const unsigned og = xb_add(&bar[XB_TOP], 1u);
            const unsigned tg = og / nx;
            if (og + 1u == (tg + 1u) * nx) xb_add(&bar[XB_TOPGEN], 1u);
            else XB_SPIN(xb_ld(&bar[XB_TOPGEN]) == tg, bar);
            __builtin_amdgcn_fence(__ATOMIC_ACQUIRE, "agent");
            xb_add(&bar[XB_XGEN(b.x)], 1u);
            asm volatile("s_waitcnt vmcnt(0)" ::: "memory");
        } else {
            XB_SPIN(xb_ld(&bar[XB_XGEN(b.x)]) == gen, bar);
            __builtin_amdgcn_fence(__ATOMIC_ACQUIRE, "agent");
            asm volatile("s_waitcnt vmcnt(0)" ::: "memory");
        }
    }
    __syncthreads();
}

namespace pg8 {
#define PG8_LAS __attribute__((address_space(3)))
typedef unsigned short bf16_t;
typedef short bf16x8 __attribute__((ext_vector_type(8)));
typedef float f32x4 __attribute__((ext_vector_type(4)));
typedef unsigned u32x4 __attribute__((ext_vector_type(4)));
constexpr int BM = 256, BK = 64, HALF = 128, HTB = HALF * BK * 2  , STAGE_BYTES = 8 * HTB, NXCD = 8, WGM = 8;

__host__ __device__ __forceinline__ int lds_byte(int r, int c) { const int st = (r >> 4) * 2 + (c >> 5), rr = r & 15, cc = c & 31, ob = rr * 64 + cc * 2; return st * 1024 + (ob ^ (((ob >> 9) & 1) << 5)); }
__host__ __device__ __forceinline__ void stage_rc(int b, int& R, int& C) { const int st = b / 1024, sb = b % 1024, swz = sb ^ (((sb >> 9) & 1) << 5); R = (st >> 1) * 16 + swz / 64; C = (st & 1) * 32 + (swz % 64) / 2; }
__host__ __device__ __forceinline__ int perm32(int rho) { const int n = rho >> 4, i = rho & 15; return 8 * (i >> 2) + 4 * n + (i & 3); }

struct Unit { int pm, pn, pz; };
struct Gemm { const bf16_t* A; const bf16_t* Bt; int M, N, K, lda, ldb; size_t a_z, b_z; };

struct StaticOrder {
    int nM, nN, nwg, G, c;
    __host__ __device__ void init(int M, int N, int G_, int c_) { nM = M / BM; nN = N / BM; nwg = nM * nN; G = G_; c = c_; }
    __host__ __device__ bool next(int i, Unit& u) const {
        const long L = (long)i * G + c; if (L >= nwg) return false;
        int wgid = (int)L; { const int q = nwg / NXCD, r = nwg % NXCD, xcd = wgid % NXCD, off = wgid / NXCD; wgid = (xcd < r ? xcd * (q + 1) : r * (q + 1) + (xcd - r) * q) + off; }
        const int nig = WGM * nN, gid = wgid / nig, fm = gid * WGM, gsz = (nM - fm) < WGM ? (nM - fm) : WGM;
        u.pm = fm + ((wgid % nig) % gsz); u.pn = (wgid % nig) / gsz; u.pz = 0; return true;
    }
    __device__ __forceinline__ void a_ready(const Unit&) const {}
    __device__ __forceinline__ void done(const Unit&) const {}
};
struct CountedOrder : StaticOrder {
    const unsigned* ready; unsigned need; unsigned* tmo;
    __device__ __forceinline__ void a_ready(const Unit& u) const {
        if (threadIdx.x < 64) {
            const unsigned long long t0 = __builtin_amdgcn_s_memrealtime(); unsigned polls = 0;
            while ((unsigned)__builtin_amdgcn_readfirstlane(__hip_atomic_load(ready + 64 * u.pm, __ATOMIC_RELAXED, __HIP_MEMORY_SCOPE_AGENT)) < need) {
                if ((++polls & 255u) == 0u && __builtin_amdgcn_readfirstlane(__hip_atomic_load(tmo, __ATOMIC_RELAXED, __HIP_MEMORY_SCOPE_AGENT)) != 0u) break;
                if (__builtin_amdgcn_s_memrealtime() - t0 > 2000000ull) {
                    if (threadIdx.x == 0) { unsigned expect = 0u; __hip_atomic_compare_exchange_strong(tmo + 1, &expect, 0x600u | (unsigned)(u.pm & 0xff), __ATOMIC_RELAXED, __ATOMIC_RELAXED, __HIP_MEMORY_SCOPE_AGENT); __hip_atomic_store(tmo, 1u, __ATOMIC_RELAXED, __HIP_MEMORY_SCOPE_AGENT); }
                    break; }
                __builtin_amdgcn_s_sleep(2); }
            __builtin_amdgcn_fence(__ATOMIC_ACQUIRE, "agent");
            asm volatile("s_waitcnt vmcnt(0)" ::: "memory");
        }
#if !defined(BROKEN_HOOK_NO_BARRIER)
        asm volatile("" ::: "memory"); __builtin_amdgcn_s_barrier(); asm volatile("" ::: "memory");
#endif
    }
};

__device__ __forceinline__ unsigned cvt_pk_bf16(float lo, float hi) { unsigned r; asm volatile("v_cvt_pk_bf16_f32 %0, %1, %2" : "=v"(r) : "v"(lo), "v"(hi)); return r; }
typedef float f32x2 __attribute__((ext_vector_type(2)));
__device__ __forceinline__ f32x2 gelu_pk(f32x2 v) {
    const f32x2 av = __builtin_elementwise_abs(v), d = av * 0.2316418882f + 1.0f;
    f32x2 t; t.x = __builtin_amdgcn_rcpf(d.x); t.y = __builtin_amdgcn_rcpf(d.y);
    f32x2 q = t * 0.5307027145f + (-0.7265760135f); q = q * t + 0.7107068705f; q = q * t + (-0.142248368f); q = q * t + 0.127414796f; q = q * t;
    const f32x2 s = (v * v) * (-0.72134752044f);
    f32x2 e; e.x = __builtin_amdgcn_exp2f(s.x); e.y = __builtin_amdgcn_exp2f(s.y);
    const f32x2 m = v * (q * e), r = v - m;
    f32x2 o; o.x = v.x < 0.f ? m.x : r.x; o.y = v.y < 0.f ? m.y : r.y; return o;
}

template <class Epi, class Sched, bool STAMP = false>
__device__ __forceinline__ void gemm_phase(PG8_LAS unsigned char* lds, const Gemm g, const Sched& S, const Epi& E, unsigned long long* stamps, int wave_uniform) {
    int tid_; asm volatile("v_mbcnt_lo_u32_b32 %0, -1, 0\n\tv_mbcnt_hi_u32_b32 %0, -1, %0" : "=v"(tid_)); tid_ += wave_uniform * 64;
    const int tid = tid_, wid = __builtin_amdgcn_readfirstlane(tid >> 6), lane = tid & 63, wr = wid >> 2, wc = wid & 3, fr = lane & 15, fq = lane >> 4;
    const int K = g.K, nt = K / BK;
    int ts_lo = 0, ts_hi = 0, nts = 0; const unsigned long long rt_entry = STAMP ? (unsigned long long)wall_clock64() : 0ull;
#define PG8_STAMP() do { if (STAMP && wid == 0 && nts < 64) { const unsigned long long _c = (unsigned long long)clock64(); \
        ts_lo = (lane == nts) ? (int)(unsigned)_c : ts_lo; ts_hi = (lane == nts) ? (int)(unsigned)(_c >> 32) : ts_hi; ++nts; } } while (0)
    PG8_STAMP();
    unsigned voffA[2], voffB[2];
#pragma unroll
    for (int i = 0; i < 2; ++i) { int R, C; stage_rc(tid * 16 + i * 8192, R, C); const int Rb = Epi::PERM ? ((R & ~31) + perm32(R & 31)) : R;
        voffA[i] = (unsigned)(R * g.lda + C) * 2u; voffB[i] = (unsigned)(Rb * g.ldb + C) * 2u; }
    const size_t kstep = (size_t)(BK * 2);
    const size_t hstepA = (size_t)HALF * g.lda * 2, hstepB = (size_t)HALF * g.ldb * 2;
    const size_t tstepA = 2 * hstepA, tstepB = 2 * hstepB;
    const unsigned ldsw = (unsigned)wid * 1024u;
    const int aoff = lds_byte(wr * 64 + fr, fq * 8), boff = lds_byte(wc * 32 + fr, fq * 8);
#define PG8_SA(b, h) (((b) * 2 + (h)) * HTB)
#define PG8_SB(b, h) ((4 + (b) * 2 + (h)) * HTB)
#define PG8_STAGE(bufoff, gbase, voff) do { _Pragma("unroll") for (int _i = 0; _i < 2; ++_i) \
        __builtin_amdgcn_global_load_lds((const unsigned*)((const char*)(gbase) + (voff)[_i]), (PG8_LAS unsigned*)(lds + (bufoff) + ldsw + _i * 8192), 16, 0, 0); } while (0)
#define PG8_LDA(dst, b, h) do { _Pragma("unroll") for (int m = 0; m < 4; ++m) _Pragma("unroll") for (int k = 0; k < 2; ++k) dst[m][k] = *(const PG8_LAS bf16x8*)(lds + PG8_SA(b, h) + aoff + m * 2048 + k * 1024); } while (0)
#define PG8_LDB(dst, b, h) do { _Pragma("unroll") for (int n = 0; n < 2; ++n) _Pragma("unroll") for (int k = 0; k < 2; ++k) dst[n][k] = *(const PG8_LAS bf16x8*)(lds + PG8_SB(b, h) + boff + n * 2048 + k * 1024); } while (0)
#define PG8_MMA(ai, bj, At, Bt) do { __builtin_amdgcn_s_setprio(1); _Pragma("unroll") for (int m = 0; m < 4; ++m) _Pragma("unroll") for (int n = 0; n < 2; ++n) _Pragma("unroll") for (int k = 0; k < 2; ++k) \
        acc[ai][bj][m][n] = __builtin_amdgcn_mfma_f32_16x16x32_bf16(Bt[n][k], At[m][k], acc[ai][bj][m][n], 0, 0, 0); __builtin_amdgcn_s_setprio(0); } while (0)
#define PG8_WAIT_V(n) asm volatile("s_waitcnt vmcnt(" #n ")" ::: "memory")
#define PG8_WAIT_L(n) asm volatile("s_waitcnt lgkmcnt(" #n ")" ::: "memory")
#define PG8_BAR __builtin_amdgcn_s_barrier()
#define PG8_SCHED __builtin_amdgcn_sched_barrier(0)
    Unit cur, nxt; int ui = 0;
    if (!S.next(0, cur)) return;
    f32x4 acc[2][2][4][2];
#pragma unroll
    for (int a = 0; a < 2; ++a)
#pragma unroll
        for (int b = 0; b < 2; ++b)
#pragma unroll
            for (int m = 0; m < 4; ++m)
#pragma unroll
                for (int n = 0; n < 2; ++n) acc[a][b][m][n] = (f32x4){0.f, 0.f, 0.f, 0.f};
    bf16x8 At[4][2], B0[2][2], B1[2][2];
    const char* cA = (const char*)g.A + (size_t)cur.pm * tstepA + (size_t)cur.pz * g.a_z * 2; const char* cB = (const char*)g.Bt + (size_t)cur.pn * tstepB + (size_t)cur.pz * g.b_z * 2;
    S.a_ready(cur);
    PG8_STAGE(PG8_SB(0, 0), cB, voffB); PG8_STAGE(PG8_SA(0, 0), cA, voffA); PG8_STAGE(PG8_SB(0, 1), cB + hstepB, voffB); PG8_STAGE(PG8_SA(0, 1), cA + hstepA, voffA);
    if (wr == 1) PG8_BAR;
    PG8_WAIT_V(4); PG8_BAR;
    PG8_STAGE(PG8_SB(1, 0), cB + kstep, voffB); PG8_STAGE(PG8_SA(1, 0), cA + kstep, voffA); PG8_STAGE(PG8_SB(1, 1), cB + hstepB + kstep, voffB);
    PG8_WAIT_V(6); PG8_BAR;
    PG8_STAMP();
    for (;;) {
        const bool has_next = S.next(ui + 1, nxt);
        const char* nA = has_next ? (const char*)g.A + (size_t)nxt.pm * tstepA + (size_t)nxt.pz * g.a_z * 2 : cA; const char* nB = has_next ? (const char*)g.Bt + (size_t)nxt.pn * tstepB + (size_t)nxt.pz * g.b_z * 2 : cB;
        for (int t = 0; t < nt; t += 2) {
            const bool last = (t == nt - 2);
            const char* a1 = cA + (size_t)(t + 1) * kstep;
            const char* a2 = last ? nA : cA + (size_t)(t + 2) * kstep; const char* b2 = last ? nB : cB + (size_t)(t + 2) * kstep;
            const char* a3 = a2 + kstep; const char* b3 = b2 + kstep;
            if (last && has_next) S.a_ready(nxt);
            PG8_LDB(B0, 0, 0); PG8_SCHED; PG8_LDA(At, 0, 0); PG8_STAGE(PG8_SA(1, 1), a1 + hstepA, voffA);
            PG8_WAIT_L(8); PG8_BAR; PG8_WAIT_L(0); PG8_MMA(0, 0, At, B0); PG8_BAR; PG8_SCHED;
            PG8_LDB(B1, 0, 1); PG8_STAGE(PG8_SB(0, 0), b2, voffB);
            PG8_BAR; PG8_WAIT_L(0); PG8_MMA(0, 1, At, B1); PG8_BAR;
            PG8_LDA(At, 0, 1); PG8_STAGE(PG8_SA(0, 0), a2, voffA);
            PG8_BAR; PG8_WAIT_L(0); PG8_MMA(1, 0, At, B0); PG8_BAR; PG8_SCHED;
            PG8_STAGE(PG8_SB(0, 1), b2 + hstepB, voffB);
            PG8_WAIT_V(6); PG8_BAR; PG8_MMA(1, 1, At, B1); PG8_BAR;
            PG8_LDB(B0, 1, 0); PG8_SCHED; PG8_LDA(At, 1, 0); PG8_STAGE(PG8_SA(0, 1), a2 + hstepA, voffA);
            PG8_WAIT_L(8); PG8_BAR; PG8_WAIT_L(0); PG8_MMA(0, 0, At, B0); PG8_BAR; PG8_SCHED;
            PG8_LDB(B1, 1, 1); PG8_STAGE(PG8_SB(1, 0), b3, voffB);
            PG8_BAR; PG8_WAIT_L(0); PG8_MMA(0, 1, At, B1); PG8_BAR;
            PG8_LDA(At, 1, 1); PG8_STAGE(PG8_SA(1, 0), a3, voffA);
            PG8_BAR; PG8_WAIT_L(0); PG8_MMA(1, 0, At, B0); PG8_BAR; PG8_SCHED;
            PG8_STAGE(PG8_SB(1, 1), b3 + hstepB, voffB);
            PG8_WAIT_V(6); PG8_BAR; PG8_MMA(1, 1, At, B1); PG8_BAR;
        }
        PG8_STAMP();
        if constexpr (!Epi::AFTER_DRAIN) { E(acc, cur, wr, wc, fr, fq); S.done(cur); }
        PG8_STAMP();
        if (!has_next) break;
#pragma unroll
        for (int a = 0; a < 2; ++a)
#pragma unroll
            for (int b = 0; b < 2; ++b)
#pragma unroll
                for (int m = 0; m < 4; ++m)
#pragma unroll
                    for (int n = 0; n < 2; ++n) acc[a][b][m][n] = (f32x4){0.f, 0.f, 0.f, 0.f};
        cur = nxt; cA = nA; cB = nB; ++ui;
    }
    PG8_WAIT_V(0);
    if (wr == 0) PG8_BAR;
    PG8_BAR;
    if constexpr (Epi::AFTER_DRAIN) { E.fused(acc, cur, wr, wc, fr, fq, lds, wid, lane); S.done(cur); }
    PG8_STAMP();
    if (STAMP && wid == 0) { stamps[lane] = lane < nts ? (((unsigned long long)(unsigned)ts_hi << 32) | (unsigned)ts_lo) : 0ull;
        if (lane == 62) stamps[62] = rt_entry; if (lane == 63) stamps[63] = (unsigned long long)wall_clock64(); }
#undef PG8_STAMP
#undef PG8_SA
#undef PG8_SB
#undef PG8_STAGE
#undef PG8_LDA
#undef PG8_LDB
#undef PG8_MMA
#undef PG8_WAIT_V
#undef PG8_WAIT_L
#undef PG8_BAR
#undef PG8_SCHED
}
}


namespace hk {
typedef pg8::bf16_t bf16_t;
typedef pg8::bf16x8 bf16x8;
typedef pg8::f32x4 f32x4;
typedef pg8::u32x4 u32x4;
typedef unsigned u32x2 __attribute__((ext_vector_type(2)));
typedef float f32x2 __attribute__((ext_vector_type(2)));

constexpr int BATCH = 8, SEQ = 4096, DM = 1024, DEPTH = 2, MEMLEN = 256, BW = 512;
constexpr int T_ALL = BATCH * SEQ;
constexpr int GB = 4;
constexpr int NGRP = BATCH / GB;
constexpr int TG = GB * SEQ;
constexpr int IN_COLS = 7896;
constexpr int PW = 7936;
constexpr int C_AQ = 0, C_AK = 512, C_AV = 1024, C_AG = 1536;
constexpr int C_BU = 2048, C_BV = 2560, C_BG = 3072;
constexpr int C_CQ = 3584, C_CIQ = 4096, C_CG = 4608, C_CK = 5120, C_CV = 5184, C_CIK = 5248, C_CIW = 5312, C_AA = 5320, C_AB = 5324, C_DDT = 5328;
constexpr int C_DZ = 5376, C_DX = 5888, C_DB = 6400, C_DC = 6656;
constexpr int C_MQ = 6912, C_MG = 7424;
constexpr int YW = 5 * BW;
constexpr int GW = 5 * DM;

constexpr size_t WS_CTL  = 0;
constexpr size_t CTL_BYTES = 65536;
constexpr size_t WS_WIN  = WS_CTL + CTL_BYTES;
constexpr size_t WS_WG   = WS_WIN + (size_t)PW * DM * 2;
constexpr size_t WS_WB   = WS_WG + (size_t)GW * DM * 2;
constexpr size_t WS_WO   = WS_WB + (size_t)5 * DM * BW * 2;
constexpr size_t WS_WKV  = WS_WO + (size_t)DM * DM * 2;
constexpr size_t WS_MEMN = WS_WKV + (size_t)DM * DM * 2;
constexpr size_t WS_KV   = WS_MEMN + (size_t)BATCH * MEMLEN * DM * 2;
constexpr size_t WS_H    = WS_KV + (size_t)BATCH * MEMLEN * DM * 2;
constexpr size_t WS_P    = WS_H + (size_t)TG * DM * 2;
constexpr size_t WS_YS   = WS_P + (size_t)TG * PW * 2;
constexpr size_t WS_GDN  = WS_YS + (size_t)TG * YW * 2;
constexpr size_t GDN_CH_BYTES = 73728;
constexpr size_t WS_SSD  = WS_GDN + (size_t)GB * 64 * 4 * GDN_CH_BYTES;
constexpr size_t WS_MASK = WS_SSD + (size_t)GB * 32 * 8 * 64 * 128 * 2;
constexpr size_t WS_DKN  = WS_MASK + (size_t)GB * SEQ * (SEQ / 8);
constexpr size_t WS_DVT  = WS_DKN + (size_t)GB * SEQ * 64 * 2;
constexpr size_t WS_SSDQ = WS_DVT + (size_t)GB * SEQ * 64 * 2;
constexpr size_t WS_SMALL= WS_SSDQ + (size_t)GB * 8 * 8 * 64 * 128 * 2;
constexpr size_t SMALL_BYTES = 1 << 20;
constexpr size_t WS_END  = WS_SMALL + SMALL_BYTES;
static_assert(WS_END <= (size_t)536870912, "workspace map exceeds 512 MiB");
constexpr int SM_GDN_CD = 0;
constexpr int SM_SSD_CD = 4096;
constexpr int SM_SSD_RS = 65536;
constexpr int SM_SSD_CS = 8192;
constexpr int SM_SSD_DT = 8192 + GB * SEQ * 8;

constexpr int LDS_BYTES = 147456;
constexpr int LDS_MISC = 143360;
constexpr int LDS_WORK = 143360;

#define LAS __attribute__((address_space(3)))
typedef LAS unsigned char* ldsp_t;

struct Params {
    const float* in[27];
    float* out;
    unsigned char* ws;
    float one; int pad;
};

__device__ __forceinline__ float bf2f(unsigned v) { return __uint_as_float(v << 16); }
__device__ __forceinline__ float bflo(unsigned v) { return __uint_as_float(v << 16); }
__device__ __forceinline__ float bfhi(unsigned v) { return __uint_as_float(v & 0xffff0000u); }
typedef __bf16 bf16x2_t __attribute__((ext_vector_type(2)));
__device__ __forceinline__ unsigned pk2m(float lo, float hi) { const f32x2 v = {lo, hi}; return __builtin_bit_cast(unsigned, __builtin_convertvector(v, bf16x2_t)); }
__device__ __forceinline__ unsigned pk2(float lo, float hi) { unsigned r; asm volatile("v_cvt_pk_bf16_f32 %0, %1, %2" : "=v"(r) : "v"(lo), "v"(hi)); return r; }
__device__ __forceinline__ bf16_t f2bf(float x) { return (bf16_t)(pk2(x, 0.f) & 0xffffu); }
__device__ __forceinline__ float shx(float v, int m, int lane) { return __builtin_bit_cast(float, __builtin_amdgcn_ds_bpermute((lane ^ m) << 2, __builtin_bit_cast(int, v))); }
__device__ __forceinline__ unsigned shxu(unsigned v, int m, int lane) { return (unsigned)__builtin_amdgcn_ds_bpermute((lane ^ m) << 2, (int)v); }
__device__ __forceinline__ float wave_sum(float v, int lane) {
#pragma unroll
    for (int o = 1; o < 64; o <<= 1) v += shx(v, o, lane);
    return v;
}
__device__ __forceinline__ float fsigmoid(float x) { return 1.0f / (1.0f + __expf(-x)); }
__device__ __forceinline__ float fsilu(float x) { return x / (1.0f + __expf(-x)); }
__device__ __forceinline__ float fsoftplus(float x) { return x > 20.f ? x : log1pf(__expf(x)); }
__device__ __forceinline__ float fgelu_tanh(float x) {
    const float u = 0.7978845608028654f * (x + 0.044715f * x * x * x);
    const float e = __expf(2.0f * u);
    const float th = 1.0f - 2.0f / (e + 1.0f);
    return 0.5f * x * (1.0f + th);
}
#define LDS_WAIT() asm volatile("s_waitcnt lgkmcnt(0)" ::: "memory")
#define VM_WAIT() asm volatile("s_waitcnt vmcnt(0)" ::: "memory")

__device__ __forceinline__ f32x4 mma16(bf16x8 a, bf16x8 b, f32x4 c) { return __builtin_amdgcn_mfma_f32_16x16x32_bf16(a, b, c, 0, 0, 0); }
__device__ __forceinline__ bf16x8 pack_frag(f32x4 d0, f32x4 d1) {
    u32x4 w; w.x = pk2m(d0[0], d0[1]); w.y = pk2m(d0[2], d0[3]); w.z = pk2m(d1[0], d1[1]); w.w = pk2m(d1[2], d1[3]);
    return __builtin_bit_cast(bf16x8, w);
}
__device__ __forceinline__ bf16x8 ld_frag_perm_g(const bf16_t* row, int s, int q) {
    const u32x2 lo = *(const u32x2*)(row + 32 * s + 4 * q), hi = *(const u32x2*)(row + 32 * s + 16 + 4 * q);
    u32x4 w; w.x = lo.x; w.y = lo.y; w.z = hi.x; w.w = hi.y; return __builtin_bit_cast(bf16x8, w);
}
__device__ __forceinline__ bf16x8 ld_frag_perm_l(const LAS bf16_t* row, int s, int q) {
    const u32x2 lo = *(const LAS u32x2*)(row + 32 * s + 4 * q), hi = *(const LAS u32x2*)(row + 32 * s + 16 + 4 * q);
    u32x4 w; w.x = lo.x; w.y = lo.y; w.z = hi.x; w.w = hi.y; return __builtin_bit_cast(bf16x8, w);
}
__device__ __forceinline__ bf16x8 ld_frag_g(const bf16_t* row, int s, int q) { return *(const bf16x8*)(row + 32 * s + 8 * q); }
__device__ __forceinline__ bf16x8 ld_frag_l(const LAS bf16_t* row, int s, int q) { return *(const LAS bf16x8*)(row + 32 * s + 8 * q); }

struct Ctx {
    ldsp_t lds; int bid, wv;
    static constexpr int G = 256;
    const Params* p;
};
#define PHASE_TID() int tid_o; asm volatile("v_mbcnt_lo_u32_b32 %0, -1, 0\n\tv_mbcnt_hi_u32_b32 %0, -1, %0" : "=v"(tid_o)); tid_o += c.wv * 64;      const int tid = tid_o, lane = tid & 63, wave = __builtin_amdgcn_readfirstlane(tid >> 6); (void)lane; (void)wave

template <int ACT  > struct EpiStoreBf16 {
    static constexpr bool PERM = true, AFTER_DRAIN = false;
    bf16_t* O; int ldc; float one;
    __device__ __forceinline__ void operator()(const f32x4 (&acc)[2][2][4][2], const pg8::Unit& u, int wr, int wc, int fr, int fq) const {
        const int row0 = u.pm * 256 + wr * 64 + fr, col0 = u.pn * 256 + wc * 32 + 8 * fq;
#pragma unroll
        for (int ai = 0; ai < 2; ++ai)
#pragma unroll
            for (int m = 0; m < 4; ++m) { bf16_t* rowp = O + (size_t)(row0 + ai * 128 + m * 16) * ldc + col0;
#pragma unroll
                for (int bj = 0; bj < 2; ++bj) { f32x4 v0 = acc[ai][bj][m][0] * one, v1 = acc[ai][bj][m][1] * one;
                    if (ACT == 1) {
#pragma unroll
                        for (int j = 0; j < 4; ++j) { v0[j] = fsigmoid(v0[j]); v1[j] = fsigmoid(v1[j]); } }
                    u32x4 w; w.x = pk2(v0[0], v0[1]); w.y = pk2(v0[2], v0[3]); w.z = pk2(v1[0], v1[1]); w.w = pk2(v1[2], v1[3]);
                    *(u32x4*)(rowp + bj * 128) = w; } }
    }
};
struct EpiMerge {
    static constexpr bool PERM = true, AFTER_DRAIN = false;
    const bf16_t* Gs; bf16_t* Mg; const float* RS;
    __device__ __forceinline__ void operator()(const f32x4 (&acc)[2][2][4][2], const pg8::Unit& u, int wr, int wc, int fr, int fq) const {
        const int row0 = u.pm * 256 + wr * 64 + fr, col0 = u.pn * 256 + wc * 32 + 8 * fq, pz = u.pz;
#pragma unroll
        for (int ai = 0; ai < 2; ++ai)
#pragma unroll
            for (int m = 0; m < 4; ++m) { const size_t row = (size_t)(row0 + ai * 128 + m * 16);
#pragma unroll
                for (int bj = 0; bj < 2; ++bj) {
                    const u32x4 g = *(const u32x4*)(Gs + row * GW + pz * DM + col0 + bj * 128);
                    bf16_t* mp = Mg + row * DM + col0 + bj * 128;
                    u32x4 pv = (u32x4){0u, 0u, 0u, 0u};
                    if (pz > 0) pv = *(const u32x4*)mp;
                    const float rs = pz == 3 ? RS[row] : 1.0f;
                    const f32x4 v0 = acc[ai][bj][m][0] * rs, v1 = acc[ai][bj][m][1] * rs;
                    u32x4 w;
                    w.x = pk2(bflo(pv.x) + bflo(g.x) * v0[0], bfhi(pv.x) + bfhi(g.x) * v0[1]);
                    w.y = pk2(bflo(pv.y) + bflo(g.y) * v0[2], bfhi(pv.y) + bfhi(g.y) * v0[3]);
                    w.z = pk2(bflo(pv.z) + bflo(g.z) * v1[0], bfhi(pv.z) + bfhi(g.z) * v1[1]);
                    w.w = pk2(bflo(pv.w) + bflo(g.w) * v1[2], bfhi(pv.w) + bfhi(g.w) * v1[3]);
                    *(u32x4*)mp = w; } }
    }
};
struct EpiResid {
    static constexpr bool PERM = false, AFTER_DRAIN = false;
    const float* xin; float* out;
    __device__ __forceinline__ void operator()(const f32x4 (&acc)[2][2][4][2], const pg8::Unit& u, int wr, int wc, int fr, int fq) const {
        const int row0 = u.pm * 256 + wr * 64 + fr, col0 = u.pn * 256 + wc * 32 + 4 * fq;
#pragma unroll
        for (int ai = 0; ai < 2; ++ai)
#pragma unroll
            for (int m = 0; m < 4; ++m) { const size_t off = (size_t)(row0 + ai * 128 + m * 16) * DM + col0;
#pragma unroll
                for (int bj = 0; bj < 2; ++bj)
#pragma unroll
                    for (int n = 0; n < 2; ++n) { const f32x4 xv = *(const f32x4*)(xin + off + bj * 128 + n * 16);
                        *(f32x4*)(out + off + bj * 128 + n * 16) = xv + acc[ai][bj][m][n]; } }
    }
};
struct MergeOrder {
    int G, c, ntile;
    __device__ __forceinline__ bool next(int i, pg8::Unit& u) const { const int tile = c + (i / 5) * G; if (tile >= ntile) return false; u.pm = tile >> 2; u.pn = tile & 3; u.pz = i % 5; return true; }
    __device__ __forceinline__ void a_ready(const pg8::Unit&) const {}
    __device__ __forceinline__ void done(const pg8::Unit&) const {}
};

__device__ __forceinline__ int win_src_col(int j) {
    if (j < 1536) return j;
    if (j < 2048) return 1544 + (j - 1536);
    if (j < 3584) return j + 8;
    if (j < 4096) return 3592 + (j - 3584);
    if (j < 4608) return 4232 + (j - 4096);
    if (j < 5120) return 4816 + (j - 4608);
    if (j < 5184) return 4104 + (j - 5120);
    if (j < 5248) return 4168 + (j - 5184);
    if (j < 5312) return 4744 + (j - 5248);
    if (j < 5320) return 4808 + (j - 5312);
    if (j < 5324) return 1536 + (j - 5320);
    if (j < 5328) return 1540 + (j - 5324);
    if (j < 5336) return 6864 + (j - 5328);
    if (j < 5376) return -1;
    if (j < 5888) return 5328 + (j - 5376);
    if (j < 6912) return 5840 + (j - 5888);
    if (j < 7424) return 6872 + (j - 6912);
    return 7384 + (j - 7424);
}
template <bool REMAP, bool SCALE>
__device__ __forceinline__ void tr_item(const float* W, int ldsrc, const float* scale, bf16_t* WT, int K, int k0, int n0, LAS float* scr, int lane) {
    const int n = lane & 31;
    const int sc = REMAP ? win_src_col(n0 + n) : (n0 + n);
#pragma unroll 8
    for (int i = 0; i < 32; ++i) { const int kk = 2 * i + (lane >> 5);
        float v = 0.f;
        if (sc >= 0) v = W[(size_t)(k0 + kk) * ldsrc + sc];
        if (SCALE) v *= scale[k0 + kk];
        scr[kk * 33 + n] = v; }
    LDS_WAIT();
    const int c = lane & 7;
#pragma unroll
    for (int j = 0; j < 4; ++j) { const int nn = (lane >> 3) + 8 * j; const LAS float* s = scr + (8 * c) * 33 + nn;
        u32x4 o; o.x = pk2(s[0 * 33], s[1 * 33]); o.y = pk2(s[2 * 33], s[3 * 33]); o.z = pk2(s[4 * 33], s[5 * 33]); o.w = pk2(s[6 * 33], s[7 * 33]);
        *(u32x4*)(WT + (size_t)(n0 + nn) * K + k0 + 8 * c) = o; }
    LDS_WAIT();
}
__device__ __forceinline__ void rms_row_to_bf16(const float* xrow, bf16_t* orow, int lane) {
    const f32x4* xr = (const f32x4*)xrow + lane;
    f32x4 v[4]; float s = 0.f;
#pragma unroll
    for (int j = 0; j < 4; ++j) { v[j] = xr[64 * j]; s += (v[j].x * v[j].x + v[j].y * v[j].y) + (v[j].z * v[j].z + v[j].w * v[j].w); }
    const float rstd = rsqrtf(wave_sum(s, lane) * (1.f / DM) + 1e-6f);
    unsigned long long* o8 = (unsigned long long*)orow + lane;
#pragma unroll
    for (int j = 0; j < 4; ++j) o8[64 * j] = (unsigned long long)pk2(v[j].x * rstd, v[j].y * rstd) | ((unsigned long long)pk2(v[j].z * rstd, v[j].w * rstd) << 32);
}
__device__ __forceinline__ void phase_convert(const Ctx& c, int layer) {
    PHASE_TID();
    const Params& p = *c.p;
    LAS float* scr = (LAS float*)(c.lds + wave * 8704);
    const int gw = c.bid * 8 + wave, NGW = c.G * 8;
    bf16_t* WIN = (bf16_t*)(p.ws + WS_WIN); bf16_t* WG = (bf16_t*)(p.ws + WS_WG); bf16_t* WB = (bf16_t*)(p.ws + WS_WB); bf16_t* WO = (bf16_t*)(p.ws + WS_WO); bf16_t* WKV = (bf16_t*)(p.ws + WS_WKV);
    const float* norm_g = p.in[2] + layer * DM;
    for (int r = gw; r < 16 * (PW / 32); r += NGW) { const int kb = r / (PW / 32), nb = r % (PW / 32);
        tr_item<true, true>(p.in[3] + (size_t)layer * DM * IN_COLS, IN_COLS, norm_g, WIN, DM, kb * 64, nb * 32, scr, lane); }
    for (int r = gw; r < 5 * 512; r += NGW) { const int pz = r / 512, q = r % 512, kb = q / 32, nb = q % 32;
        tr_item<false, true>(p.in[24] + (size_t)(layer * 5 + pz) * DM * DM, DM, norm_g, WG + (size_t)pz * DM * DM, DM, kb * 64, nb * 32, scr, lane); }
    for (int r = gw; r < 4 * 256; r += NGW) { const int pi = r / 256, pz = pi < 3 ? pi : 4, q = r % 256, kb = q / 32, nb = q % 32;
        tr_item<false, false>(p.in[25] + (size_t)(layer * 5 + pz) * BW * DM, DM, nullptr, WB + (size_t)pz * DM * BW, BW, kb * 64, nb * 32, scr, lane); }
    for (int r = gw; r < 256; r += NGW) { const int kb = r / 32, nb = r % 32;
        tr_item<false, true>(p.in[25] + (size_t)(layer * 5 + 3) * BW * DM, DM, p.in[19] + layer * BW, WB + (size_t)3 * DM * BW, BW, kb * 64, nb * 32, scr, lane); }
    for (int r = gw; r < 512; r += NGW) { const int kb = r / 32, nb = r % 32;
        tr_item<false, false>(p.in[26] + (size_t)layer * DM * DM, DM, nullptr, WO, DM, kb * 64, nb * 32, scr, lane); }
    for (int r = gw; r < 512; r += NGW) { const int kb = r / 32, nb = r % 32;
        tr_item<false, true>(p.in[21] + (size_t)layer * DM * DM, DM, p.in[20] + layer * DM, WKV, DM, kb * 64, nb * 32, scr, lane); }
    if (layer == 0) {
        bf16_t* MEMN = (bf16_t*)(p.ws + WS_MEMN);
        for (int r = gw; r < BATCH * MEMLEN; r += NGW) rms_row_to_bf16(p.in[1] + (size_t)r * DM, MEMN + (size_t)r * DM, lane);
    }
}
__device__ __forceinline__ void phase_norm(const Ctx& c, const float* xin  ) {
    PHASE_TID();
    bf16_t* H = (bf16_t*)(c.p->ws + WS_H);
    const int gw = c.bid * 8 + wave, NGW = c.G * 8;
    for (int r = gw; r < TG; r += NGW) rms_row_to_bf16(xin + (size_t)r * DM, H + (size_t)r * DM, lane);
}

__device__ __forceinline__ void sg_unit(const Ctx& c, int layer, int lb, int n) {
    PHASE_TID();
    const Params& p = *c.p;
    const bf16_t* P = (const bf16_t*)(p.ws + WS_P); bf16_t* YS = (bf16_t*)(p.ws + WS_YS);
    const float* ln_g = p.in[8] + layer * BW; const float* ln_b = p.in[9] + layer * BW;
    const float* w_s = p.in[10] + (size_t)layer * 4 * 128 * 128; const float* b_s = p.in[11] + layer * 4 * 128;
    LAS float* st = (LAS float*)c.lds;
    LAS bf16_t* Wl = (LAS bf16_t*)(c.lds + 1024);
    LAS bf16_t* vT = (LAS bf16_t*)(c.lds + 1024 + 34816);
    const int r0 = lb * SEQ + n * 128, q = lane >> 4, l15 = lane & 15;
    __syncthreads();
    for (int t = wave * 16; t < wave * 16 + 16; ++t) {
        const u32x4 raw = *(const u32x4*)(P + (size_t)(r0 + t) * PW + C_BV + lane * 8);
        float x[8]; x[0] = bflo(raw.x); x[1] = bfhi(raw.x); x[2] = bflo(raw.y); x[3] = bfhi(raw.y); x[4] = bflo(raw.z); x[5] = bfhi(raw.z); x[6] = bflo(raw.w); x[7] = bfhi(raw.w);
        float s = 0.f;
#pragma unroll
        for (int j = 0; j < 8; ++j) { x[j] = fgelu_tanh(x[j]); s += x[j]; }
        const float mean = wave_sum(s, lane) * (1.f / BW); float s2 = 0.f;
#pragma unroll
        for (int j = 0; j < 8; ++j) { const float d = x[j] - mean; s2 += d * d; }
        const float var = wave_sum(s2, lane) * (1.f / BW);
        if (lane == 0) { st[t] = mean; st[128 + t] = rsqrtf(var + 1e-5f); }
    }
    for (int g = 0; g < 4; ++g) {
        __syncthreads();
        {
            const int t = tid >> 2, sb = (tid & 3) * 32; const float* src = w_s + (size_t)(g * 128 + t) * 128 + sb;
#pragma unroll
            for (int j = 0; j < 4; ++j) { const f32x4 a = *(const f32x4*)(src + 8 * j), b = *(const f32x4*)(src + 8 * j + 4); const int s0 = sb + 8 * j;
                u32x4 w; w.x = pk2(s0 + 0 <= t ? a[0] : 0.f, s0 + 1 <= t ? a[1] : 0.f); w.y = pk2(s0 + 2 <= t ? a[2] : 0.f, s0 + 3 <= t ? a[3] : 0.f);
                w.z = pk2(s0 + 4 <= t ? b[0] : 0.f, s0 + 5 <= t ? b[1] : 0.f); w.w = pk2(s0 + 6 <= t ? b[2] : 0.f, s0 + 7 <= t ? b[3] : 0.f);
                *(LAS u32x4*)(Wl + t * 136 + s0) = w; }
        }
#pragma unroll
        for (int j = 0; j < 4; ++j) { const int e = tid + 512 * j, s = e >> 4, cb = (e & 15) * 8;
            const u32x4 raw = *(const u32x4*)(P + (size_t)(r0 + s) * PW + C_BV + g * 128 + cb);
            float x[8]; x[0] = bflo(raw.x); x[1] = bfhi(raw.x); x[2] = bflo(raw.y); x[3] = bfhi(raw.y); x[4] = bflo(raw.z); x[5] = bfhi(raw.z); x[6] = bflo(raw.w); x[7] = bfhi(raw.w);
            const float mean = st[s], rstd = st[128 + s];
#pragma unroll
            for (int k = 0; k < 8; ++k) { const int ch = g * 128 + cb + k; const float y = (fgelu_tanh(x[k]) - mean) * rstd * ln_g[ch] + ln_b[ch]; vT[(cb + k) * 136 + s] = f2bf(y); } }
        __syncthreads();
        f32x4 acc[8];
#pragma unroll
        for (int ct = 0; ct < 8; ++ct) acc[ct] = (f32x4){0.f, 0.f, 0.f, 0.f};
        const int nks = (wave >> 1) + 1;
        for (int ks = 0; ks < nks; ++ks) {
            const bf16x8 bw = ld_frag_l(Wl + (wave * 16 + l15) * 136, ks, q);
#pragma unroll
            for (int ct = 0; ct < 8; ++ct) acc[ct] = mma16(ld_frag_l(vT + (ct * 16 + l15) * 136, ks, q), bw, acc[ct]);
        }
        const int t = wave * 16 + l15; const size_t row = (size_t)(r0 + t); const float bias = b_s[g * 128 + t];
#pragma unroll
        for (int ct = 0; ct < 8; ++ct) { const int ch = g * 128 + ct * 16 + 4 * q;
            const u32x2 ur = *(const u32x2*)(P + row * PW + C_BU + ch), gr = *(const u32x2*)(P + row * PW + C_BG + ch);
            const float o0 = fgelu_tanh(bflo(ur.x)) * (acc[ct][0] + bias) * fsilu(bflo(gr.x)), o1 = fgelu_tanh(bfhi(ur.x)) * (acc[ct][1] + bias) * fsilu(bfhi(gr.x));
            const float o2 = fgelu_tanh(bflo(ur.y)) * (acc[ct][2] + bias) * fsilu(bflo(gr.y)), o3 = fgelu_tanh(bfhi(ur.y)) * (acc[ct][3] + bias) * fsilu(bfhi(gr.y));
            u32x2 w; w.x = pk2(o0, o1); w.y = pk2(o2, o3);
            *(u32x2*)(YS + row * YW + 1 * BW + ch) = w; }
    }
}

__device__ __forceinline__ void mem_unit(const Ctx& c, int layer, int grp, int lb, int head, int qc) {
    PHASE_TID();
    const Params& p = *c.p;
    const bf16_t* P = (const bf16_t*)(p.ws + WS_P); bf16_t* YS = (bf16_t*)(p.ws + WS_YS); const bf16_t* KV = (const bf16_t*)(p.ws + WS_KV);
    const float* qg = p.in[22] + layer * 128; const float* kg = p.in[23] + layer * 128;
    LAS bf16_t* Kn = (LAS bf16_t*)c.lds;
    LAS bf16_t* VT = (LAS bf16_t*)(c.lds + 69632);
    const int q = lane >> 4, l15 = lane & 15, gbatch = grp * GB + lb;
    __syncthreads();
#pragma unroll
    for (int j = 0; j < 8; ++j) { const int e = tid + 512 * j, m = e >> 4, pc = e & 15; const bf16_t* src = KV + (size_t)(gbatch * MEMLEN + m) * DM + head * 128 + pc * 8;
        const u32x4 kr = *(const u32x4*)src, vr = *(const u32x4*)(src + BW);
        float x[8]; x[0] = bflo(kr.x); x[1] = bfhi(kr.x); x[2] = bflo(kr.y); x[3] = bfhi(kr.y); x[4] = bflo(kr.z); x[5] = bfhi(kr.z); x[6] = bflo(kr.w); x[7] = bfhi(kr.w);
        float ss = 0.f;
#pragma unroll
        for (int k = 0; k < 8; ++k) ss += x[k] * x[k];
        ss += shx(ss, 1, lane); ss += shx(ss, 2, lane); ss += shx(ss, 4, lane); ss += shx(ss, 8, lane);
        const float rstd = rsqrtf(ss * (1.f / 128.f) + 1e-6f);
        u32x4 w; w.x = pk2(x[0] * rstd * kg[pc * 8 + 0], x[1] * rstd * kg[pc * 8 + 1]); w.y = pk2(x[2] * rstd * kg[pc * 8 + 2], x[3] * rstd * kg[pc * 8 + 3]);
        w.z = pk2(x[4] * rstd * kg[pc * 8 + 4], x[5] * rstd * kg[pc * 8 + 5]); w.w = pk2(x[6] * rstd * kg[pc * 8 + 6], x[7] * rstd * kg[pc * 8 + 7]);
        *(LAS u32x4*)(Kn + m * 136 + pc * 8) = w;
        VT[(pc * 8 + 0) * 264 + m] = (bf16_t)(vr.x & 0xffffu); VT[(pc * 8 + 1) * 264 + m] = (bf16_t)(vr.x >> 16);
        VT[(pc * 8 + 2) * 264 + m] = (bf16_t)(vr.y & 0xffffu); VT[(pc * 8 + 3) * 264 + m] = (bf16_t)(vr.y >> 16);
        VT[(pc * 8 + 4) * 264 + m] = (bf16_t)(vr.z & 0xffffu); VT[(pc * 8 + 5) * 264 + m] = (bf16_t)(vr.z >> 16);
        VT[(pc * 8 + 6) * 264 + m] = (bf16_t)(vr.w & 0xffffu); VT[(pc * 8 + 7) * 264 + m] = (bf16_t)(vr.w >> 16); }
    __syncthreads();
    const float qscale = 0.08838834764831845f * 1.4426950408889634f;
    for (int qt = 0; qt < 4; ++qt) {
        const size_t row = (size_t)(lb * SEQ + qc * 512 + qt * 128 + wave * 16 + l15);
        bf16x8 qf[4];
        { float x[4][8]; float ss = 0.f;
#pragma unroll
          for (int ks = 0; ks < 4; ++ks) { const u32x4 r = *(const u32x4*)(P + row * PW + C_MQ + head * 128 + 32 * ks + 8 * q);
              x[ks][0] = bflo(r.x); x[ks][1] = bfhi(r.x); x[ks][2] = bflo(r.y); x[ks][3] = bfhi(r.y); x[ks][4] = bflo(r.z); x[ks][5] = bfhi(r.z); x[ks][6] = bflo(r.w); x[ks][7] = bfhi(r.w);
#pragma unroll
              for (int k = 0; k < 8; ++k) ss += x[ks][k] * x[ks][k]; }
          ss += shx(ss, 16, lane); ss += shx(ss, 32, lane);
          const float rs = rsqrtf(ss * (1.f / 128.f) + 1e-6f) * qscale;
#pragma unroll
          for (int ks = 0; ks < 4; ++ks) { const float* gp = qg + 32 * ks + 8 * q; u32x4 w;
              w.x = pk2m(x[ks][0] * rs * gp[0], x[ks][1] * rs * gp[1]); w.y = pk2m(x[ks][2] * rs * gp[2], x[ks][3] * rs * gp[3]);
              w.z = pk2m(x[ks][4] * rs * gp[4], x[ks][5] * rs * gp[5]); w.w = pk2m(x[ks][6] * rs * gp[6], x[ks][7] * rs * gp[7]);
              qf[ks] = __builtin_bit_cast(bf16x8, w); } }
        f32x4 s[16];
#pragma unroll
        for (int kt = 0; kt < 16; ++kt) { s[kt] = (f32x4){0.f, 0.f, 0.f, 0.f};
#pragma unroll
            for (int ks = 0; ks < 4; ++ks) s[kt] = mma16(ld_frag_l(Kn + (kt * 16 + l15) * 136, ks, q), qf[ks], s[kt]); }
        float mx = -3.0e38f;
#pragma unroll
        for (int kt = 0; kt < 16; ++kt) mx = fmaxf(fmaxf(fmaxf(s[kt][0], s[kt][1]), fmaxf(s[kt][2], s[kt][3])), mx);
        mx = fmaxf(mx, shx(mx, 16, lane)); mx = fmaxf(mx, shx(mx, 32, lane));
        float sum = 0.f;
#pragma unroll
        for (int kt = 0; kt < 16; ++kt) {
#pragma unroll
            for (int i = 0; i < 4; ++i) { const float e = __builtin_amdgcn_exp2f(s[kt][i] - mx); s[kt][i] = e; sum += e; } }
        sum += shx(sum, 16, lane); sum += shx(sum, 32, lane);
        const float inv = 1.0f / sum;
        f32x4 o[8];
#pragma unroll
        for (int dt = 0; dt < 8; ++dt) o[dt] = (f32x4){0.f, 0.f, 0.f, 0.f};
#pragma unroll
        for (int ks = 0; ks < 8; ++ks) { const bf16x8 pf = pack_frag(s[2 * ks], s[2 * ks + 1]);
#pragma unroll
            for (int dt = 0; dt < 8; ++dt) o[dt] = mma16(ld_frag_perm_l(VT + (dt * 16 + l15) * 264, ks, q), pf, o[dt]); }
#pragma unroll
        for (int dt = 0; dt < 8; ++dt) { const int ch = head * 128 + dt * 16 + 4 * q;
            const u32x2 gr = *(const u32x2*)(P + row * PW + C_MG + ch);
            u32x2 w; w.x = pk2(o[dt][0] * inv * fsilu(bflo(gr.x)), o[dt][1] * inv * fsilu(bfhi(gr.x))); w.y = pk2(o[dt][2] * inv * fsilu(bflo(gr.y)), o[dt][3] * inv * fsilu(bfhi(gr.y)));
            *(u32x2*)(YS + row * YW + 4 * BW + ch) = w; }
    }
}

__device__ __forceinline__ void ssd_conv8(const bf16_t* prow_col, int tb, const float* cw  , const float* cb, int ch0, float (&y)[8]) {
#pragma unroll
    for (int k = 0; k < 8; ++k) y[k] = cb[ch0 + k];
#pragma unroll
    for (int j = 0; j < 4; ++j) { const int dt = j - 3;
        if (tb + dt >= 0) { const u32x4 r = *(const u32x4*)(prow_col + (ptrdiff_t)dt * PW);
            const f32x4 w0 = *(const f32x4*)(cw + j * 1024 + ch0), w1 = *(const f32x4*)(cw + j * 1024 + ch0 + 4);
            y[0] += w0[0] * bflo(r.x); y[1] += w0[1] * bfhi(r.x); y[2] += w0[2] * bflo(r.y); y[3] += w0[3] * bfhi(r.y);
            y[4] += w1[0] * bflo(r.z); y[5] += w1[1] * bfhi(r.z); y[6] += w1[2] * bflo(r.w); y[7] += w1[3] * bfhi(r.w); } }
#pragma unroll
    for (int k = 0; k < 8; ++k) y[k] = fsilu(y[k]);
}
__device__ __forceinline__ void ssd_conv8x2(const bf16_t* prow_col, int tb0, const float* cw, const float* cb, int ch0, float (&y0)[8], float (&y1)[8]) {
#pragma unroll
    for (int k = 0; k < 8; ++k) { y0[k] = cb[ch0 + k]; y1[k] = y0[k]; }
    f32x4 w[4][2];
#pragma unroll
    for (int j = 0; j < 4; ++j) { w[j][0] = *(const f32x4*)(cw + j * 1024 + ch0); w[j][1] = *(const f32x4*)(cw + j * 1024 + ch0 + 4); }
#pragma unroll
    for (int d = -3; d <= 1; ++d) {
        if (tb0 + d >= 0) { const u32x4 r = *(const u32x4*)(prow_col + (ptrdiff_t)d * PW);
            const float x[8] = {bflo(r.x), bfhi(r.x), bflo(r.y), bfhi(r.y), bflo(r.z), bfhi(r.z), bflo(r.w), bfhi(r.w)};
            if (d + 3 <= 3) {
#pragma unroll
                for (int k = 0; k < 8; ++k) y0[k] += w[d + 3 <= 3 ? d + 3 : 0][k >> 2][k & 3] * x[k]; }
            if (d + 2 >= 0) {
#pragma unroll
                for (int k = 0; k < 8; ++k) y1[k] += w[d + 2 >= 0 ? d + 2 : 0][k >> 2][k & 3] * x[k]; } } }
#pragma unroll
    for (int k = 0; k < 8; ++k) { y0[k] = fsilu(y0[k]); y1[k] = fsilu(y1[k]); }
}
__device__ __forceinline__ void ssd_dt_tables(const Ctx& c, int layer, int lb, int n, int h0, int nh, LAS float* dtL, LAS float* csL, int tid, bool to_global) {
    const Params& p = *c.p; const bf16_t* P = (const bf16_t*)(p.ws + WS_P); float* SM = (float*)(p.ws + WS_SMALL);
    const int r0 = lb * SEQ + n * 128;
    for (int e = tid; e < 128 * nh; e += 512) { const int s = e / nh, hh = h0 + e % nh;
        const float x = bf2f(P[(size_t)(r0 + s) * PW + C_DDT + hh]) + p.in[17][layer * 8 + hh];
        const float dt = fsoftplus(x); dtL[s * nh + (hh - h0)] = dt; csL[s * nh + (hh - h0)] = dt * (-__expf(p.in[16][layer * 8 + hh])); }
    __syncthreads();
    if (tid < nh) { float run = 0.f; for (int s = 0; s < 128; ++s) { run += csL[s * nh + tid]; csL[s * nh + tid] = run; }
        if (to_global) SM[SM_SSD_CD + (lb * 8 + h0 + tid) * 32 + n] = __expf(run); }
    __syncthreads();
}
__device__ __forceinline__ void ssd1_unit(const Ctx& c, int layer, int lb, int n, int g) {
    PHASE_TID();
    const Params& p = *c.p; const bf16_t* P = (const bf16_t*)(p.ws + WS_P);
    const float* cw = p.in[14] + (size_t)layer * 4 * 1024; const float* cbias = p.in[15] + layer * 1024;
    LAS float* dtL = (LAS float*)c.lds; LAS float* csL = (LAS float*)(c.lds + 2048);
    LAS bf16_t* bmT = (LAS bf16_t*)(c.lds + 4096);
    LAS bf16_t* xdT = (LAS bf16_t*)(c.lds + 4096 + 34816);
    const int r0 = lb * SEQ + n * 128, q = lane >> 4, l15 = lane & 15;
    __syncthreads();
    ssd_dt_tables(c, layer, lb, n, g * 4, 4, dtL, csL, tid, true);
    for (int e = tid; e < 64 * 48; e += 512) { const int sp = e / 48, blk = e % 48, s0 = 2 * sp; float y0[8], y1[8];
        if (blk < 16) { const int ch0 = 512 + g * 128 + blk * 8;
            ssd_conv8x2(P + (size_t)(r0 + s0) * PW + C_DX + ch0, n * 128 + s0, cw, cbias, ch0, y0, y1);
#pragma unroll
            for (int k = 0; k < 8; ++k) *(LAS unsigned*)(bmT + (blk * 8 + k) * 136 + s0) = pk2(y0[k], y1[k]);
        } else { const int b2 = blk - 16, r = b2 >> 3, ch0 = (g * 4 + r) * 64 + (b2 & 7) * 8;
            ssd_conv8x2(P + (size_t)(r0 + s0) * PW + C_DX + ch0, n * 128 + s0, cw, cbias, ch0, y0, y1);
            const float cl = csL[127 * 4 + r];
            const float f0 = dtL[s0 * 4 + r] * __expf(cl - csL[s0 * 4 + r]), f1 = dtL[(s0 + 1) * 4 + r] * __expf(cl - csL[(s0 + 1) * 4 + r]);
#pragma unroll
            for (int k = 0; k < 8; ++k) *(LAS unsigned*)(xdT + (b2 * 8 + k) * 136 + s0) = pk2(y0[k] * f0, y1[k] * f1); }
    }
    __syncthreads();
    f32x4 acc[2][8];
#pragma unroll
    for (int a = 0; a < 2; ++a)
#pragma unroll
        for (int m = 0; m < 8; ++m) acc[a][m] = (f32x4){0.f, 0.f, 0.f, 0.f};
#pragma unroll
    for (int ks = 0; ks < 4; ++ks) {
        const bf16x8 b0 = ld_frag_l(xdT + ((2 * wave) * 16 + l15) * 136, ks, q), b1 = ld_frag_l(xdT + ((2 * wave + 1) * 16 + l15) * 136, ks, q);
#pragma unroll
        for (int m = 0; m < 8; ++m) { const bf16x8 a = ld_frag_l(bmT + (m * 16 + l15) * 136, ks, q); acc[0][m] = mma16(a, b0, acc[0][m]); acc[1][m] = mma16(a, b1, acc[1][m]); }
    }
    bf16_t* ST = (bf16_t*)(p.ws + WS_SSD) + (size_t)(lb * 32 + n) * 8 * 8192;
#pragma unroll
    for (int a = 0; a < 2; ++a) { const int rp = (2 * wave + a) * 16 + l15, hh = g * 4 + (rp >> 6), pp = rp & 63;
#pragma unroll
        for (int m = 0; m < 8; ++m) { u32x2 w; w.x = pk2m(acc[a][m][0], acc[a][m][1]); w.y = pk2m(acc[a][m][2], acc[a][m][3]);
            *(u32x2*)(ST + (size_t)hh * 8192 + pp * 128 + m * 16 + 4 * q) = w; } }
}
__device__ __forceinline__ void ssd_scan(const Ctx& c) {
    PHASE_TID();
    const Params& p = *c.p; const float* SM = (const float*)(p.ws + WS_SMALL);
    for (int e = c.bid * 512 + tid; e < GB * 8 * 4096; e += c.G * 512) {
        const int lb = e >> 15, hh = (e >> 12) & 7, pr = e & 4095;
        const unsigned* base = (const unsigned*)(p.ws + WS_SSD) + (size_t)(lb * 32) * 8 * 4096 + (size_t)hh * 4096 + pr;
        unsigned* qb = (unsigned*)(p.ws + WS_SSDQ) + (size_t)(lb * 8) * 8 * 4096 + (size_t)hh * 4096 + pr;
        unsigned v[32];
#pragma unroll
        for (int n = 0; n < 32; ++n) v[n] = base[(size_t)n * 8 * 4096];
        float r0 = 0.f, r1 = 0.f;
#pragma unroll
        for (int n = 0; n < 32; ++n) { const float cd = SM[SM_SSD_CD + (lb * 8 + hh) * 32 + n];
            if ((n & 3) == 0) qb[(size_t)(n >> 2) * 8 * 4096] = pk2(r0, r1);
            r0 = cd * r0 + bflo(v[n]); r1 = cd * r1 + bfhi(v[n]); }
    }
}
__device__ __forceinline__ void ssd3_unit(const Ctx& c, int layer, int lb, int n) {
    PHASE_TID();
    const Params& p = *c.p; const bf16_t* P = (const bf16_t*)(p.ws + WS_P); bf16_t* YS = (bf16_t*)(p.ws + WS_YS);
    const float* cw = p.in[14] + (size_t)layer * 4 * 1024; const float* cbias = p.in[15] + layer * 1024;
    const float* dskip = p.in[18] + layer * 8;
    LAS float* dtL = (LAS float*)c.lds; LAS float* csL = (LAS float*)(c.lds + 4096);
    LAS bf16_t* cmL = (LAS bf16_t*)(c.lds + 8192);
    LAS bf16_t* bmL = (LAS bf16_t*)(c.lds + 8192 + 34816);
    LAS bf16_t* xdT = (LAS bf16_t*)(c.lds + 8192 + 34816);
    const int r0 = lb * SEQ + n * 128, q = lane >> 4, l15 = lane & 15;
    const size_t row = (size_t)(r0 + wave * 16 + l15);
    const int m4 = n >> 2, rr = n & 3;
    const bf16_t* QB = (const bf16_t*)(p.ws + WS_SSDQ) + (size_t)(lb * 8 + m4) * 8 * 8192;
    const bf16_t* ST = (const bf16_t*)(p.ws + WS_SSD) + (size_t)(lb * 32 + 4 * m4) * 8 * 8192;
    const float* SMf = (const float*)(p.ws + WS_SMALL);
    __syncthreads();
    ssd_dt_tables(c, layer, lb, n, 0, 8, dtL, csL, tid, false);
    float ssq = 0.f;
    for (int g = 0; g < 2; ++g) {
        __syncthreads();
        for (int e = tid; e < 128 * 32; e += 512) { const int s = e >> 5, blk = e & 31; float y[8];
            const int ch0 = (blk < 16 ? 768 : 512) + g * 128 + (blk & 15) * 8;
            ssd_conv8(P + (size_t)(r0 + s) * PW + C_DX + ch0, n * 128 + s, cw, cbias, ch0, y);
            u32x4 w; w.x = pk2(y[0], y[1]); w.y = pk2(y[2], y[3]); w.z = pk2(y[4], y[5]); w.w = pk2(y[6], y[7]);
            *(LAS u32x4*)((blk < 16 ? cmL : bmL) + s * 136 + (blk & 15) * 8) = w; }
        __syncthreads();
        bf16x8 cmf[4];
#pragma unroll
        for (int ks = 0; ks < 4; ++ks) cmf[ks] = ld_frag_l(cmL + (wave * 16 + l15) * 136, ks, q);
        f32x4 cbT[8];
#pragma unroll
        for (int st = 0; st < 8; ++st) { cbT[st] = (f32x4){0.f, 0.f, 0.f, 0.f};
            if (st <= wave) {
#pragma unroll
                for (int ks = 0; ks < 4; ++ks) cbT[st] = mma16(ld_frag_l(bmL + (st * 16 + l15) * 136, ks, q), cmf[ks], cbT[st]); } }
        __syncthreads();
        for (int e = tid; e < 128 * 32; e += 512) { const int s = e >> 5, b2 = e & 31, r = b2 >> 3, ch0 = (g * 4 + r) * 64 + (b2 & 7) * 8; float y[8];
            ssd_conv8(P + (size_t)(r0 + s) * PW + C_DX + ch0, n * 128 + s, cw, cbias, ch0, y);
            const float f = dtL[s * 8 + g * 4 + r];
#pragma unroll
            for (int k = 0; k < 8; ++k) xdT[(b2 * 8 + k) * 136 + s] = f2bf(y[k] * f); }
        __syncthreads();
        const int cpos = wave * 16 + l15;
#pragma unroll 1
        for (int r = 0; r < 4; ++r) { const int hh = g * 4 + r; const float csc = csL[cpos * 8 + hh];
            float cq = 1.f, c0 = 0.f, c1 = 0.f;
            { const float* cdp = SMf + SM_SSD_CD + (lb * 8 + hh) * 32 + 4 * m4;
              if (rr == 1) { cq = cdp[0]; c0 = 1.f; }
              else if (rr == 2) { const float d0 = cdp[0], d1 = cdp[1]; cq = d0 * d1; c0 = d1; c1 = 1.f; }
              else if (rr == 3) { const float d0 = cdp[0], d1 = cdp[1], d2 = cdp[2]; cq = d0 * d1 * d2; c0 = d1 * d2; c1 = d2; } }
            f32x4 yd[4], yo[4];
#pragma unroll
            for (int pt = 0; pt < 4; ++pt) { yd[pt] = (f32x4){0.f, 0.f, 0.f, 0.f}; yo[pt] = (f32x4){0.f, 0.f, 0.f, 0.f}; }
#pragma unroll
            for (int ks = 0; ks < 4; ++ks) {
                if (2 * ks <= wave) {
                    f32x4 m0, m1;
#pragma unroll
                    for (int i = 0; i < 4; ++i) { const int s0 = 32 * ks + 4 * q + i, s1 = s0 + 16;
                        m0[i] = s0 <= cpos ? cbT[2 * ks][i] * __expf(fminf(csc - csL[s0 * 8 + hh], 0.f)) : 0.f;
                        m1[i] = s1 <= cpos ? cbT[2 * ks + 1][i] * __expf(fminf(csc - csL[s1 * 8 + hh], 0.f)) : 0.f; }
                    const bf16x8 mf = pack_frag(m0, m1);
#pragma unroll
                    for (int pt = 0; pt < 4; ++pt) yd[pt] = mma16(ld_frag_perm_l(xdT + (r * 64 + pt * 16 + l15) * 136, ks, q), mf, yd[pt]);
                }
#pragma unroll
                for (int pt = 0; pt < 4; ++pt) {
                    const size_t off = (size_t)hh * 8192 + (pt * 16 + l15) * 128 + 32 * ks + 8 * q;
                    const u32x4 qv = *(const u32x4*)(QB + off);
                    float f[8] = {cq * bflo(qv.x), cq * bfhi(qv.x), cq * bflo(qv.y), cq * bfhi(qv.y), cq * bflo(qv.z), cq * bfhi(qv.z), cq * bflo(qv.w), cq * bfhi(qv.w)};
                    if (rr > 0) { const u32x4 sv = *(const u32x4*)(ST + off);
                        f[0] += c0 * bflo(sv.x); f[1] += c0 * bfhi(sv.x); f[2] += c0 * bflo(sv.y); f[3] += c0 * bfhi(sv.y); f[4] += c0 * bflo(sv.z); f[5] += c0 * bfhi(sv.z); f[6] += c0 * bflo(sv.w); f[7] += c0 * bfhi(sv.w); }
                    if (rr > 1) { const u32x4 sv = *(const u32x4*)(ST + (size_t)8 * 8192 + off);
                        f[0] += c1 * bflo(sv.x); f[1] += c1 * bfhi(sv.x); f[2] += c1 * bflo(sv.y); f[3] += c1 * bfhi(sv.y); f[4] += c1 * bflo(sv.z); f[5] += c1 * bfhi(sv.z); f[6] += c1 * bflo(sv.w); f[7] += c1 * bfhi(sv.w); }
                    if (rr > 2) { const u32x4 sv = *(const u32x4*)(ST + (size_t)2 * 8 * 8192 + off);
                        f[0] += bflo(sv.x); f[1] += bfhi(sv.x); f[2] += bflo(sv.y); f[3] += bfhi(sv.y); f[4] += bflo(sv.z); f[5] += bfhi(sv.z); f[6] += bflo(sv.w); f[7] += bfhi(sv.w); }
                    u32x4 w; w.x = pk2m(f[0], f[1]); w.y = pk2m(f[2], f[3]); w.z = pk2m(f[4], f[5]); w.w = pk2m(f[6], f[7]);
                    yo[pt] = mma16(__builtin_bit_cast(bf16x8, w), cmf[ks], yo[pt]); }
            }
            const float ecs = __expf(csc), dsk = dskip[hh] / dtL[cpos * 8 + hh];
#pragma unroll
            for (int pt = 0; pt < 4; ++pt) { const int ch = hh * 64 + pt * 16 + 4 * q;
                const u32x2 zr = *(const u32x2*)(P + row * PW + C_DZ + ch);
                float yv[4];
#pragma unroll
                for (int i = 0; i < 4; ++i) yv[i] = yd[pt][i] + ecs * yo[pt][i] + dsk * bf2f(xdT[(r * 64 + pt * 16 + 4 * q + i) * 136 + cpos]);
                yv[0] *= fsilu(bflo(zr.x)); yv[1] *= fsilu(bfhi(zr.x)); yv[2] *= fsilu(bflo(zr.y)); yv[3] *= fsilu(bfhi(zr.y));
                ssq += (yv[0] * yv[0] + yv[1] * yv[1]) + (yv[2] * yv[2] + yv[3] * yv[3]);
                u32x2 w; w.x = pk2(yv[0], yv[1]); w.y = pk2(yv[2], yv[3]);
                *(u32x2*)(YS + row * YW + 3 * BW + ch) = w; }
        }
    }
    ssq += shx(ssq, 16, lane); ssq += shx(ssq, 32, lane);
    if (q == 0) ((float*)(p.ws + WS_SMALL))[SM_SSD_RS + row] = rsqrtf(ssq * (1.f / BW) + 1e-6f);
}

__device__ __forceinline__ float row16_sum(float v) {
    v += __builtin_bit_cast(float, __builtin_amdgcn_mov_dpp(__builtin_bit_cast(int, v), 0xB1, 0xF, 0xF, true));
    v += __builtin_bit_cast(float, __builtin_amdgcn_mov_dpp(__builtin_bit_cast(int, v), 0x4E, 0xF, 0xF, true));
    v += __builtin_bit_cast(float, __builtin_amdgcn_mov_dpp(__builtin_bit_cast(int, v), 0x141, 0xF, 0xF, true));
    v += __builtin_bit_cast(float, __builtin_amdgcn_mov_dpp(__builtin_bit_cast(int, v), 0x140, 0xF, 0xF, true));
    return v;
}
__device__ __forceinline__ void gdn_pre_unit(const Ctx& c, int layer, int lb, int n, int h) {
    PHASE_TID();
    const Params& p = *c.p; const bf16_t* P = (const bf16_t*)(p.ws + WS_P);
    const float* cw = p.in[4] + (size_t)layer * 4 * 1536;
    LAS bf16_t* qL = (LAS bf16_t*)c.lds; LAS bf16_t* kL = (LAS bf16_t*)(c.lds + 17408); LAS bf16_t* vL = (LAS bf16_t*)(c.lds + 34816);
    LAS float* Lm = (LAS float*)(c.lds + 52224);
    LAS float* gcL = (LAS float*)(c.lds + 69632); LAS float* btL = (LAS float*)(c.lds + 69888);
    unsigned char* scr = p.ws + WS_GDN + (size_t)((lb * 4 + h) * 64 + n) * GDN_CH_BYTES;
    bf16_t* WK = (bf16_t*)scr; bf16_t* U0T = (bf16_t*)(scr + 16384); bf16_t* QD = (bf16_t*)(scr + 32768); bf16_t* KDT = (bf16_t*)(scr + 49152); bf16_t* QK = (bf16_t*)(scr + 65536);
    const int r0 = lb * SEQ + n * 64, q = lane >> 4, l15 = lane & 15;
    __syncthreads();
    if (wave == 0) {
        const float a_in = bf2f(P[(size_t)(r0 + lane) * PW + C_AA + h]), b_in = bf2f(P[(size_t)(r0 + lane) * PW + C_AB + h]);
        float gl = -__expf(p.in[5][layer * 4 + h]) * fsoftplus(a_in + p.in[6][layer * 4 + h]);
#pragma unroll
        for (int o = 1; o < 64; o <<= 1) { const float t = __builtin_bit_cast(float, __builtin_amdgcn_ds_bpermute((lane - o) << 2, __builtin_bit_cast(int, gl))); if (lane >= o) gl += t; }
        gcL[lane] = gl; btL[lane] = fsigmoid(b_in);
    }
#pragma unroll 1
    for (int j = 0; j < 6; ++j) { const int e = tid + 512 * j, part = e >> 10, s = (e >> 4) & 63, blk = e & 15, ch0 = part * 512 + h * 128 + blk * 8, tb = n * 64 + s;
        const bf16_t* src = P + (size_t)(r0 + s) * PW + ch0;
        float y[8] = {0.f, 0.f, 0.f, 0.f, 0.f, 0.f, 0.f, 0.f};
#pragma unroll
        for (int jj = 0; jj < 4; ++jj) { const int dt = jj - 3;
            if (tb + dt >= 0) { const u32x4 r = *(const u32x4*)(src + (ptrdiff_t)dt * PW);
                const f32x4 w0 = *(const f32x4*)(cw + jj * 1536 + ch0), w1 = *(const f32x4*)(cw + jj * 1536 + ch0 + 4);
                y[0] += w0[0] * bflo(r.x); y[1] += w0[1] * bfhi(r.x); y[2] += w0[2] * bflo(r.y); y[3] += w0[3] * bfhi(r.y);
                y[4] += w1[0] * bflo(r.z); y[5] += w1[1] * bfhi(r.z); y[6] += w1[2] * bflo(r.w); y[7] += w1[3] * bfhi(r.w); } }
        float ss = 0.f;
#pragma unroll
        for (int k = 0; k < 8; ++k) { y[k] = fsilu(y[k]); ss += y[k] * y[k]; }
        ss = row16_sum(ss);
        const float sc = part == 2 ? 1.0f : rsqrtf(ss + 1e-6f) * (part == 0 ? 0.08838834764831845f : 1.0f);
        u32x4 w; w.x = pk2(y[0] * sc, y[1] * sc); w.y = pk2(y[2] * sc, y[3] * sc); w.z = pk2(y[4] * sc, y[5] * sc); w.w = pk2(y[6] * sc, y[7] * sc);
        *(LAS u32x4*)((part == 0 ? qL : part == 1 ? kL : vL) + s * 136 + blk * 8) = w; }
    __syncthreads();
    {
        const int sel = wave >> 2, ct = wave & 3, cc = ct * 16 + l15; const float gcc = gcL[cc], btc = btL[cc];
        bf16x8 bf[4];
#pragma unroll
        for (int ks = 0; ks < 4; ++ks) bf[ks] = ld_frag_l((sel ? qL : kL) + cc * 136, ks, q);
#pragma unroll
        for (int st = 0; st < 4; ++st) { f32x4 d = (f32x4){0.f, 0.f, 0.f, 0.f};
            if (st <= ct) {
#pragma unroll
                for (int ks = 0; ks < 4; ++ks) d = mma16(ld_frag_l(kL + (st * 16 + l15) * 136, ks, q), bf[ks], d); }
            f32x4 o;
#pragma unroll
            for (int i = 0; i < 4; ++i) { const int s = st * 16 + 4 * q + i; const float dec = __expf(fminf(gcc - gcL[s], 0.f));
                o[i] = sel ? (s <= cc ? d[i] * dec : 0.f) : (s < cc ? d[i] * dec * btc : 0.f); }
            if (sel) { u32x2 w; w.x = pk2(o[0], o[1]); w.y = pk2(o[2], o[3]); *(u32x2*)(QK + cc * 64 + st * 16 + 4 * q) = w; }
            else *(LAS f32x4*)(Lm + cc * 68 + st * 16 + 4 * q) = o; }
    }
    __syncthreads();
    if (tid < 256) {
        const int j = tid; const bool isk = j < 128; const LAS bf16_t* colp = (isk ? kL : vL) + (j & 127);
        LAS float* X = (LAS float*)(c.lds + 70144) + j;
#pragma unroll 1
        for (int cb = 0; cb < 16; ++cb) {
            float a[4];
#pragma unroll
            for (int r = 0; r < 4; ++r) { const int cc = 4 * cb + r; a[r] = btL[cc] * (isk ? __expf(gcL[cc]) : 1.0f) * bf2f(colp[cc * 136]); }
#pragma unroll 1
            for (int g4 = 0; g4 < cb; ++g4) { const float x0 = X[(4 * g4) * 256], x1 = X[(4 * g4 + 1) * 256], x2 = X[(4 * g4 + 2) * 256], x3 = X[(4 * g4 + 3) * 256];
#pragma unroll
                for (int r = 0; r < 4; ++r) { const f32x4 lv = *(const LAS f32x4*)(Lm + (4 * cb + r) * 68 + 4 * g4); a[r] -= (lv[0] * x0 + lv[1] * x1) + (lv[2] * x2 + lv[3] * x3); } }
            const f32x4 l1 = *(const LAS f32x4*)(Lm + (4 * cb + 1) * 68 + 4 * cb), l2 = *(const LAS f32x4*)(Lm + (4 * cb + 2) * 68 + 4 * cb), l3 = *(const LAS f32x4*)(Lm + (4 * cb + 3) * 68 + 4 * cb);
            const float y0 = a[0], y1 = a[1] - l1[0] * y0, y2 = a[2] - l2[0] * y0 - l2[1] * y1, y3 = a[3] - l3[0] * y0 - l3[1] * y1 - l3[2] * y2;
            X[(4 * cb) * 256] = y0; X[(4 * cb + 1) * 256] = y1; X[(4 * cb + 2) * 256] = y2; X[(4 * cb + 3) * 256] = y3; }
        if (isk) {
#pragma unroll 8
            for (int cc = 0; cc < 64; ++cc) WK[cc * 128 + j] = f2bf(X[cc * 256]);
        } else { bf16_t* dst = U0T + (j - 128) * 64;
#pragma unroll 1
            for (int g8 = 0; g8 < 8; ++g8) { u32x4 w; w.x = pk2(X[(8 * g8) * 256], X[(8 * g8 + 1) * 256]); w.y = pk2(X[(8 * g8 + 2) * 256], X[(8 * g8 + 3) * 256]); w.z = pk2(X[(8 * g8 + 4) * 256], X[(8 * g8 + 5) * 256]); w.w = pk2(X[(8 * g8 + 6) * 256], X[(8 * g8 + 7) * 256]);
                *(u32x4*)(dst + 8 * g8) = w; } }
    } else {
        const int t2 = tid - 256; const float g63 = gcL[63];
#pragma unroll
        for (int jj = 0; jj < 4; ++jj) { const int e = t2 + 256 * jj, s = e >> 4, blk = e & 15; const float sc = __expf(gcL[s]);
            const u32x4 r = *(const LAS u32x4*)(qL + s * 136 + blk * 8);
            u32x4 w; w.x = pk2(bflo(r.x) * sc, bfhi(r.x) * sc); w.y = pk2(bflo(r.y) * sc, bfhi(r.y) * sc); w.z = pk2(bflo(r.z) * sc, bfhi(r.z) * sc); w.w = pk2(bflo(r.w) * sc, bfhi(r.w) * sc);
            *(u32x4*)(QD + s * 128 + blk * 8) = w; }
#pragma unroll
        for (int jj = 0; jj < 4; ++jj) { const int e = t2 + 256 * jj, d = e & 127, s0 = (e >> 7) * 8; float v[8];
#pragma unroll
            for (int i = 0; i < 8; ++i) v[i] = bf2f(kL[(s0 + i) * 136 + d]) * __expf(g63 - gcL[s0 + i]);
            u32x4 w; w.x = pk2(v[0], v[1]); w.y = pk2(v[2], v[3]); w.z = pk2(v[4], v[5]); w.w = pk2(v[6], v[7]);
            *(u32x4*)(KDT + d * 64 + s0) = w; }
        if (t2 == 0) ((float*)(p.ws + WS_SMALL))[SM_GDN_CD + (lb * 4 + h) * 64 + n] = __expf(g63);
    }
}

__device__ __forceinline__ void gdn_chain(const Ctx& c, int layer, int lb, int h) {
    PHASE_TID();
    const Params& p = *c.p; const bf16_t* P = (const bf16_t*)(p.ws + WS_P); bf16_t* YS = (bf16_t*)(p.ws + WS_YS);
    const float* SM = (const float*)(p.ws + WS_SMALL); const float* ng = p.in[7] + layer * 128;
    const int q = lane >> 4, l15 = lane & 15, vs = wave, vcol = vs * 16 + l15;
    const unsigned char* scr0 = p.ws + WS_GDN + (size_t)((lb * 4 + h) * 64) * GDN_CH_BYTES;
    constexpr int BUFB = 62464;
    LAS float* ssqL = (LAS float*)(c.lds + 2 * BUFB);
    const float gv = ng[vcol];
    f32x4 st[8];
#pragma unroll
    for (int d = 0; d < 8; ++d) st[d] = (f32x4){0.f, 0.f, 0.f, 0.f};
    f32x4 oprev[4];
#pragma unroll
    for (int m = 0; m < 4; ++m) oprev[m] = (f32x4){0.f, 0.f, 0.f, 0.f};
    u32x4 sreg[7]; u32x2 u0r[4];
#define GDN_LOAD(nn) do { const unsigned char* sc_ = scr0 + (size_t)(nn) * GDN_CH_BYTES; \
        _Pragma("unroll") for (int j = 0; j < 7; ++j) { const int idx = tid + 512 * j; \
            const size_t so = j < 2 ? (size_t)idx * 16 : j < 4 ? 32768 + (size_t)(idx - 1024) * 16 : j < 6 ? 49152 + (size_t)(idx - 2048) * 16 : 65536 + (size_t)(idx - 3072) * 16; \
            sreg[j] = *(const u32x4*)(sc_ + so); } \
        _Pragma("unroll") for (int m = 0; m < 4; ++m) u0r[m] = *(const u32x2*)(sc_ + 16384 + (size_t)(vcol * 64 + m * 16 + 4 * q) * 2); } while (0)
#define GDN_STORE(buf) do { ldsp_t b_ = c.lds + (buf) * BUFB; \
        _Pragma("unroll") for (int j = 0; j < 7; ++j) { const int idx = tid + 512 * j; \
            const int lo = j < 2 ? (idx >> 4) * 272 + (idx & 15) * 16 : j < 4 ? 17408 + ((idx - 1024) >> 4) * 272 + (idx & 15) * 16 \
                         : j < 6 ? 34816 + ((idx - 2048) >> 3) * 144 + (idx & 7) * 16 : 53248 + ((idx - 3072) >> 3) * 144 + (idx & 7) * 16; \
            *(LAS u32x4*)(b_ + lo) = sreg[j]; } } while (0)
    __syncthreads();
    GDN_LOAD(0); GDN_STORE(0);
    f32x4 u0[4];
#pragma unroll
    for (int m = 0; m < 4; ++m) u0[m] = (f32x4){bflo(u0r[m].x), bfhi(u0r[m].x), bflo(u0r[m].y), bfhi(u0r[m].y)};
    __syncthreads();
#pragma unroll 1
    for (int n = 0; n <= 64; ++n) {
        if (n < 63) GDN_LOAD(n + 1);
        if (n > 0) {
            const LAS float* sq = ssqL + ((n - 1) & 1) * 512; const size_t rowb = (size_t)(lb * SEQ + (n - 1) * 64);
#pragma unroll
            for (int m = 0; m < 4; ++m) { f32x4 tot = (f32x4){0.f, 0.f, 0.f, 0.f};
#pragma unroll
                for (int w = 0; w < 8; ++w) tot += *(const LAS f32x4*)(sq + w * 64 + m * 16 + 4 * q);
#pragma unroll
                for (int i = 0; i < 4; ++i) { const size_t row = rowb + m * 16 + 4 * q + i;
                    const float gate = bf2f(P[row * PW + C_AG + h * 128 + vcol]);
                    YS[row * YW + h * 128 + vcol] = f2bf(oprev[m][i] * rsqrtf(tot[i] * (1.f / 128.f) + 1e-6f) * gv * fsilu(gate)); } }
        }
        if (n < 64) {
            ldsp_t b = c.lds + (n & 1) * BUFB;
            const LAS bf16_t* wkL = (const LAS bf16_t*)b; const LAS bf16_t* qdL = (const LAS bf16_t*)(b + 17408);
            const LAS bf16_t* kdL = (const LAS bf16_t*)(b + 34816); const LAS bf16_t* qkL = (const LAS bf16_t*)(b + 53248);
            const float cd = SM[SM_GDN_CD + (lb * 4 + h) * 64 + n];
            bf16x8 sf[4];
#pragma unroll
            for (int ks = 0; ks < 4; ++ks) sf[ks] = pack_frag(st[2 * ks], st[2 * ks + 1]);
            f32x4 x[4], o[4];
#pragma unroll
            for (int m = 0; m < 4; ++m) { x[m] = (f32x4){0.f, 0.f, 0.f, 0.f}; o[m] = (f32x4){0.f, 0.f, 0.f, 0.f};
#pragma unroll
                for (int ks = 0; ks < 4; ++ks) { x[m] = mma16(ld_frag_perm_l(wkL + (m * 16 + l15) * 136, ks, q), sf[ks], x[m]); o[m] = mma16(ld_frag_perm_l(qdL + (m * 16 + l15) * 136, ks, q), sf[ks], o[m]); } }
#pragma unroll
            for (int m = 0; m < 4; ++m) x[m] = u0[m] - x[m];
            bf16x8 uf[2];
#pragma unroll
            for (int k2 = 0; k2 < 2; ++k2) uf[k2] = pack_frag(x[2 * k2], x[2 * k2 + 1]);
#pragma unroll
            for (int m = 0; m < 4; ++m)
#pragma unroll
                for (int k2 = 0; k2 < 2; ++k2) o[m] = mma16(ld_frag_perm_l(qkL + (m * 16 + l15) * 72, k2, q), uf[k2], o[m]);
#pragma unroll
            for (int d = 0; d < 8; ++d) { st[d] = st[d] * cd;
#pragma unroll
                for (int k2 = 0; k2 < 2; ++k2) st[d] = mma16(ld_frag_perm_l(kdL + (d * 16 + l15) * 72, k2, q), uf[k2], st[d]); }
            LAS float* sq = ssqL + (n & 1) * 512 + wave * 64;
#pragma unroll
            for (int m = 0; m < 4; ++m) { f32x4 s2;
#pragma unroll
                for (int i = 0; i < 4; ++i) s2[i] = row16_sum(o[m][i] * o[m][i]);
                if (l15 == 0) *(LAS f32x4*)(sq + m * 16 + 4 * q) = s2;
                oprev[m] = o[m]; }
            if (n < 63) {
#pragma unroll
                for (int m = 0; m < 4; ++m) u0[m] = (f32x4){bflo(u0r[m].x), bfhi(u0r[m].x), bflo(u0r[m].y), bfhi(u0r[m].y)};
                GDN_STORE((n + 1) & 1); }
        }
        __syncthreads();
    }
#undef GDN_LOAD
#undef GDN_STORE
}

__device__ __forceinline__ float row8_sum(float v) {
    v += __builtin_bit_cast(float, __builtin_amdgcn_mov_dpp(__builtin_bit_cast(int, v), 0xB1, 0xF, 0xF, true));
    v += __builtin_bit_cast(float, __builtin_amdgcn_mov_dpp(__builtin_bit_cast(int, v), 0x4E, 0xF, 0xF, true));
    v += __builtin_bit_cast(float, __builtin_amdgcn_mov_dpp(__builtin_bit_cast(int, v), 0x141, 0xF, 0xF, true));
    return v;
}
__device__ __forceinline__ void dsa_prep_unit(const Ctx& c, int layer, int lb, int tt) {
    PHASE_TID();
    const Params& p = *c.p; const bf16_t* P = (const bf16_t*)(p.ws + WS_P);
    bf16_t* DKN = (bf16_t*)(p.ws + WS_DKN) + (size_t)lb * SEQ * 64; bf16_t* DVT = (bf16_t*)(p.ws + WS_DVT) + (size_t)lb * 64 * SEQ;
    const float* kg = p.in[13] + layer * 64;
    LAS bf16_t* vL = (LAS bf16_t*)c.lds;
    const int t = tid >> 3, pc = tid & 7, tok = tt * 64 + t;
    __syncthreads();
    const bf16_t* src = P + (size_t)(lb * SEQ + tok) * PW;
    const u32x4 kr = *(const u32x4*)(src + C_CK + pc * 8), vr = *(const u32x4*)(src + C_CV + pc * 8);
    float x[8] = {bflo(kr.x), bfhi(kr.x), bflo(kr.y), bfhi(kr.y), bflo(kr.z), bfhi(kr.z), bflo(kr.w), bfhi(kr.w)};
    float ss = 0.f;
#pragma unroll
    for (int k = 0; k < 8; ++k) ss += x[k] * x[k];
    ss = row8_sum(ss);
    const float rs = rsqrtf(ss * (1.f / 64.f) + 1e-6f);
    u32x4 w; w.x = pk2(x[0] * rs * kg[pc * 8 + 0], x[1] * rs * kg[pc * 8 + 1]); w.y = pk2(x[2] * rs * kg[pc * 8 + 2], x[3] * rs * kg[pc * 8 + 3]);
    w.z = pk2(x[4] * rs * kg[pc * 8 + 4], x[5] * rs * kg[pc * 8 + 5]); w.w = pk2(x[6] * rs * kg[pc * 8 + 6], x[7] * rs * kg[pc * 8 + 7]);
    *(u32x4*)(DKN + (size_t)tok * 64 + pc * 8) = w;
    vL[(pc * 8 + 0) * 72 + t] = (bf16_t)(vr.x & 0xffffu); vL[(pc * 8 + 1) * 72 + t] = (bf16_t)(vr.x >> 16);
    vL[(pc * 8 + 2) * 72 + t] = (bf16_t)(vr.y & 0xffffu); vL[(pc * 8 + 3) * 72 + t] = (bf16_t)(vr.y >> 16);
    vL[(pc * 8 + 4) * 72 + t] = (bf16_t)(vr.z & 0xffffu); vL[(pc * 8 + 5) * 72 + t] = (bf16_t)(vr.z >> 16);
    vL[(pc * 8 + 6) * 72 + t] = (bf16_t)(vr.w & 0xffffu); vL[(pc * 8 + 7) * 72 + t] = (bf16_t)(vr.w >> 16);
    __syncthreads();
    { const int d = tid >> 3; *(u32x4*)(DVT + (size_t)d * SEQ + tt * 64 + pc * 8) = *(const LAS u32x4*)(vL + d * 72 + pc * 8); }
}

__device__ __forceinline__ void dsa1_unit(const Ctx& c, int layer, int lb, int qt) {
    PHASE_TID();
    const Params& p = *c.p; const bf16_t* P = (const bf16_t*)(p.ws + WS_P);
    unsigned* MASK = (unsigned*)(p.ws + WS_MASK) + (size_t)lb * SEQ * 128;
    LAS unsigned* hist = (LAS unsigned*)c.lds;
    LAS unsigned short* mk16 = (LAS unsigned short*)(c.lds + 16384);
    LAS float* redL = (LAS float*)(c.lds + 24576);
    LAS int* selL = (LAS int*)(c.lds + 25600);
    const int q = lane >> 4, l15 = lane & 15, t0 = qt * 16, tq = t0 + l15, nb = qt + 1;
    __syncthreads();
    if (qt < 16) {
        const int qq = tid >> 5, wl = tid & 31, t = t0 + qq;
        if (wl <= (t >> 5)) MASK[(size_t)t * 128 + wl] = wl < (t >> 5) ? 0xFFFFFFFFu : (0xFFFFFFFFu >> (31 - (t & 31)));
        return;
    }
    for (int i = tid; i < 2048; i += 512) ((LAS unsigned*)mk16)[i] = 0u;
    const bf16_t* qrow = P + (size_t)(lb * SEQ + tq) * PW;
    bf16x8 bq[8][2]; float wq[8];
#pragma unroll
    for (int h = 0; h < 8; ++h) { wq[h] = bf2f(qrow[C_CIW + h]) * 0.044194173824159216f;
#pragma unroll
        for (int ks = 0; ks < 2; ++ks) bq[h][ks] = ld_frag_g(qrow + C_CIQ + h * 64, ks, q); }
    f32x4 sc[32];
    float mn = 3.0e38f, mx = -3.0e38f;
    const bf16_t* kbase = P + (size_t)(lb * SEQ) * PW + C_CIK;
#pragma unroll
    for (int i = 0; i < 32; ++i) { const int kb = 8 * i + wave;
        sc[i] = (f32x4){0.f, 0.f, 0.f, 0.f};
        if (kb < nb) {
            const bf16_t* krow = kbase + (size_t)(kb * 16 + l15) * PW;
            const bf16x8 a0 = ld_frag_g(krow, 0, q), a1 = ld_frag_g(krow, 1, q);
            f32x4 tot = (f32x4){0.f, 0.f, 0.f, 0.f};
#pragma unroll
            for (int h = 0; h < 8; ++h) { f32x4 d = mma16(a0, bq[h][0], (f32x4){0.f, 0.f, 0.f, 0.f}); d = mma16(a1, bq[h][1], d);
#pragma unroll
                for (int e = 0; e < 4; ++e) tot[e] += wq[h] * fmaxf(d[e], 0.f); }
#pragma unroll
            for (int e = 0; e < 4; ++e) { const bool ok = kb * 16 + 4 * q + e <= tq;
                if (ok) { mn = fminf(mn, tot[e]); mx = fmaxf(mx, tot[e]); }
                sc[i][e] = ok ? tot[e] : __int_as_float(0x7fc00000); }
        } else {
#pragma unroll
            for (int e = 0; e < 4; ++e) sc[i][e] = __int_as_float(0x7fc00000);
        }
    }
    mn = fminf(mn, shx(mn, 16, lane)); mn = fminf(mn, shx(mn, 32, lane)); mx = fmaxf(mx, shx(mx, 16, lane)); mx = fmaxf(mx, shx(mx, 32, lane));
    if (q == 0) { redL[(wave * 16 + l15) * 2] = mn; redL[(wave * 16 + l15) * 2 + 1] = mx; }
    __syncthreads();
#pragma unroll
    for (int w = 0; w < 8; ++w) { mn = fminf(mn, redL[(w * 16 + l15) * 2]); mx = fmaxf(mx, redL[(w * 16 + l15) * 2 + 1]); }
    const float scale = mx > mn ? 16777215.0f / (mx - mn) : 0.f;
#pragma unroll
    for (int i = 0; i < 32; ++i)
#pragma unroll
        for (int e = 0; e < 4; ++e) { const float s = sc[i][e]; int key = -1;
            if (s == s) { key = (int)((s - mn) * scale); key = key > 16777215 ? 16777215 : (key < 0 ? 0 : key); }
            sc[i][e] = __int_as_float(key); }
    int pref = 0, krem = 256;
#pragma unroll 1
    for (int pass = 0; pass < 3; ++pass) { const int shift = 16 - 8 * pass;
        for (int i = tid; i < 4096; i += 512) hist[i] = 0u;
        __syncthreads();
#pragma unroll
        for (int i = 0; i < 32; ++i)
#pragma unroll
            for (int e = 0; e < 4; ++e) { const int key = __float_as_int(sc[i][e]);
                if (key >= 0 && (pass == 0 || (key >> (shift + 8)) == pref)) __hip_atomic_fetch_add(hist + l15 * 256 + ((key >> shift) & 255), 1u, __ATOMIC_RELAXED, __HIP_MEMORY_SCOPE_WORKGROUP); }
        __syncthreads();
        {
            const int qq = 2 * wave + (lane >> 5), hl = lane & 31; int kr = krem;
            if (pass > 0) kr = selL[qq * 2 + 1];
            unsigned cnt[8]; unsigned s8 = 0;
#pragma unroll
            for (int b = 0; b < 8; ++b) { cnt[b] = hist[qq * 256 + hl * 8 + b]; s8 += cnt[b]; }
            unsigned suf = s8;
#pragma unroll
            for (int o = 1; o < 32; o <<= 1) { const unsigned t2 = (unsigned)__builtin_amdgcn_ds_bpermute((lane + o) << 2, (int)suf); if (hl + o < 32) suf += t2; }
            const unsigned after = suf - s8;
            __syncthreads();
            if (after < (unsigned)kr && (unsigned)kr <= after + s8) { unsigned cum = after; int bsel = 0, knew = 1; bool done = false;
#pragma unroll
                for (int b = 7; b >= 0; --b) { if (!done && cum + cnt[b] >= (unsigned)kr) { bsel = hl * 8 + b; knew = kr - (int)cum; done = true; } cum += cnt[b]; }
                selL[qq * 2] = bsel; selL[qq * 2 + 1] = knew; }
        }
        __syncthreads();
        pref = (pref << 8) | selL[l15 * 2]; krem = selL[l15 * 2 + 1];
    }
#pragma unroll
    for (int i = 0; i < 32; ++i) { const int kb = 8 * i + wave;
        if (kb < nb) { unsigned nib = 0;
#pragma unroll
            for (int e = 0; e < 4; ++e) { const int key = __float_as_int(sc[i][e]); nib |= (key >= pref ? 1u : 0u) << e; }
            unsigned v = nib << (4 * q); v |= shxu(v, 16, lane); v |= shxu(v, 32, lane);
            if (q == 0) mk16[l15 * 256 + kb] = (unsigned short)v; } }
    __syncthreads();
    { const int qq = tid >> 5, wl = tid & 31, t = t0 + qq; const LAS unsigned* mrow = (const LAS unsigned*)(mk16 + qq * 256);
      for (int w4 = wl; w4 <= (t >> 5); w4 += 32) MASK[(size_t)t * 128 + w4] = mrow[w4]; }
}

__device__ __forceinline__ void dsa2_tile(const Ctx& c, int layer, int lb, int jt) {
    PHASE_TID();
    const Params& p = *c.p; const bf16_t* P = (const bf16_t*)(p.ws + WS_P); bf16_t* YS = (bf16_t*)(p.ws + WS_YS);
    const bf16_t* DKN = (const bf16_t*)(p.ws + WS_DKN) + (size_t)lb * SEQ * 64; const bf16_t* DVT = (const bf16_t*)(p.ws + WS_DVT) + (size_t)lb * 64 * SEQ;
    const unsigned* MASK = (const unsigned*)(p.ws + WS_MASK) + (size_t)lb * SEQ * 128;
    const float* qg = p.in[12] + layer * 64;
    constexpr int KVB = 35840;
    const int q = lane >> 4, l15 = lane & 15, qs = wave & 1, hp = wave >> 1, tq = jt * 32 + qs * 16 + l15, tmaxw = jt * 32 + qs * 16 + 15;
    const size_t row = (size_t)(lb * SEQ + tq);
    const int nck = (jt * 32 + 32 + 127) >> 7;
    bf16x8 qf[2][2];
#pragma unroll
    for (int hh = 0; hh < 2; ++hh) { const int h = hp * 2 + hh; float x[2][8]; float ss = 0.f;
#pragma unroll
        for (int ks = 0; ks < 2; ++ks) { const u32x4 r = *(const u32x4*)(P + row * PW + C_CQ + h * 64 + 32 * ks + 8 * q);
            x[ks][0] = bflo(r.x); x[ks][1] = bfhi(r.x); x[ks][2] = bflo(r.y); x[ks][3] = bfhi(r.y); x[ks][4] = bflo(r.z); x[ks][5] = bfhi(r.z); x[ks][6] = bflo(r.w); x[ks][7] = bfhi(r.w);
#pragma unroll
            for (int k = 0; k < 8; ++k) ss += x[ks][k] * x[ks][k]; }
        ss += shx(ss, 16, lane); ss += shx(ss, 32, lane);
        const float rs = rsqrtf(ss * (1.f / 64.f) + 1e-6f) * (0.125f * 1.4426950408889634f);
#pragma unroll
        for (int ks = 0; ks < 2; ++ks) { const float* gp = qg + 32 * ks + 8 * q; u32x4 w;
            w.x = pk2m(x[ks][0] * rs * gp[0], x[ks][1] * rs * gp[1]); w.y = pk2m(x[ks][2] * rs * gp[2], x[ks][3] * rs * gp[3]);
            w.z = pk2m(x[ks][4] * rs * gp[4], x[ks][5] * rs * gp[5]); w.w = pk2m(x[ks][6] * rs * gp[6], x[ks][7] * rs * gp[7]);
            qf[hh][ks] = __builtin_bit_cast(bf16x8, w); } }
    const float sl2[2] = {exp2f(-(float)(hp * 2 + 1)) * 1.4426950408889634f, exp2f(-(float)(hp * 2 + 2)) * 1.4426950408889634f};
    f32x4 oacc[2][4]; float mrun[2] = {-3.0e38f, -3.0e38f}, lrun[2] = {0.f, 0.f};
#pragma unroll
    for (int hh = 0; hh < 2; ++hh)
#pragma unroll
        for (int d = 0; d < 4; ++d) oacc[hh][d] = (f32x4){0.f, 0.f, 0.f, 0.f};
    u32x4 kreg[2], vreg[2];
#define DSA_LOAD(ck) do { _Pragma("unroll") for (int j = 0; j < 2; ++j) { const int idx = tid + 512 * j; \
        kreg[j] = *(const u32x4*)(DKN + (size_t)((ck) * 128 + (idx >> 3)) * 64 + (idx & 7) * 8); \
        vreg[j] = *(const u32x4*)(DVT + (size_t)(idx >> 4) * SEQ + (ck) * 128 + (idx & 15) * 8); } } while (0)
#define DSA_STORE(buf) do { ldsp_t b_ = c.lds + (buf) * KVB; _Pragma("unroll") for (int j = 0; j < 2; ++j) { const int idx = tid + 512 * j; \
        *(LAS u32x4*)(b_ + (idx >> 3) * 144 + (idx & 7) * 16) = kreg[j]; *(LAS u32x4*)(b_ + 18432 + (idx >> 4) * 272 + (idx & 15) * 16) = vreg[j]; } } while (0)
    __syncthreads();
    DSA_LOAD(0); DSA_STORE(0);
    __syncthreads();
#pragma unroll 1
    for (int ck = 0; ck < nck; ++ck) {
        if (ck + 1 < nck) DSA_LOAD(ck + 1);
        ldsp_t b = c.lds + (ck & 1) * KVB; const LAS bf16_t* knL = (const LAS bf16_t*)b; const LAS bf16_t* vtL = (const LAS bf16_t*)(b + 18432);
#pragma unroll 1
        for (int s4 = 0; s4 < 4; ++s4) { const int s = ck * 4 + s4, key0 = s * 32;
            if (key0 > tmaxw) break;
            const unsigned mw = MASK[(size_t)tq * 128 + s];
            bf16x8 ka[2][2];
#pragma unroll
            for (int kt = 0; kt < 2; ++kt)
#pragma unroll
                for (int ks = 0; ks < 2; ++ks) ka[kt][ks] = ld_frag_l(knL + (s4 * 32 + kt * 16 + l15) * 72, ks, q);
#pragma unroll
            for (int hh = 0; hh < 2; ++hh) {
                f32x4 sv[2];
#pragma unroll
                for (int kt = 0; kt < 2; ++kt) { sv[kt] = mma16(ka[kt][0], qf[hh][0], (f32x4){0.f, 0.f, 0.f, 0.f}); sv[kt] = mma16(ka[kt][1], qf[hh][1], sv[kt]); }
                float tmax = -3.0e38f;
#pragma unroll
                for (int kt = 0; kt < 2; ++kt)
#pragma unroll
                    for (int e = 0; e < 4; ++e) { const int key = key0 + kt * 16 + 4 * q + e; const bool on = (mw >> (kt * 16 + 4 * q + e)) & 1u;
                        const float xv = on ? sv[kt][e] + sl2[hh] * (float)(key - tq) : -3.0e38f; sv[kt][e] = xv; tmax = fmaxf(tmax, xv); }
                tmax = fmaxf(tmax, shx(tmax, 16, lane)); tmax = fmaxf(tmax, shx(tmax, 32, lane));
                const float mnew = fmaxf(mrun[hh], tmax), corr = __builtin_amdgcn_exp2f(mrun[hh] - mnew); mrun[hh] = mnew;
                float ps = 0.f;
#pragma unroll
                for (int kt = 0; kt < 2; ++kt)
#pragma unroll
                    for (int e = 0; e < 4; ++e) { const float pe = sv[kt][e] > -1.0e38f ? __builtin_amdgcn_exp2f(sv[kt][e] - mnew) : 0.f; sv[kt][e] = pe; ps += pe; }
                lrun[hh] = lrun[hh] * corr + ps;
                const bf16x8 pf = pack_frag(sv[0], sv[1]);
#pragma unroll
                for (int d = 0; d < 4; ++d) { oacc[hh][d] = oacc[hh][d] * corr; oacc[hh][d] = mma16(ld_frag_perm_l(vtL + (d * 16 + l15) * 136, s4, q), pf, oacc[hh][d]); }
            }
        }
        if (ck + 1 < nck) DSA_STORE((ck + 1) & 1);
        __syncthreads();
    }
#undef DSA_LOAD
#undef DSA_STORE
#pragma unroll
    for (int hh = 0; hh < 2; ++hh) { const int h = hp * 2 + hh; float l = lrun[hh]; l += shx(l, 16, lane); l += shx(l, 32, lane); const float inv = 1.0f / l;
#pragma unroll
        for (int d = 0; d < 4; ++d) { const int ch = h * 64 + d * 16 + 4 * q; const u32x2 gr = *(const u32x2*)(P + row * PW + C_CG + ch);
            u32x2 w; w.x = pk2(oacc[hh][d][0] * inv * fsilu(bflo(gr.x)), oacc[hh][d][1] * inv * fsilu(bfhi(gr.x))); w.y = pk2(oacc[hh][d][2] * inv * fsilu(bflo(gr.y)), oacc[hh][d][3] * inv * fsilu(bfhi(gr.y)));
            *(u32x2*)(YS + row * YW + 2 * BW + ch) = w; } }
}

__device__ __forceinline__ void phase_s1(const Ctx& c, int layer, int grp) {
    for (int u = c.bid; u < 2816; u += c.G) {
        if (u < 1024) dsa1_unit(c, layer, u & 3, 255 - (u >> 2));
        else if (u < 2048) { const int v = u - 1024; gdn_pre_unit(c, layer, v >> 8, (v >> 2) & 63, v & 3); }
        else if (u < 2304) { const int v = u - 2048; ssd1_unit(c, layer, v >> 6, (v >> 1) & 31, v & 1); }
        else if (u < 2560) { const int v = u - 2304; dsa_prep_unit(c, layer, v >> 6, v & 63); }
        else if (u < 2688) { const int v = u - 2560; sg_unit(c, layer, v >> 5, v & 31); }
        else { const int v = u - 2688; mem_unit(c, layer, grp, v >> 5, (v >> 3) & 3, v & 7); }
    }
}
__device__ __forceinline__ void phase_s2(const Ctx& c, int layer, int grp) {
    if (c.bid < 16) gdn_chain(c, layer, c.bid >> 2, c.bid & 3);
    ssd_scan(c);
    for (int u = c.bid; u < 256; u += c.G) { const int lb = u >> 6, j = u & 63; dsa2_tile(c, layer, lb, 127 - j); dsa2_tile(c, layer, lb, j); }
}
__device__ __forceinline__ void phase_s3(const Ctx& c, int layer, int grp) {
    for (int u = c.bid; u < 128; u += c.G) ssd3_unit(c, layer, u >> 5, u & 31);
}

__global__ void __launch_bounds__(512, 2) hybrid_fwd(Params prm) {
    extern __shared__ __attribute__((aligned(16))) unsigned char lds_raw[];
    Ctx c;
    c.lds = (ldsp_t)lds_raw; c.bid = blockIdx.x; c.wv = __builtin_amdgcn_readfirstlane((int)threadIdx.x >> 6); c.p = &prm;
    for (int u = threadIdx.x; u < (LDS_BYTES - LDS_MISC) / 4; u += 512) ((LAS unsigned*)(c.lds + LDS_MISC))[u] = 0u;
    __syncthreads();
    XcdBarrier bar = xcd_barrier_post((unsigned*)(prm.ws + WS_CTL), (volatile LAS unsigned*)(c.lds + LDS_MISC));
    unsigned char* ws = prm.ws;
    bf16_t* H = (bf16_t*)(ws + WS_H); bf16_t* P = (bf16_t*)(ws + WS_P); bf16_t* YS = (bf16_t*)(ws + WS_YS);
    bf16_t* GS = (bf16_t*)(ws + WS_P);
    bf16_t* MG = (bf16_t*)(ws + WS_H);

    for (int layer = 0; layer < DEPTH; ++layer) {
        phase_convert(c, layer);
        xcd_barrier(bar);
        for (int grp = 0; grp < NGRP; ++grp) {
            const float* xin = (layer == 0 ? prm.in[0] : (const float*)prm.out) + (size_t)grp * TG * DM;
            float* xout = prm.out + (size_t)grp * TG * DM;
            phase_norm(c, xin);
            xcd_barrier(bar);
#if !defined(NO_P1)
            {
                pg8::Gemm g{H, (const bf16_t*)(ws + WS_WIN), TG, PW, DM, DM, DM, 0, 0}; pg8::StaticOrder S; S.init(TG, PW, c.G, c.bid);
                EpiStoreBf16<0> E{P, PW, prm.one};
                pg8::gemm_phase<EpiStoreBf16<0>, pg8::StaticOrder>(c.lds, g, S, E, nullptr, c.wv);
                if (grp == 0) {
                    __syncthreads();
                    pg8::Gemm g2{(const bf16_t*)(ws + WS_MEMN), (const bf16_t*)(ws + WS_WKV), BATCH * MEMLEN, DM, DM, DM, DM, 0, 0}; pg8::StaticOrder S2; S2.init(BATCH * MEMLEN, DM, c.G, c.bid);
                    EpiStoreBf16<0> E2{(bf16_t*)(ws + WS_KV), DM, prm.one};
                    pg8::gemm_phase<EpiStoreBf16<0>, pg8::StaticOrder>(c.lds, g2, S2, E2, nullptr, c.wv);
                }
            }
#endif
            xcd_barrier(bar);
            phase_s1(c, layer, grp);
            xcd_barrier(bar);
            phase_s2(c, layer, grp);
            xcd_barrier(bar);
            phase_s3(c, layer, grp);
            xcd_barrier(bar);
#if !defined(NO_P2)
            {
                pg8::Gemm g{H, (const bf16_t*)(ws + WS_WG), TG, GW, DM, DM, DM, 0, 0}; pg8::StaticOrder S; S.init(TG, GW, c.G, c.bid);
                EpiStoreBf16<1> E{GS, GW, prm.one};
                pg8::gemm_phase<EpiStoreBf16<1>, pg8::StaticOrder>(c.lds, g, S, E, nullptr, c.wv);
            }
#endif
            xcd_barrier(bar);
#if !defined(NO_P3)
            {
                pg8::Gemm g{YS, (const bf16_t*)(ws + WS_WB), TG, DM, BW, YW, BW, (size_t)BW, (size_t)DM * BW}; MergeOrder S{c.G, c.bid, (TG / 256) * 4};
                EpiMerge E{GS, MG, (const float*)(ws + WS_SMALL) + SM_SSD_RS};
                pg8::gemm_phase<EpiMerge, MergeOrder>(c.lds, g, S, E, nullptr, c.wv);
            }
#endif
            xcd_barrier(bar);
#if !defined(NO_P4)
            {
                pg8::Gemm g{MG, (const bf16_t*)(ws + WS_WO), TG, DM, DM, DM, DM, 0, 0}; pg8::StaticOrder S; S.init(TG, DM, c.G, c.bid);
                EpiResid E{xin, xout};
                pg8::gemm_phase<EpiResid, pg8::StaticOrder>(c.lds, g, S, E, nullptr, c.wv);
            }
#endif
            xcd_barrier(bar);
        }
    }
}
}

extern "C" void kernel_launch(void* const* d_in, const int* in_sizes, int n_in, void* d_out, int out_size, void* d_ws, size_t ws_size, hipStream_t stream) {
    static int grid = 0;
    if (grid == 0) {
        if (n_in != 27 || ws_size < hk::WS_END) { fprintf(stderr, "kernel_launch: expected 27 inputs and >= %zu bytes of workspace, got %d / %zu\n", (size_t)hk::WS_END, n_in, ws_size); grid = -1; return; }
        int dev = 0, cus = 0, per_cu = 0;
        if (hipGetDevice(&dev) != hipSuccess || hipDeviceGetAttribute(&cus, hipDeviceAttributeMultiprocessorCount, dev) != hipSuccess) { grid = -1; return; }
        if (hipFuncSetAttribute((const void*)hk::hybrid_fwd, hipFuncAttributeMaxDynamicSharedMemorySize, hk::LDS_BYTES) != hipSuccess) { fprintf(stderr, "kernel_launch: hipFuncSetAttribute failed\n"); grid = -1; return; }
        if (hipOccupancyMaxActiveBlocksPerMultiprocessor(&per_cu, (const void*)hk::hybrid_fwd, 512, hk::LDS_BYTES) != hipSuccess || per_cu < 1)
            fprintf(stderr, "kernel_launch: occupancy query reports %d workgroups per CU\n", per_cu);
        (void)hipGetLastError();
        if (cus < hk::Ctx::G) { fprintf(stderr, "kernel_launch: built for >= %d CUs, device has %d\n", hk::Ctx::G, cus); grid = -1; return; }
        grid = hk::Ctx::G;
    }
    if (grid < 0) return;
    (void)hipMemsetAsync((char*)d_ws + hk::WS_CTL, 0, hk::CTL_BYTES, stream);
    hk::Params p{};
    for (int i = 0; i < 27; ++i) p.in[i] = (const float*)d_in[i];
    p.out = (float*)d_out; p.ws = (unsigned char*)d_ws; p.one = 1.0f; p.pad = 0;
    hipLaunchKernelGGL(hk::hybrid_fwd, dim3(grid), dim3(512), hk::LDS_BYTES, stream, p);
}
```

```cpp
#include <hip/hip_runtime.h>
#include <cstdio>
#include <cstdint>

#define XB_TMO      128
#define XB_XCNT(j)  (256  + 64 * (j))
#define XB_XSUB(j)  (1280 + 64 * (j))
#define XB_XGEN(j)  (2304 + 64 * (j))
#define XB_TOP      3328
#define XB_TOPGEN   3392
#define XCD_BAR_WORDS 3456
#define XB_SPIN_CAP (1u << 18)
#define LAS __attribute__((address_space(3)))

__device__ __forceinline__ unsigned xb_ld(unsigned* p)              { return __hip_atomic_load(p, __ATOMIC_RELAXED, __HIP_MEMORY_SCOPE_AGENT); }
__device__ __forceinline__ unsigned xb_add(unsigned* p, unsigned v) { return __hip_atomic_fetch_add(p, v, __ATOMIC_RELAXED, __HIP_MEMORY_SCOPE_AGENT); }
__device__ __forceinline__ unsigned xb_xcc_id() { return (unsigned)__builtin_amdgcn_s_getreg((3 << 11) | 20) & 0xFu; }
#define XB_SPIN(cond, bar) do { unsigned _sp = 0; while (cond) { __builtin_amdgcn_s_sleep(1); \
    if ((++_sp & 255u) == 0u) { if (xb_ld(&(bar)[XB_TMO])) break; if (_sp > XB_SPIN_CAP) { atomicAdd(&(bar)[XB_TMO], 1u); break; } } } } while (0)

struct XcdBarrier {
    unsigned* bar; unsigned x;
    volatile LAS unsigned* st;
};

__device__ __forceinline__ XcdBarrier xcd_barrier_post(unsigned* bar, volatile LAS unsigned* st) {
    XcdBarrier b; b.bar = bar; b.x = xb_xcc_id(); b.st = st;
    if (threadIdx.x == 0) (void)xb_add(&bar[XB_XCNT(b.x)], 1u);
    return b;
}
__device__ __forceinline__ void xcd_barrier_complete(unsigned* bar, unsigned x, unsigned& nloc, unsigned& nx) {
    const unsigned G = gridDim.x * gridDim.y * gridDim.z;
    unsigned sum, cnt, mine, sp = 0u;
    for (;;) {
        sum = 0u; cnt = 0u; mine = 0u;
#pragma unroll
        for (unsigned j = 0; j < 16; ++j) { const unsigned c = xb_ld(&bar[XB_XCNT(j)]); sum += c; cnt += (c > 0u) ? 1u : 0u; mine = (j == x) ? c : mine; }
        if (sum == G) break;
        __builtin_amdgcn_s_sleep(1);
        if ((++sp & 255u) == 0u) { if (xb_ld(&bar[XB_TMO])) break; if (sp > XB_SPIN_CAP) { atomicAdd(&bar[XB_TMO], 1u); break; } }
    }
    nloc = mine > 0u ? mine : 1u; nx = cnt > 0u ? cnt : 1u;
}

__device__ __forceinline__ void xcd_barrier(const XcdBarrier& b) {
    asm volatile("s_waitcnt vmcnt(0)" ::: "memory");
    __syncthreads();
    if (threadIdx.x == 0) {
        unsigned* bar = b.bar;
        __builtin_amdgcn_s_waitcnt(0);
        unsigned nloc = b.st[0], nx = b.st[1];
        if (nloc == 0u) { xcd_barrier_complete(bar, b.x, nloc, nx); b.st[0] = nloc; b.st[1] = nx; }
        const unsigned old = xb_add(&bar[XB_XSUB(b.x)], 1u);
        const unsigned gen = old / nloc;
        if (old + 1u == (gen + 1u) * nloc) {
            __builtin_amdgcn_fence(__ATOMIC_RELEASE, "agent");
            asm volatile("s_waitcnt vmcnt(0)" ::: "memory");
            const unsigned og = xb_add(&bar[XB_TOP], 1u);
            const unsigned tg = og / nx;
            if (og + 1u == (tg + 1u) * nx) xb_add(&bar[XB_TOPGEN], 1u);
            else XB_SPIN(xb_ld(&bar[XB_TOPGEN]) == tg, bar);
            __builtin_amdgcn_fence(__ATOMIC_ACQUIRE, "agent");
            xb_add(&bar[XB_XGEN(b.x)], 1u);
            asm volatile("s_waitcnt vmcnt(0)" ::: "memory");
        } else {
            XB_SPIN(xb_ld(&bar[XB_XGEN(b.x)]) == gen, bar);
            __builtin_amdgcn_fence(__ATOMIC_ACQUIRE, "agent");
            asm volatile("s_waitcnt vmcnt(0)" ::: "memory");
        }
    }
    __syncthreads();
}

namespace pg8 {
#define PG8_LAS __attribute__((address_space(3)))
typedef unsigned short bf16_t;
typedef short bf16x8 __attribute__((ext_vector_type(8)));
typedef float f32x4 __attribute__((ext_vector_type(4)));
typedef unsigned u32x4 __attribute__((ext_vector_type(4)));
typedef int i32x8 __attribute__((ext_vector_type(8)));
typedef short bf16x16 __attribute__((ext_vector_type(16)));
constexpr int BM = 256, BK = 64, HALF = 128, HTB = HALF * BK * 2  , STAGE_BYTES = 8 * HTB, NXCD = 8, WGM = 8;

__host__ __device__ __forceinline__ int lds_byte(int r, int c) { const int st = (r >> 4) * 2 + (c >> 5), rr = r & 15, cc = c & 31, ob = rr * 64 + cc * 2; return st * 1024 + (ob ^ (((ob >> 9) & 1) << 5)); }
__host__ __device__ __forceinline__ void stage_rc(int b, int& R, int& C) { const int st = b / 1024, sb = b % 1024, swz = sb ^ (((sb >> 9) & 1) << 5); R = (st >> 1) * 16 + swz / 64; C = (st & 1) * 32 + (swz % 64) / 2; }
__host__ __device__ __forceinline__ int perm32(int rho) { const int n = rho >> 4, i = rho & 15; return 8 * (i >> 2) + 4 * n + (i & 3); }

struct Unit { int pm, pn, pz; };
struct Gemm { const bf16_t* A; const bf16_t* Bt; int M, N, K, lda, ldb; size_t a_z, b_z; };

struct StaticOrder {
    int nM, nN, nwg, G, c;
    __host__ __device__ void init(int M, int N, int G_, int c_) { nM = M / BM; nN = N / BM; nwg = nM * nN; G = G_; c = c_; }
    __host__ __device__ bool next(int i, Unit& u) const {
        const long L = (long)i * G + c; if (L >= nwg) return false;
        int wgid = (int)L; { const int q = nwg / NXCD, r = nwg % NXCD, xcd = wgid % NXCD, off = wgid / NXCD; wgid = (xcd < r ? xcd * (q + 1) : r * (q + 1) + (xcd - r) * q) + off; }
        const int nig = WGM * nN, gid = wgid / nig, fm = gid * WGM, gsz = (nM - fm) < WGM ? (nM - fm) : WGM;
        u.pm = fm + ((wgid % nig) % gsz); u.pn = (wgid % nig) / gsz; u.pz = 0; return true;
    }
    __device__ __forceinline__ void a_ready(const Unit&) const {}
    __device__ __forceinline__ void done(const Unit&) const {}
};
struct CountedOrder : StaticOrder {
    const unsigned* ready; unsigned need; unsigned* tmo;
    __device__ __forceinline__ void a_ready(const Unit& u) const {
        if (threadIdx.x < 64) {
            const unsigned long long t0 = __builtin_amdgcn_s_memrealtime(); unsigned polls = 0;
            while ((unsigned)__builtin_amdgcn_readfirstlane(__hip_atomic_load(ready + 64 * u.pm, __ATOMIC_RELAXED, __HIP_MEMORY_SCOPE_AGENT)) < need) {
                if ((++polls & 255u) == 0u && __builtin_amdgcn_readfirstlane(__hip_atomic_load(tmo, __ATOMIC_RELAXED, __HIP_MEMORY_SCOPE_AGENT)) != 0u) break;
                if (__builtin_amdgcn_s_memrealtime() - t0 > 2000000ull) {
                    if (threadIdx.x == 0) { unsigned expect = 0u; __hip_atomic_compare_exchange_strong(tmo + 1, &expect, 0x600u | (unsigned)(u.pm & 0xff), __ATOMIC_RELAXED, __ATOMIC_RELAXED, __HIP_MEMORY_SCOPE_AGENT); __hip_atomic_store(tmo, 1u, __ATOMIC_RELAXED, __HIP_MEMORY_SCOPE_AGENT); }
                    break; }
                __builtin_amdgcn_s_sleep(2); }
            __builtin_amdgcn_fence(__ATOMIC_ACQUIRE, "agent");
            asm volatile("s_waitcnt vmcnt(0)" ::: "memory");
        }
#if !defined(BROKEN_HOOK_NO_BARRIER)
        asm volatile("" ::: "memory"); __builtin_amdgcn_s_barrier(); asm volatile("" ::: "memory");
#endif
    }
};

__device__ __forceinline__ unsigned cvt_pk_bf16(float lo, float hi) { unsigned r; asm volatile("v_cvt_pk_bf16_f32 %0, %1, %2" : "=v"(r) : "v"(lo), "v"(hi)); return r; }
typedef float f32x2 __attribute__((ext_vector_type(2)));
__device__ __forceinline__ f32x2 gelu_pk(f32x2 v) {
    const f32x2 av = __builtin_elementwise_abs(v), d = av * 0.2316418882f + 1.0f;
    f32x2 t; t.x = __builtin_amdgcn_rcpf(d.x); t.y = __builtin_amdgcn_rcpf(d.y);
    f32x2 q = t * 0.5307027145f + (-0.7265760135f); q = q * t + 0.7107068705f; q = q * t + (-0.142248368f); q = q * t + 0.127414796f; q = q * t;
    const f32x2 s = (v * v) * (-0.72134752044f);
    f32x2 e; e.x = __builtin_amdgcn_exp2f(s.x); e.y = __builtin_amdgcn_exp2f(s.y);
    const f32x2 m = v * (q * e), r = v - m;
    f32x2 o; o.x = v.x < 0.f ? m.x : r.x; o.y = v.y < 0.f ? m.y : r.y; return o;
}

template <class Epi, class Sched, bool STAMP = false>
__device__ __forceinline__ void gemm_phase(PG8_LAS unsigned char* lds, const Gemm g, const Sched& S, const Epi& E, unsigned long long* stamps, int wave_uniform) {
    int tid_; asm volatile("v_mbcnt_lo_u32_b32 %0, -1, 0\n\tv_mbcnt_hi_u32_b32 %0, -1, %0" : "=v"(tid_)); tid_ += wave_uniform * 64;
    const int tid = tid_, wid = __builtin_amdgcn_readfirstlane(tid >> 6), lane = tid & 63, wr = wid >> 2, wc = wid & 3, fr = lane & 15, fq = lane >> 4;
    const int K = g.K, nt = K / BK;
    int ts_lo = 0, ts_hi = 0, nts = 0; const unsigned long long rt_entry = STAMP ? (unsigned long long)wall_clock64() : 0ull;
#define PG8_STAMP() do { if (STAMP && wid == 0 && nts < 64) { const unsigned long long _c = (unsigned long long)clock64(); \
        ts_lo = (lane == nts) ? (int)(unsigned)_c : ts_lo; ts_hi = (lane == nts) ? (int)(unsigned)(_c >> 32) : ts_hi; ++nts; } } while (0)
    PG8_STAMP();
    unsigned voffA[2], voffB[2];
#pragma unroll
    for (int i = 0; i < 2; ++i) { int R, C; stage_rc(tid * 16 + i * 8192, R, C); const int Rb = Epi::PERM ? ((R & ~31) + perm32(R & 31)) : R;
        voffA[i] = (unsigned)(R * g.lda + C) * 2u; voffB[i] = (unsigned)(Rb * g.ldb + C) * 2u; }
    const size_t kstep = (size_t)(BK * 2);
    const size_t hstepA = (size_t)HALF * g.lda * 2, hstepB = (size_t)HALF * g.ldb * 2;
    const size_t tstepA = 2 * hstepA, tstepB = 2 * hstepB;
    const unsigned ldsw = (unsigned)wid * 1024u;
    const int aoff = lds_byte(wr * 64 + fr, fq * 8), boff = lds_byte(wc * 32 + fr, fq * 8);
#define PG8_SA(b, h) (((b) * 2 + (h)) * HTB)
#define PG8_SB(b, h) ((4 + (b) * 2 + (h)) * HTB)
#define PG8_STAGE(bufoff, gbase, voff) do { const char* gb_ = (const char*)(gbase); asm volatile("" : "+s"(gb_));     \
        _Pragma("unroll") for (int _i = 0; _i < 2; ++_i) { unsigned vo_ = (voff)[_i]; asm volatile("" : "+v"(vo_)); \
        __builtin_amdgcn_global_load_lds((const unsigned*)(gb_ + vo_), (PG8_LAS unsigned*)(lds + (bufoff) + ldsw + _i * 8192), 16, 0, 0); } } while (0)
#define PG8_LDA(dst, b, h) do { _Pragma("unroll") for (int m = 0; m < 4; ++m) _Pragma("unroll") for (int k = 0; k < 2; ++k) dst[m][k] = *(const PG8_LAS bf16x8*)(lds + PG8_SA(b, h) + aoff + m * 2048 + k * 1024); } while (0)
#define PG8_LDB(dst, b, h) do { _Pragma("unroll") for (int n = 0; n < 2; ++n) _Pragma("unroll") for (int k = 0; k < 2; ++k) dst[n][k] = *(const PG8_LAS bf16x8*)(lds + PG8_SB(b, h) + boff + n * 2048 + k * 1024); } while (0)
#define PG8_MMA(ai, bj, At, Bt) do { __builtin_amdgcn_s_setprio(1); _Pragma("unroll") for (int m = 0; m < 4; ++m) _Pragma("unroll") for (int n = 0; n < 2; ++n) _Pragma("unroll") for (int k = 0; k < 2; ++k) \
        acc[ai][bj][m][n] = __builtin_amdgcn_mfma_f32_16x16x32_bf16(Bt[n][k], At[m][k], acc[ai][bj][m][n], 0, 0, 0); __builtin_amdgcn_s_setprio(0); } while (0)
#define PG8_WAIT_V(n) asm volatile("s_waitcnt vmcnt(" #n ")" ::: "memory")
#define PG8_WAIT_L(n) asm volatile("s_waitcnt lgkmcnt(" #n ")" ::: "memory")
#define PG8_BAR __builtin_amdgcn_s_barrier()
#define PG8_SCHED __builtin_amdgcn_sched_barrier(0)
    Unit cur, nxt; int ui = 0;
    if (!S.next(0, cur)) return;
    f32x4 acc[2][2][4][2];
#pragma unroll
    for (int a = 0; a < 2; ++a)
#pragma unroll
        for (int b = 0; b < 2; ++b)
#pragma unroll
            for (int m = 0; m < 4; ++m)
#pragma unroll
                for (int n = 0; n < 2; ++n) acc[a][b][m][n] = (f32x4){0.f, 0.f, 0.f, 0.f};
    bf16x8 At[4][2], B0[2][2], B1[2][2];
    const char* cA = (const char*)g.A + (size_t)cur.pm * tstepA + (size_t)cur.pz * g.a_z * 2; const char* cB = (const char*)g.Bt + (size_t)cur.pn * tstepB + (size_t)cur.pz * g.b_z * 2;
    S.a_ready(cur);
    PG8_STAGE(PG8_SB(0, 0), cB, voffB); PG8_STAGE(PG8_SA(0, 0), cA, voffA); PG8_STAGE(PG8_SB(0, 1), cB + hstepB, voffB); PG8_STAGE(PG8_SA(0, 1), cA + hstepA, voffA);
    if (wr == 1) PG8_BAR;
    PG8_WAIT_V(4); PG8_BAR;
    PG8_STAGE(PG8_SB(1, 0), cB + kstep, voffB); PG8_STAGE(PG8_SA(1, 0), cA + kstep, voffA); PG8_STAGE(PG8_SB(1, 1), cB + hstepB + kstep, voffB);
    PG8_WAIT_V(6); PG8_BAR;
    PG8_STAMP();
    for (;;) {
        const bool has_next = S.next(ui + 1, nxt);
        const char* nA = has_next ? (const char*)g.A + (size_t)nxt.pm * tstepA + (size_t)nxt.pz * g.a_z * 2 : cA; const char* nB = has_next ? (const char*)g.Bt + (size_t)nxt.pn * tstepB + (size_t)nxt.pz * g.b_z * 2 : cB;
        for (int t = 0; t < nt; t += 2) {
            const bool last = (t == nt - 2);
            const char* a1 = cA + (size_t)(t + 1) * kstep;
            const char* a2 = last ? nA : cA + (size_t)(t + 2) * kstep; const char* b2 = last ? nB : cB + (size_t)(t + 2) * kstep;
            const char* a3 = a2 + kstep; const char* b3 = b2 + kstep;
            if (last && has_next) S.a_ready(nxt);
            PG8_LDB(B0, 0, 0); PG8_SCHED; PG8_LDA(At, 0, 0); PG8_STAGE(PG8_SA(1, 1), a1 + hstepA, voffA);
            PG8_WAIT_L(8); PG8_BAR; PG8_WAIT_L(0); PG8_MMA(0, 0, At, B0); PG8_BAR; PG8_SCHED;
            PG8_LDB(B1, 0, 1); PG8_STAGE(PG8_SB(0, 0), b2, voffB);
            PG8_BAR; PG8_WAIT_L(0); PG8_MMA(0, 1, At, B1); PG8_BAR;
            PG8_LDA(At, 0, 1); PG8_STAGE(PG8_SA(0, 0), a2, voffA);
            PG8_BAR; PG8_WAIT_L(0); PG8_MMA(1, 0, At, B0); PG8_BAR; PG8_SCHED;
            PG8_STAGE(PG8_SB(0, 1), b2 + hstepB, voffB);
            PG8_WAIT_V(6); PG8_BAR; PG8_MMA(1, 1, At, B1); PG8_BAR;
            PG8_LDB(B0, 1, 0); PG8_SCHED; PG8_LDA(At, 1, 0); PG8_STAGE(PG8_SA(0, 1), a2 + hstepA, voffA);
            PG8_WAIT_L(8); PG8_BAR; PG8_WAIT_L(0); PG8_MMA(0, 0, At, B0); PG8_BAR; PG8_SCHED;
            PG8_LDB(B1, 1, 1); PG8_STAGE(PG8_SB(1, 0), b3, voffB);
            PG8_BAR; PG8_WAIT_L(0); PG8_MMA(0, 1, At, B1); PG8_BAR;
            PG8_LDA(At, 1, 1); PG8_STAGE(PG8_SA(1, 0), a3, voffA);
            PG8_BAR; PG8_WAIT_L(0); PG8_MMA(1, 0, At, B0); PG8_BAR; PG8_SCHED;
            PG8_STAGE(PG8_SB(1, 1), b3 + hstepB, voffB);
            PG8_WAIT_V(6); PG8_BAR; PG8_MMA(1, 1, At, B1); PG8_BAR;
        }
        PG8_STAMP();
        if constexpr (!Epi::AFTER_DRAIN) { E(acc, cur, wr, wc, fr, fq); S.done(cur); }
        PG8_STAMP();
        if (!has_next) break;
#pragma unroll
        for (int a = 0; a < 2; ++a)
#pragma unroll
            for (int b = 0; b < 2; ++b)
#pragma unroll
                for (int m = 0; m < 4; ++m)
#pragma unroll
                    for (int n = 0; n < 2; ++n) acc[a][b][m][n] = (f32x4){0.f, 0.f, 0.f, 0.f};
        cur = nxt; cA = nA; cB = nB; ++ui;
    }
    PG8_WAIT_V(0);
    if (wr == 0) PG8_BAR;
    PG8_BAR;
    if constexpr (Epi::AFTER_DRAIN) { E.fused(acc, cur, wr, wc, fr, fq, lds, wid, lane); S.done(cur); }
    PG8_STAMP();
    if (STAMP && wid == 0) { stamps[lane] = lane < nts ? (((unsigned long long)(unsigned)ts_hi << 32) | (unsigned)ts_lo) : 0ull;
        if (lane == 62) stamps[62] = rt_entry; if (lane == 63) stamps[63] = (unsigned long long)wall_clock64(); }
#undef PG8_STAMP
#undef PG8_SA
#undef PG8_SB
#undef PG8_STAGE
#undef PG8_LDA
#undef PG8_LDB
#undef PG8_MMA
#undef PG8_WAIT_V
#undef PG8_WAIT_L
#undef PG8_BAR
#undef PG8_SCHED
}
#define PG8_KLOOPX(NT_, VA_C, VB_C, HSA_C, HSB_C, VA_N, VB_N, HSA_N, HSB_N, LDA_, LDB_, MMA_) \
        for (int t = 0; t < NT_; t += 2) { \
            const bool last = (t == NT_ - 2); \
            const size_t hA2 = last ? HSA_N : HSA_C, hB2 = last ? HSB_N : HSB_C; \
            const unsigned vA2 = last ? VA_N : VA_C, vB2 = last ? VB_N : VB_C; \
            const char* a1 = cA + (size_t)(t + 1) * kstep; \
            const char* a2 = last ? nA : cA + (size_t)(t + 2) * kstep; const char* b2 = last ? nB : cB + (size_t)(t + 2) * kstep; \
            const char* a3 = a2 + kstep; const char* b3 = b2 + kstep; \
            LDB_(B0, 0, 0); PG8_SCHED; LDA_(At, 0, 0); PG8_STAGE(PG8_SA(1, 1), a1 + HSA_C, VA_C, HSA_C); \
            PG8_WAIT_L(8); PG8_BAR; PG8_WAIT_L(0); MMA_(0, 0, At, B0); PG8_BAR; PG8_SCHED; \
            LDB_(B1, 0, 1); PG8_STAGE(PG8_SB(0, 0), b2, vB2, hB2); \
            PG8_BAR; PG8_WAIT_L(0); MMA_(0, 1, At, B1); PG8_BAR; \
            LDA_(At, 0, 1); PG8_STAGE(PG8_SA(0, 0), a2, vA2, hA2); \
            PG8_BAR; PG8_WAIT_L(0); MMA_(1, 0, At, B0); PG8_BAR; PG8_SCHED; \
            PG8_STAGE(PG8_SB(0, 1), b2 + hB2, vB2, hB2); \
            PG8_WAIT_V(6); PG8_BAR; MMA_(1, 1, At, B1); PG8_BAR; \
            LDB_(B0, 1, 0); PG8_SCHED; LDA_(At, 1, 0); PG8_STAGE(PG8_SA(0, 1), a2 + hA2, vA2, hA2); \
            PG8_WAIT_L(8); PG8_BAR; PG8_WAIT_L(0); MMA_(0, 0, At, B0); PG8_BAR; PG8_SCHED; \
            LDB_(B1, 1, 1); PG8_STAGE(PG8_SB(1, 0), b3, vB2, hB2); \
            PG8_BAR; PG8_WAIT_L(0); MMA_(0, 1, At, B1); PG8_BAR; \
            LDA_(At, 1, 1); PG8_STAGE(PG8_SA(1, 0), a3, vA2, hA2); \
            PG8_BAR; PG8_WAIT_L(0); MMA_(1, 0, At, B0); PG8_BAR; PG8_SCHED; \
            PG8_STAGE(PG8_SB(1, 1), b3 + hB2, vB2, hB2); \
            PG8_WAIT_V(6); PG8_BAR; MMA_(1, 1, At, B1); PG8_BAR; \
        }

template <class EpiG, class EpiY>
__device__ __forceinline__ void gemm_gate_merge(PG8_LAS unsigned char* lds, const bf16_t* H, const bf16_t* WG, const bf16_t* YS, const bf16_t* WB, int pm, int pn, const EpiG& EG, const EpiY& EY, int wave_uniform) {
    int tid_; asm volatile("v_mbcnt_lo_u32_b32 %0, -1, 0\n\tv_mbcnt_hi_u32_b32 %0, -1, %0" : "=v"(tid_)); tid_ += wave_uniform * 64;
    const int tid = tid_, wid = __builtin_amdgcn_readfirstlane(tid >> 6), lane = tid & 63, wr = wid >> 2, wc = wid & 3, fr = lane & 15, fq = lane >> 4;
    constexpr int LDA0B = 15872, LDB0B = 1024, NT0 = 8, LDA1 = 2560, LDB1 = 512, NT1 = 8;
    unsigned voffA0, voffB0, voffA1, voffB1;
    { int R, C; stage_rc(tid * 16, R, C); const int Rb = (R & ~31) + perm32(R & 31);
        voffA0 = (unsigned)(R * LDA0B + C * 2); voffB0 = (unsigned)(Rb * LDB0B + C * 2); voffA1 = (unsigned)(R * LDA1 + C) * 2u; voffB1 = (unsigned)(Rb * LDB1 + C) * 2u; }
    const size_t kstep = (size_t)(BK * 2);
    constexpr size_t hsA0 = (size_t)HALF * LDA0B, hsB0 = (size_t)HALF * LDB0B, hsA1 = (size_t)HALF * LDA1 * 2, hsB1 = (size_t)HALF * LDB1 * 2;
    const unsigned ldsw = (unsigned)wid * 1024u;
#define PG8_SA(b, h) (((b) * 2 + (h)) * HTB)
#define PG8_SB(b, h) ((4 + (b) * 2 + (h)) * HTB)
#define PG8_STAGE(bufoff, gbase, voff, hs) do { _Pragma("unroll") for (int _i = 0; _i < 2; ++_i) { \
        const char* gb_ = (const char*)(gbase) + _i * ((hs) / 2); asm volatile("" : "+s"(gb_));     \
        unsigned vo_ = (voff); asm volatile("" : "+v"(vo_));                                       \
        __builtin_amdgcn_global_load_lds((const unsigned*)(gb_ + vo_), (PG8_LAS unsigned*)(lds + (bufoff) + ldsw + _i * 8192), 16, 0, 0); } } while (0)
#define PG8_LDA(dst, b, h) do { _Pragma("unroll") for (int m = 0; m < 4; ++m) _Pragma("unroll") for (int k = 0; k < 2; ++k) dst[m][k] = *(const PG8_LAS bf16x8*)(lds + PG8_SA(b, h) + aoff + m * 2048 + k * 1024); } while (0)
#define PG8_LDA8(dst, b, h) do { _Pragma("unroll") for (int m = 0; m < 4; ++m) _Pragma("unroll") for (int k = 0; k < 2; ++k) dst[m][k] = *(const PG8_LAS bf16x8*)(lds + PG8_SA(b, h) + aoff8 + m * 2048 + k * 16); } while (0)
#define PG8_LDB8(dst, b, h) do { _Pragma("unroll") for (int n = 0; n < 2; ++n) _Pragma("unroll") for (int k = 0; k < 2; ++k) dst[n][k] = *(const PG8_LAS bf16x8*)(lds + PG8_SB(b, h) + boff8 + n * 2048 + k * 16); } while (0)
#define PG8_CAT8(x) __builtin_bit_cast(i32x8, (bf16x16){x[0][0], x[0][1], x[0][2], x[0][3], x[0][4], x[0][5], x[0][6], x[0][7], x[1][0], x[1][1], x[1][2], x[1][3], x[1][4], x[1][5], x[1][6], x[1][7]})
#define PG8_MMA8(ai, bj, At, Bt) do { __builtin_amdgcn_s_setprio(1); _Pragma("unroll") for (int m = 0; m < 4; ++m) _Pragma("unroll") for (int n = 0; n < 2; ++n) \
        acc[ai][bj][m][n] = __builtin_amdgcn_mfma_scale_f32_16x16x128_f8f6f4(PG8_CAT8(Bt[n]), PG8_CAT8(At[m]), acc[ai][bj][m][n], 0, 0, 0, 0, 0, 0  ); __builtin_amdgcn_s_setprio(0); } while (0)
#define PG8_LDB(dst, b, h) do { _Pragma("unroll") for (int n = 0; n < 2; ++n) _Pragma("unroll") for (int k = 0; k < 2; ++k) dst[n][k] = *(const PG8_LAS bf16x8*)(lds + PG8_SB(b, h) + boff + n * 2048 + k * 1024); } while (0)
#define PG8_MMA(ai, bj, At, Bt) do { __builtin_amdgcn_s_setprio(1); _Pragma("unroll") for (int m = 0; m < 4; ++m) _Pragma("unroll") for (int n = 0; n < 2; ++n) _Pragma("unroll") for (int k = 0; k < 2; ++k) \
        acc[ai][bj][m][n] = __builtin_amdgcn_mfma_f32_16x16x32_bf16(Bt[n][k], At[m][k], acc[ai][bj][m][n], 0, 0, 0); __builtin_amdgcn_s_setprio(0); } while (0)
#define PG8_WAIT_V(n) asm volatile("s_waitcnt vmcnt(" #n ")" ::: "memory")
#define PG8_WAIT_L(n) asm volatile("s_waitcnt lgkmcnt(" #n ")" ::: "memory")
#define PG8_BAR __builtin_amdgcn_s_barrier()
#define PG8_SCHED __builtin_amdgcn_sched_barrier(0)
#define PG8_ZERO_ACC() do { _Pragma("unroll") for (int a = 0; a < 2; ++a) _Pragma("unroll") for (int b = 0; b < 2; ++b) _Pragma("unroll") for (int m = 0; m < 4; ++m) _Pragma("unroll") for (int n = 0; n < 2; ++n) acc[a][b][m][n] = (f32x4){0.f, 0.f, 0.f, 0.f}; } while (0)
    f32x4 acc[2][2][4][2];
    PG8_ZERO_ACC();
    bf16x8 At[4][2], B0[2][2], B1[2][2];
    unsigned gk[32];
    const char* gA = (const char*)H + (size_t)pm * 2 * hsA0; const char* yA0 = (const char*)YS + (size_t)pm * 2 * hsA1;
    const char* gB0 = (const char*)WG + (size_t)pn * 2 * hsB0; const char* yB0 = (const char*)WB + (size_t)pn * 2 * hsB1;
    const char* cA = gA; const char* cB = gB0;
    PG8_STAGE(PG8_SB(0, 0), cB, voffB0, hsB0); PG8_STAGE(PG8_SA(0, 0), cA, voffA0, hsA0); PG8_STAGE(PG8_SB(0, 1), cB + hsB0, voffB0, hsB0); PG8_STAGE(PG8_SA(0, 1), cA + hsA0, voffA0, hsA0);
    if (wr == 1) PG8_BAR;
    PG8_WAIT_V(4); PG8_BAR;
    PG8_STAGE(PG8_SB(1, 0), cB + kstep, voffB0, hsB0); PG8_STAGE(PG8_SA(1, 0), cA + kstep, voffA0, hsA0); PG8_STAGE(PG8_SB(1, 1), cB + hsB0 + kstep, voffB0, hsB0);
    PG8_WAIT_V(6); PG8_BAR;
#pragma unroll 1
    for (int pz = 0; pz < 5; ++pz) {
        Unit cur; cur.pm = pm; cur.pn = pn; cur.pz = pz;
        {
            const char* nA = yA0 + (size_t)pz * 512 * 2; const char* nB = yB0 + (size_t)pz * 1024 * 512 * 2;
            int fr1 = fr, fq1 = fq; asm volatile("" : "+v"(fr1), "+v"(fq1));
            const int aoff8 = lds_byte(wr * 64 + fr1, fq1 * 16), boff8 = lds_byte(wc * 32 + fr1, fq1 * 16);
            PG8_KLOOPX(NT0, voffA0, voffB0, hsA0, hsB0, voffA1, voffB1, hsA1, hsB1, PG8_LDA8, PG8_LDB8, PG8_MMA8)
            EG(acc, gk);
            PG8_ZERO_ACC();
            cA = nA; cB = nB;
        }
        {
            const char* nA = gA; const char* nB = gB0 + (size_t)(pz < 4 ? pz + 1 : 0) * 1024 * 1024;
            int fr1 = fr, fq1 = fq; asm volatile("" : "+v"(fr1), "+v"(fq1));
            const int aoff = lds_byte(wr * 64 + fr1, fq1 * 8), boff = lds_byte(wc * 32 + fr1, fq1 * 8);
            PG8_KLOOPX(NT1, voffA1, voffB1, hsA1, hsB1, voffA0, voffB0, hsA0, hsB0, PG8_LDA, PG8_LDB, PG8_MMA)
            { int fr2 = fr, fq2 = fq; asm volatile("" : "+v"(fr2), "+v"(fq2)); EY(acc, gk, cur, wr, wc, fr2, fq2); }
            PG8_ZERO_ACC();
            cA = nA; cB = nB;
        }
    }
    PG8_WAIT_V(0);
    if (wr == 0) PG8_BAR;
    PG8_BAR;
#undef PG8_ZERO_ACC
#undef PG8_LDA8
#undef PG8_LDB8
#undef PG8_CAT8
#undef PG8_MMA8
#undef PG8_SA
#undef PG8_SB
#undef PG8_STAGE
#undef PG8_LDA
#undef PG8_LDB
#undef PG8_MMA
#undef PG8_WAIT_V
#undef PG8_WAIT_L
#undef PG8_BAR
#undef PG8_SCHED
}
#undef PG8_KLOOPX
}


namespace hk {
typedef pg8::bf16_t bf16_t;
typedef pg8::bf16x8 bf16x8;
typedef pg8::f32x4 f32x4;
typedef pg8::u32x4 u32x4;
typedef unsigned u32x2 __attribute__((ext_vector_type(2)));
typedef float f32x2 __attribute__((ext_vector_type(2)));
typedef __fp16 h2_t __attribute__((ext_vector_type(2)));

constexpr int BATCH = 8, SEQ = 4096, DM = 1024, DEPTH = 2, MEMLEN = 256, BW = 512;
constexpr int T_ALL = BATCH * SEQ;
constexpr int GB = 4;
constexpr int NGRP = BATCH / GB;
constexpr int TG = GB * SEQ;
constexpr int IN_COLS = 7896;
constexpr int PW = 7936;
constexpr int C_AQ = 0, C_AK = 512, C_AV = 1024, C_AG = 1536;
constexpr int C_BU = 2048, C_BV = 2560, C_BG = 3072;
constexpr int C_CQ = 3584, C_CIQ = 4096, C_CG = 4608, C_CK = 5120, C_CV = 5184, C_CIK = 5248, C_CIW = 5312, C_AA = 5320, C_AB = 5324, C_DDT = 5328;
constexpr int C_DZ = 5376, C_DX = 5888, C_DB = 6400, C_DC = 6656;
constexpr int C_MQ = 6912, C_MG = 7424;
constexpr int YW = 5 * BW;
constexpr int GW = 5 * DM;

constexpr size_t WS_CTL  = 0;
constexpr size_t CTL_BYTES = 65536;
constexpr size_t WS_WIN  = WS_CTL + CTL_BYTES;
constexpr size_t WS_WG   = WS_WIN + (size_t)PW * DM * 2;
constexpr size_t WS_WB   = WS_WG + (size_t)GW * DM * 2;
constexpr size_t WS_WO   = WS_WB + (size_t)5 * DM * BW * 2;
constexpr size_t WS_WKV  = WS_WO + (size_t)DM * DM * 2;
constexpr size_t WS_MEMN = WS_WKV + (size_t)DM * DM * 2;
constexpr size_t WS_KV   = WS_MEMN + (size_t)BATCH * MEMLEN * DM * 2;
constexpr size_t WS_H    = WS_KV + (size_t)BATCH * MEMLEN * DM * 2;
constexpr size_t WS_P    = WS_H + (size_t)TG * DM * 2;
constexpr size_t WS_YS   = WS_P + (size_t)TG * PW * 2;
constexpr size_t WS_GDN  = WS_YS + (size_t)TG * YW * 2;
constexpr size_t GDN_CH_BYTES = 73728;
constexpr size_t WS_SSD  = WS_GDN + (size_t)GB * 64 * 4 * GDN_CH_BYTES;
constexpr size_t WS_MASK = WS_SSD + (size_t)GB * 32 * 8 * 64 * 128 * 2;
constexpr size_t WS_DKN  = WS_MASK + (size_t)GB * SEQ * (SEQ / 8);
constexpr size_t WS_DVT  = WS_DKN + (size_t)GB * SEQ * 64 * 2;
constexpr size_t WS_SSDQ = WS_DVT + (size_t)GB * SEQ * 64 * 2;
constexpr size_t WS_SMALL= WS_SSDQ + (size_t)GB * 8 * 8 * 64 * 128 * 2;
constexpr size_t SMALL_BYTES = 1 << 20;
constexpr size_t WS_VN   = WS_SMALL + SMALL_BYTES;
constexpr size_t WS_END  = WS_VN + (size_t)GB * SEQ * 64 * 2;
constexpr int QSPLIT = 2048;
static_assert(WS_END <= (size_t)536870912, "workspace map exceeds 512 MiB");
constexpr int SM_GDN_CD = 0;
constexpr int SM_SSD_CD = 4096;
constexpr int SM_SSD_RS = 65536;
constexpr int SM_SSD_CS = 8192;
constexpr int SM_SSD_DT = 8192 + GB * SEQ * 8;

constexpr int LDS_BYTES = 147456;
constexpr int LDS_MISC = 143360;
constexpr int LDS_WORK = 143360;

#define LAS __attribute__((address_space(3)))
typedef LAS unsigned char* ldsp_t;

struct Params {
    const float* in[27];
    float* out;
    unsigned char* ws;
    float one; int pad;
};

__device__ __forceinline__ float bf2f(unsigned v) { return __uint_as_float(v << 16); }
__device__ __forceinline__ float bflo(unsigned v) { return __uint_as_float(v << 16); }
__device__ __forceinline__ float bfhi(unsigned v) { return __uint_as_float(v & 0xffff0000u); }
typedef __bf16 bf16x2_t __attribute__((ext_vector_type(2)));
__device__ __forceinline__ unsigned pk2m(float lo, float hi) { const f32x2 v = {lo, hi}; return __builtin_bit_cast(unsigned, __builtin_convertvector(v, bf16x2_t)); }
__device__ __forceinline__ unsigned pk2(float lo, float hi) { unsigned r; asm volatile("s_nop 1\n\tv_cvt_pk_bf16_f32 %0, %1, %2" : "=v"(r) : "v"(lo), "v"(hi)); return r; }
__device__ __forceinline__ bf16_t f2bf(float x) { return (bf16_t)(pk2(x, 0.f) & 0xffffu); }
__device__ __forceinline__ bf16_t f2bfm(float x) { return (bf16_t)(pk2m(x, 0.f) & 0xffffu); }
__device__ __forceinline__ float shx(float v, int m, int lane) { return __builtin_bit_cast(float, __builtin_amdgcn_ds_bpermute((lane ^ m) << 2, __builtin_bit_cast(int, v))); }
__device__ __forceinline__ unsigned shxu(unsigned v, int m, int lane) { return (unsigned)__builtin_amdgcn_ds_bpermute((lane ^ m) << 2, (int)v); }
__device__ __forceinline__ float wave_sum(float v, int lane) {
#pragma unroll
    for (int o = 1; o < 64; o <<= 1) v += shx(v, o, lane);
    return v;
}
__device__ __forceinline__ float frcp(float x) { return __builtin_amdgcn_rcpf(x); }
__device__ __forceinline__ float fsigmoid(float x) { return frcp(1.0f + __builtin_amdgcn_exp2f(-1.4426950408889634f * x)); }
__device__ __forceinline__ float fsilu(float x) { return x * frcp(1.0f + __builtin_amdgcn_exp2f(-1.4426950408889634f * x)); }
__device__ __forceinline__ float fsoftplus(float x) { return x > 20.f ? x : log1pf(__expf(x)); }
__device__ __forceinline__ float fgelu_tanh(float x) {
    const float u = 0.7978845608028654f * (x + 0.044715f * x * x * x);
    const float e = __builtin_amdgcn_exp2f(2.8853900817779268f * u);
    const float th = 1.0f - 2.0f * frcp(e + 1.0f);
    return 0.5f * x * (1.0f + th);
}
#define LDS_WAIT() asm volatile("s_waitcnt lgkmcnt(0)" ::: "memory")
#define VM_WAIT() asm volatile("s_waitcnt vmcnt(0)" ::: "memory")

__device__ __forceinline__ f32x4 mma16(bf16x8 a, bf16x8 b, f32x4 c) { return __builtin_amdgcn_mfma_f32_16x16x32_bf16(a, b, c, 0, 0, 0); }
__device__ __forceinline__ bf16x8 pack_frag(f32x4 d0, f32x4 d1) {
    u32x4 w; w.x = pk2m(d0[0], d0[1]); w.y = pk2m(d0[2], d0[3]); w.z = pk2m(d1[0], d1[1]); w.w = pk2m(d1[2], d1[3]);
    return __builtin_bit_cast(bf16x8, w);
}
__device__ __forceinline__ bf16x8 ld_frag_perm_g(const bf16_t* row, int s, int q) {
    const u32x2 lo = *(const u32x2*)(row + 32 * s + 4 * q), hi = *(const u32x2*)(row + 32 * s + 16 + 4 * q);
    u32x4 w; w.x = lo.x; w.y = lo.y; w.z = hi.x; w.w = hi.y; return __builtin_bit_cast(bf16x8, w);
}
__device__ __forceinline__ bf16x8 ld_frag_perm_l(const LAS bf16_t* row, int s, int q) {
    const u32x2 lo = *(const LAS u32x2*)(row + 32 * s + 4 * q), hi = *(const LAS u32x2*)(row + 32 * s + 16 + 4 * q);
    u32x4 w; w.x = lo.x; w.y = lo.y; w.z = hi.x; w.w = hi.y; return __builtin_bit_cast(bf16x8, w);
}
__device__ __forceinline__ bf16x8 ld_frag_g(const bf16_t* row, int s, int q) { return *(const bf16x8*)(row + 32 * s + 8 * q); }
__device__ __forceinline__ bf16x8 ld_frag_l(const LAS bf16_t* row, int s, int q) { return *(const LAS bf16x8*)(row + 32 * s + 8 * q); }

struct Ctx {
    ldsp_t lds; int bid, wv;
    static constexpr int G = 256;
    const Params* p;
};
#define PHASE_TID() int tid_o; asm volatile("v_mbcnt_lo_u32_b32 %0, -1, 0\n\tv_mbcnt_hi_u32_b32 %0, -1, %0" : "=v"(tid_o)); tid_o += c.wv * 64;      const int tid = tid_o, lane = tid & 63, wave = __builtin_amdgcn_readfirstlane(tid >> 6); (void)lane; (void)wave

template <int ACT  > struct EpiStoreBf16 {
    static constexpr bool PERM = true, AFTER_DRAIN = false;
    bf16_t* O; int ldc; float one;
    __device__ __forceinline__ void operator()(const f32x4 (&acc)[2][2][4][2], const pg8::Unit& u, int wr, int wc, int fr, int fq) const {
        const int row0 = u.pm * 256 + wr * 64 + fr, col0 = u.pn * 256 + wc * 32 + 8 * fq;
#pragma unroll
        for (int ai = 0; ai < 2; ++ai)
#pragma unroll
            for (int m = 0; m < 4; ++m) { bf16_t* rowp = O + (size_t)(row0 + ai * 128 + m * 16) * ldc + col0;
#pragma unroll
                for (int bj = 0; bj < 2; ++bj) { f32x4 v0 = acc[ai][bj][m][0], v1 = acc[ai][bj][m][1];
                    if (ACT == 1) {
#pragma unroll
                        for (int j = 0; j < 4; ++j) { v0[j] = fsigmoid(v0[j]); v1[j] = fsigmoid(v1[j]); } }
                    v0 = v0 * one; v1 = v1 * one;
                    u32x4 w; w.x = pk2(v0[0], v0[1]); w.y = pk2(v0[2], v0[3]); w.z = pk2(v1[0], v1[1]); w.w = pk2(v1[2], v1[3]);
                    *(u32x4*)(rowp + bj * 128) = w; } }
    }
};
struct EpiMerge {
    static constexpr bool PERM = true, AFTER_DRAIN = false;
    const bf16_t* Gs; bf16_t* Mg; const float* RS;
    __device__ __forceinline__ void operator()(const f32x4 (&acc)[2][2][4][2], const pg8::Unit& u, int wr, int wc, int fr, int fq) const {
        const int row0 = u.pm * 256 + wr * 64 + fr, col0 = u.pn * 256 + wc * 32 + 8 * fq, pz = u.pz;
#pragma unroll
        for (int ai = 0; ai < 2; ++ai) {
            u32x4 g[4][2], pv[4][2]; float rs[4];
#pragma unroll
            for (int m = 0; m < 4; ++m) { const size_t row = (size_t)(row0 + ai * 128 + m * 16);
                rs[m] = RS[row];
#pragma unroll
                for (int bj = 0; bj < 2; ++bj) { g[m][bj] = *(const u32x4*)(Gs + row * GW + pz * DM + col0 + bj * 128);
                    pv[m][bj] = *(const u32x4*)(Mg + row * DM + col0 + bj * 128); } }
            asm volatile("" ::: "memory");
#pragma unroll
            for (int m = 0; m < 4; ++m) { const size_t row = (size_t)(row0 + ai * 128 + m * 16); const float rsm = pz == 3 ? rs[m] : 1.0f;
#pragma unroll
                for (int bj = 0; bj < 2; ++bj) { u32x4 p4 = pv[m][bj]; if (pz == 0) p4 = (u32x4){0u, 0u, 0u, 0u};
                    const u32x4 g4 = g[m][bj]; const f32x4 v0 = acc[ai][bj][m][0] * rsm, v1 = acc[ai][bj][m][1] * rsm;
                    u32x4 w;
                    w.x = pk2(bflo(p4.x) + bflo(g4.x) * v0[0], bfhi(p4.x) + bfhi(g4.x) * v0[1]);
                    w.y = pk2(bflo(p4.y) + bflo(g4.y) * v0[2], bfhi(p4.y) + bfhi(g4.y) * v0[3]);
                    w.z = pk2(bflo(p4.z) + bflo(g4.z) * v1[0], bfhi(p4.z) + bfhi(g4.z) * v1[1]);
                    w.w = pk2(bflo(p4.w) + bflo(g4.w) * v1[2], bfhi(p4.w) + bfhi(g4.w) * v1[3]);
                    *(u32x4*)(Mg + row * DM + col0 + bj * 128) = w; } }
            asm volatile("" ::: "memory");
        }
    }
};
struct OneUnit {
    int pm, pn, pz;
    __device__ __forceinline__ bool next(int i, pg8::Unit& u) const { if (i > 0) return false; u.pm = pm; u.pn = pn; u.pz = pz; return true; }
    __device__ __forceinline__ void a_ready(const pg8::Unit&) const {}
    __device__ __forceinline__ void done(const pg8::Unit&) const {}
};
struct EpiGateTile {
    static constexpr bool PERM = true, AFTER_DRAIN = false;
    __device__ __forceinline__ void operator()(const f32x4 (&acc)[2][2][4][2], unsigned (&gk)[32]) const {
#pragma unroll
        for (int ai = 0; ai < 2; ++ai)
#pragma unroll
            for (int bj = 0; bj < 2; ++bj)
#pragma unroll
                for (int m = 0; m < 4; ++m)
#pragma unroll
                    for (int n = 0; n < 2; ++n) { const f32x4 v = acc[ai][bj][m][n]; unsigned q[4];
#pragma unroll
                        for (int j = 0; j < 4; ++j) q[j] = (unsigned)(fsigmoid(v[j] * 0.03125f) * 255.0f + 0.5f);
                        unsigned w = q[0] | (q[1] << 8) | (q[2] << 16) | (q[3] << 24); asm volatile("" : "+v"(w));
                        gk[(ai * 2 + bj) * 8 + m * 2 + n] = w; }
    }
};
struct EpiMergeTile {
    static constexpr bool PERM = true, AFTER_DRAIN = false;
    bf16_t* Mg; const float* RS;
    __device__ __forceinline__ void operator()(const f32x4 (&acc)[2][2][4][2], const unsigned (&gk)[32], const pg8::Unit& u, int wr, int wc, int fr, int fq) const {
        const int lr0 = wr * 64 + fr, lc0 = wc * 32 + 8 * fq, row0 = u.pm * 256 + lr0, col0 = u.pn * 256 + lc0, pz = u.pz;
#pragma unroll
        for (int ai = 0; ai < 2; ++ai) {
            u32x4 pv[4][2]; float rs[4];
#pragma unroll
            for (int m = 0; m < 4; ++m) { const size_t row = (size_t)(row0 + ai * 128 + m * 16);
                rs[m] = pz == 3 ? RS[row] * (1.0f / 255.0f) : (1.0f / 255.0f);
#pragma unroll
                for (int bj = 0; bj < 2; ++bj) pv[m][bj] = pz != 0 ? *(const u32x4*)(Mg + row * DM + col0 + bj * 128) : (u32x4){0u, 0u, 0u, 0u}; }
            asm volatile("" ::: "memory");
#pragma unroll
            for (int m = 0; m < 4; ++m) { const size_t row = (size_t)(row0 + ai * 128 + m * 16); const float rsm = rs[m];
#pragma unroll
                for (int bj = 0; bj < 2; ++bj) { const u32x4 p4 = pv[m][bj];
                    const unsigned g0 = gk[(ai * 2 + bj) * 8 + m * 2], g1 = gk[(ai * 2 + bj) * 8 + m * 2 + 1]; const f32x4 v0 = acc[ai][bj][m][0] * rsm, v1 = acc[ai][bj][m][1] * rsm;
                    u32x4 w;
                    w.x = pk2(bflo(p4.x) + (float)(g0 & 255u) * v0[0], bfhi(p4.x) + (float)((g0 >> 8) & 255u) * v0[1]);
                    w.y = pk2(bflo(p4.y) + (float)((g0 >> 16) & 255u) * v0[2], bfhi(p4.y) + (float)(g0 >> 24) * v0[3]);
                    w.z = pk2(bflo(p4.z) + (float)(g1 & 255u) * v1[0], bfhi(p4.z) + (float)((g1 >> 8) & 255u) * v1[1]);
                    w.w = pk2(bflo(p4.w) + (float)((g1 >> 16) & 255u) * v1[2], bfhi(p4.w) + (float)(g1 >> 24) * v1[3]);
                    *(u32x4*)(Mg + row * DM + col0 + bj * 128) = w; } }
            asm volatile("" ::: "memory");
        }
    }
};
struct EpiResid {
    static constexpr bool PERM = false, AFTER_DRAIN = false;
    const float* xin; float* out;
    __device__ __forceinline__ void operator()(const f32x4 (&acc)[2][2][4][2], const pg8::Unit& u, int wr, int wc, int fr, int fq) const {
        const int row0 = u.pm * 256 + wr * 64 + fr, col0 = u.pn * 256 + wc * 32 + 4 * fq;
#pragma unroll
        for (int ai = 0; ai < 2; ++ai)
#pragma unroll
            for (int mh = 0; mh < 2; ++mh) {
                f32x4 xv[2][2][2];
#pragma unroll
                for (int m2 = 0; m2 < 2; ++m2) { const size_t off = (size_t)(row0 + ai * 128 + (mh * 2 + m2) * 16) * DM + col0;
#pragma unroll
                    for (int bj = 0; bj < 2; ++bj)
#pragma unroll
                        for (int n = 0; n < 2; ++n) xv[m2][bj][n] = *(const f32x4*)(xin + off + bj * 128 + n * 16); }
                asm volatile("" ::: "memory");
#pragma unroll
                for (int m2 = 0; m2 < 2; ++m2) { const int m = mh * 2 + m2; const size_t off = (size_t)(row0 + ai * 128 + m * 16) * DM + col0;
#pragma unroll
                    for (int bj = 0; bj < 2; ++bj)
#pragma unroll
                        for (int n = 0; n < 2; ++n) *(f32x4*)(out + off + bj * 128 + n * 16) = xv[m2][bj][n] + acc[ai][bj][m][n]; }
                asm volatile("" ::: "memory");
            }
    }
};
struct MergeOrder {
    int G, c, ntile;
    __device__ __forceinline__ bool next(int i, pg8::Unit& u) const { const int tile = c + (i / 5) * G; if (tile >= ntile) return false; u.pm = tile >> 2; u.pn = tile & 3; u.pz = i % 5; return true; }
    __device__ __forceinline__ void a_ready(const pg8::Unit&) const {}
    __device__ __forceinline__ void done(const pg8::Unit&) const {}
};

__device__ __forceinline__ int win_src_col(int j) {
    if (j < 1536) return j;
    if (j < 2048) return 1544 + (j - 1536);
    if (j < 3584) return j + 8;
    if (j < 4096) return 3592 + (j - 3584);
    if (j < 4608) return 4232 + (j - 4096);
    if (j < 5120) return 4816 + (j - 4608);
    if (j < 5184) return 4104 + (j - 5120);
    if (j < 5248) return 4168 + (j - 5184);
    if (j < 5312) return 4744 + (j - 5248);
    if (j < 5320) return 4808 + (j - 5312);
    if (j < 5324) return 1536 + (j - 5320);
    if (j < 5328) return 1540 + (j - 5324);
    if (j < 5336) return 6864 + (j - 5328);
    if (j < 5376) return -1;
    if (j < 5888) return 5328 + (j - 5376);
    if (j < 6912) return 5840 + (j - 5888);
    if (j < 7424) return 6872 + (j - 6912);
    return 7384 + (j - 7424);
}
template <bool REMAP, bool SCALE>
__device__ __forceinline__ void tr_item(const float* W, int ldsrc, const float* scale, bf16_t* WT, int K, int k0, int n0, LAS float* scr, int lane) {
    const int n4 = (lane & 7) * 4;
    const int sc = REMAP ? win_src_col(n0 + n4) : (n0 + n4);
    f32x4 v8[8]; float s8[8];
#pragma unroll
    for (int i = 0; i < 8; ++i) { const int kk = 8 * i + (lane >> 3);
        v8[i] = (f32x4){0.f, 0.f, 0.f, 0.f};
        if (sc >= 0) v8[i] = *(const f32x4*)(W + (size_t)(k0 + kk) * ldsrc + sc);
        s8[i] = SCALE ? scale[k0 + kk] : 1.0f; }
#pragma unroll
    for (int i = 0; i < 8; ++i) { const int kk = 8 * i + (lane >> 3); const f32x4 v = SCALE ? v8[i] * s8[i] : v8[i];
        scr[kk * 33 + n4] = v[0]; scr[kk * 33 + n4 + 1] = v[1]; scr[kk * 33 + n4 + 2] = v[2]; scr[kk * 33 + n4 + 3] = v[3]; }
    LDS_WAIT();
    const int c = lane & 7;
#pragma unroll
    for (int j = 0; j < 4; ++j) { const int nn = (lane >> 3) + 8 * j; const LAS float* s = scr + (8 * c) * 33 + nn;
        u32x4 o; o.x = pk2(s[0 * 33], s[1 * 33]); o.y = pk2(s[2 * 33], s[3 * 33]); o.z = pk2(s[4 * 33], s[5 * 33]); o.w = pk2(s[6 * 33], s[7 * 33]);
        *(u32x4*)(WT + (size_t)(n0 + nn) * K + k0 + 8 * c) = o; }
    LDS_WAIT();
}
__device__ __forceinline__ unsigned pk4_fp8(float a, float b, float c, float d) {
    a = fminf(fmaxf(a, -448.f), 448.f); b = fminf(fmaxf(b, -448.f), 448.f); c = fminf(fmaxf(c, -448.f), 448.f); d = fminf(fmaxf(d, -448.f), 448.f);
    unsigned w = 0u; w = (unsigned)__builtin_amdgcn_cvt_pk_fp8_f32(a, b, (int)w, false); w = (unsigned)__builtin_amdgcn_cvt_pk_fp8_f32(c, d, (int)w, true); return w;
}
__device__ __forceinline__ void tr_item8(const float* W, int ldsrc, const float* scale, float mul, unsigned char* WT8, int K, int k0, int n0, LAS float* scr, int lane) {
    const int n4 = (lane & 7) * 4;
    f32x4 v8[8]; float s8[8];
#pragma unroll
    for (int i = 0; i < 8; ++i) { const int kk = 8 * i + (lane >> 3); v8[i] = *(const f32x4*)(W + (size_t)(k0 + kk) * ldsrc + n0 + n4); s8[i] = scale[k0 + kk] * mul; }
#pragma unroll
    for (int i = 0; i < 8; ++i) { const int kk = 8 * i + (lane >> 3); const f32x4 v = v8[i] * s8[i];
        scr[kk * 33 + n4] = v[0]; scr[kk * 33 + n4 + 1] = v[1]; scr[kk * 33 + n4 + 2] = v[2]; scr[kk * 33 + n4 + 3] = v[3]; }
    LDS_WAIT();
    const int c = lane & 7;
#pragma unroll
    for (int j = 0; j < 4; ++j) { const int nn = (lane >> 3) + 8 * j; const LAS float* s = scr + (8 * c) * 33 + nn;
        u32x2 o; o.x = pk4_fp8(s[0 * 33], s[1 * 33], s[2 * 33], s[3 * 33]); o.y = pk4_fp8(s[4 * 33], s[5 * 33], s[6 * 33], s[7 * 33]);
        *(u32x2*)(WT8 + (size_t)(n0 + nn) * K + k0 + 8 * c) = o; }
    LDS_WAIT();
}
__device__ __forceinline__ void rms_row_to_bf16(const float* xrow, bf16_t* orow, int lane) {
    const f32x4* xr = (const f32x4*)xrow + lane;
    f32x4 v[4]; float s = 0.f;
#pragma unroll
    for (int j = 0; j < 4; ++j) { v[j] = xr[64 * j]; s += (v[j].x * v[j].x + v[j].y * v[j].y) + (v[j].z * v[j].z + v[j].w * v[j].w); }
    const float rstd = rsqrtf(wave_sum(s, lane) * (1.f / DM) + 1e-6f);
    unsigned long long* o8 = (unsigned long long*)orow + lane;
#pragma unroll
    for (int j = 0; j < 4; ++j) o8[64 * j] = (unsigned long long)pk2(v[j].x * rstd, v[j].y * rstd) | ((unsigned long long)pk2(v[j].z * rstd, v[j].w * rstd) << 32);
}
__device__ __forceinline__ void phase_convert(const Ctx& c, int layer) {
    PHASE_TID();
    const Params& p = *c.p;
    LAS float* scr = (LAS float*)(c.lds + wave * 8704);
    const int gw = c.bid * 8 + wave, NGW = c.G * 8;
    bf16_t* WIN = (bf16_t*)(p.ws + WS_WIN); bf16_t* WG = (bf16_t*)(p.ws + WS_WG); bf16_t* WB = (bf16_t*)(p.ws + WS_WB); bf16_t* WO = (bf16_t*)(p.ws + WS_WO); bf16_t* WKV = (bf16_t*)(p.ws + WS_WKV);
    const float* norm_g = p.in[2] + layer * DM;
    for (int r = gw; r < 16 * (PW / 32); r += NGW) { const int kb = r / (PW / 32), nb = r % (PW / 32);
        tr_item<true, true>(p.in[3] + (size_t)layer * DM * IN_COLS, IN_COLS, norm_g, WIN, DM, kb * 64, nb * 32, scr, lane); }
    for (int r = gw; r < 5 * 512; r += NGW) { const int pz = r / 512, q = r % 512, kb = q / 32, nb = q % 32;
#ifndef NO_TR8
        tr_item8(p.in[24] + (size_t)(layer * 5 + pz) * DM * DM, DM, norm_g, 32.0f, (unsigned char*)WG + (size_t)pz * DM * DM, DM, kb * 64, nb * 32, scr, lane); }
#else
        }
#endif
    for (int r = gw; r < 4 * 256; r += NGW) { const int pi = r / 256, pz = pi < 3 ? pi : 4, q = r % 256, kb = q / 32, nb = q % 32;
        tr_item<false, false>(p.in[25] + (size_t)(layer * 5 + pz) * BW * DM, DM, nullptr, WB + (size_t)pz * DM * BW, BW, kb * 64, nb * 32, scr, lane); }
    for (int r = gw; r < 256; r += NGW) { const int kb = r / 32, nb = r % 32;
        tr_item<false, true>(p.in[25] + (size_t)(layer * 5 + 3) * BW * DM, DM, p.in[19] + layer * BW, WB + (size_t)3 * DM * BW, BW, kb * 64, nb * 32, scr, lane); }
    for (int r = gw; r < 512; r += NGW) { const int kb = r / 32, nb = r % 32;
        tr_item<false, false>(p.in[26] + (size_t)layer * DM * DM, DM, nullptr, WO, DM, kb * 64, nb * 32, scr, lane); }
    for (int r = gw; r < 512; r += NGW) { const int kb = r / 32, nb = r % 32;
        tr_item<false, true>(p.in[21] + (size_t)layer * DM * DM, DM, p.in[20] + layer * DM, WKV, DM, kb * 64, nb * 32, scr, lane); }
    if (layer == 0) {
        bf16_t* MEMN = (bf16_t*)(p.ws + WS_MEMN);
        for (int r = gw; r < BATCH * MEMLEN; r += NGW) rms_row_to_bf16(p.in[1] + (size_t)r * DM, MEMN + (size_t)r * DM, lane);
    }
}
__device__ __forceinline__ void phase_norm(const Ctx& c, const float* xin  ) {
    PHASE_TID();
    bf16_t* H = (bf16_t*)(c.p->ws + WS_H);
    const int gw = c.bid * 8 + wave, NGW = c.G * 8;
    for (int r = gw; r < TG; r += 4 * NGW) {
        f32x4 v[4][4]; float s[4];
#pragma unroll
        for (int k = 0; k < 4; ++k) { const f32x4* xr = (const f32x4*)(xin + (size_t)(r + k * NGW) * DM) + lane;
#pragma unroll
            for (int j = 0; j < 4; ++j) v[k][j] = xr[64 * j]; }
        asm volatile("" ::: "memory");
#pragma unroll
        for (int k = 0; k < 4; ++k) { s[k] = 0.f;
#pragma unroll
            for (int j = 0; j < 4; ++j) s[k] += (v[k][j].x * v[k][j].x + v[k][j].y * v[k][j].y) + (v[k][j].z * v[k][j].z + v[k][j].w * v[k][j].w); }
#pragma unroll
        for (int k = 0; k < 4; ++k) s[k] = rsqrtf(wave_sum(s[k], lane) * (1.f / DM) + 1e-6f);
#pragma unroll
        for (int k = 0; k < 4; ++k) { unsigned long long* o8 = (unsigned long long*)(H + (size_t)(r + k * NGW) * DM) + lane; const float rstd = s[k];
#pragma unroll
            for (int j = 0; j < 4; ++j) o8[64 * j] = (unsigned long long)pk2(v[k][j].x * rstd, v[k][j].y * rstd) | ((unsigned long long)pk2(v[k][j].z * rstd, v[k][j].w * rstd) << 32); }
        asm volatile("" ::: "memory");
    }
}

__device__ __forceinline__ void h8_rows(const Ctx& c) {
    PHASE_TID();
    const bf16_t* H = (const bf16_t*)(c.p->ws + WS_H); unsigned char* P8 = c.p->ws + WS_P;
    for (int r = c.bid * 8 + wave; r < TG; r += c.G * 16) {
        u32x4 a[2][2];
#pragma unroll
        for (int k = 0; k < 2; ++k) { const size_t rr = (size_t)(r + k * c.G * 8); a[k][0] = *(const u32x4*)(H + rr * DM + lane * 16); a[k][1] = *(const u32x4*)(H + rr * DM + lane * 16 + 8); }
        asm volatile("" ::: "memory");
#pragma unroll
        for (int k = 0; k < 2; ++k) { const size_t rr = (size_t)(r + k * c.G * 8); const u32x4 x = a[k][0], y = a[k][1]; u32x4 o;
            o.x = pk4_fp8(bflo(x.x), bfhi(x.x), bflo(x.y), bfhi(x.y)); o.y = pk4_fp8(bflo(x.z), bfhi(x.z), bflo(x.w), bfhi(x.w));
            o.z = pk4_fp8(bflo(y.x), bfhi(y.x), bflo(y.y), bfhi(y.y)); o.w = pk4_fp8(bflo(y.z), bfhi(y.z), bflo(y.w), bfhi(y.w));
            *(u32x4*)(P8 + rr * (size_t)(PW * 2) + lane * 16) = o; }
        asm volatile("" ::: "memory");
    }
}

__device__ __forceinline__ float sg_row16_sum(float v) {
    v += __builtin_bit_cast(float, __builtin_amdgcn_mov_dpp(__builtin_bit_cast(int, v), 0xB1, 0xF, 0xF, true));
    v += __builtin_bit_cast(float, __builtin_amdgcn_mov_dpp(__builtin_bit_cast(int, v), 0x4E, 0xF, 0xF, true));
    v += __builtin_bit_cast(float, __builtin_amdgcn_mov_dpp(__builtin_bit_cast(int, v), 0x141, 0xF, 0xF, true));
    v += __builtin_bit_cast(float, __builtin_amdgcn_mov_dpp(__builtin_bit_cast(int, v), 0x140, 0xF, 0xF, true));
    return v;
}
__device__ __forceinline__ void sg_unit(const Ctx& c, int layer, int lb, int n) {
    PHASE_TID();
    const Params& p = *c.p;
    const bf16_t* P = (const bf16_t*)(p.ws + WS_P); bf16_t* YS = (bf16_t*)(p.ws + WS_YS);
    const float* ln_g = p.in[8] + layer * BW; const float* ln_b = p.in[9] + layer * BW;
    const float* w_s = p.in[10] + (size_t)layer * 4 * 128 * 128; const float* b_s = p.in[11] + layer * 4 * 128;
    LAS float* st = (LAS float*)c.lds;
    LAS bf16_t* Wl = (LAS bf16_t*)(c.lds + 1024);
    LAS bf16_t* vT = (LAS bf16_t*)(c.lds + 1024 + 34816);
    const int r0 = lb * SEQ + n * 128, q = lane >> 4, l15 = lane & 15;
    __syncthreads();
#pragma unroll
    for (int ps = 0; ps < 4; ++ps) { const int t = wave * 16 + ps * 4 + q;
        const bf16_t* src = P + (size_t)(r0 + t) * PW + C_BV + l15 * 32;
        u32x4 raw[4];
#pragma unroll
        for (int j = 0; j < 4; ++j) raw[j] = *(const u32x4*)(src + 8 * j);
        float x[32]; float sm = 0.f;
#pragma unroll
        for (int j = 0; j < 4; ++j) { x[8 * j + 0] = bflo(raw[j].x); x[8 * j + 1] = bfhi(raw[j].x); x[8 * j + 2] = bflo(raw[j].y); x[8 * j + 3] = bfhi(raw[j].y);
            x[8 * j + 4] = bflo(raw[j].z); x[8 * j + 5] = bfhi(raw[j].z); x[8 * j + 6] = bflo(raw[j].w); x[8 * j + 7] = bfhi(raw[j].w); }
#pragma unroll
        for (int k = 0; k < 32; ++k) { x[k] = fgelu_tanh(x[k]); sm += x[k]; }
        const float mean = sg_row16_sum(sm) * (1.f / BW); float s2 = 0.f;
#pragma unroll
        for (int k = 0; k < 32; ++k) { const float d = x[k] - mean; s2 += d * d; }
        const float var = sg_row16_sum(s2) * (1.f / BW);
        if (l15 == 0) { st[t] = mean; st[128 + t] = rsqrtf(var + 1e-5f); }
    }
    for (int g = 0; g < 4; ++g) {
        __syncthreads();
        {
            const int t = tid >> 2, sb = (tid & 3) * 32; const float* src = w_s + (size_t)(g * 128 + t) * 128 + sb;
#pragma unroll
            for (int j = 0; j < 4; ++j) { const f32x4 a = *(const f32x4*)(src + 8 * j), b = *(const f32x4*)(src + 8 * j + 4); const int s0 = sb + 8 * j;
                u32x4 w; w.x = pk2(s0 + 0 <= t ? a[0] : 0.f, s0 + 1 <= t ? a[1] : 0.f); w.y = pk2(s0 + 2 <= t ? a[2] : 0.f, s0 + 3 <= t ? a[3] : 0.f);
                w.z = pk2(s0 + 4 <= t ? b[0] : 0.f, s0 + 5 <= t ? b[1] : 0.f); w.w = pk2(s0 + 6 <= t ? b[2] : 0.f, s0 + 7 <= t ? b[3] : 0.f);
                *(LAS u32x4*)(Wl + t * 136 + s0) = w; }
        }
#pragma unroll
        for (int j = 0; j < 4; ++j) { const int e = tid + 512 * j, s = e >> 4, cb = (e & 15) * 8;
            const u32x4 raw = *(const u32x4*)(P + (size_t)(r0 + s) * PW + C_BV + g * 128 + cb);
            float x[8]; x[0] = bflo(raw.x); x[1] = bfhi(raw.x); x[2] = bflo(raw.y); x[3] = bfhi(raw.y); x[4] = bflo(raw.z); x[5] = bfhi(raw.z); x[6] = bflo(raw.w); x[7] = bfhi(raw.w);
            const float mean = st[s], rstd = st[128 + s];
#pragma unroll
            for (int k = 0; k < 8; ++k) { const int ch = g * 128 + cb + k; const float y = (fgelu_tanh(x[k]) - mean) * rstd * ln_g[ch] + ln_b[ch]; vT[(cb + k) * 136 + s] = f2bf(y); } }
        __syncthreads();
        f32x4 acc[8];
#pragma unroll
        for (int ct = 0; ct < 8; ++ct) acc[ct] = (f32x4){0.f, 0.f, 0.f, 0.f};
        const int nks = (wave >> 1) + 1;
        for (int ks = 0; ks < nks; ++ks) {
            const bf16x8 bw = ld_frag_l(Wl + (wave * 16 + l15) * 136, ks, q);
#pragma unroll
            for (int ct = 0; ct < 8; ++ct) acc[ct] = mma16(ld_frag_l(vT + (ct * 16 + l15) * 136, ks, q), bw, acc[ct]);
        }
        const int t = wave * 16 + l15; const size_t row = (size_t)(r0 + t); const float bias = b_s[g * 128 + t];
        u32x2 ur[8], gr[8];
#pragma unroll
        for (int ct = 0; ct < 8; ++ct) { const int ch = g * 128 + ct * 16 + 4 * q; ur[ct] = *(const u32x2*)(P + row * PW + C_BU + ch); gr[ct] = *(const u32x2*)(P + row * PW + C_BG + ch); }
        asm volatile("" ::: "memory");
#pragma unroll
        for (int ct = 0; ct < 8; ++ct) { const int ch = g * 128 + ct * 16 + 4 * q;
            const float o0 = fgelu_tanh(bflo(ur[ct].x)) * (acc[ct][0] + bias) * fsilu(bflo(gr[ct].x)), o1 = fgelu_tanh(bfhi(ur[ct].x)) * (acc[ct][1] + bias) * fsilu(bfhi(gr[ct].x));
            const float o2 = fgelu_tanh(bflo(ur[ct].y)) * (acc[ct][2] + bias) * fsilu(bflo(gr[ct].y)), o3 = fgelu_tanh(bfhi(ur[ct].y)) * (acc[ct][3] + bias) * fsilu(bfhi(gr[ct].y));
            u32x2 w; w.x = pk2(o0, o1); w.y = pk2(o2, o3);
            *(u32x2*)(YS + row * YW + 1 * BW + ch) = w; }
        asm volatile("" ::: "memory");
    }
}

__device__ __forceinline__ void mem_unit(const Ctx& c, int layer, int grp, int lb, int head, int qc) {
    PHASE_TID();
    const Params& p = *c.p;
    const bf16_t* P = (const bf16_t*)(p.ws + WS_P); bf16_t* YS = (bf16_t*)(p.ws + WS_YS); const bf16_t* KV = (const bf16_t*)(p.ws + WS_KV);
    const float* qg = p.in[22] + layer * 128; const float* kg = p.in[23] + layer * 128;
    LAS bf16_t* Kn = (LAS bf16_t*)c.lds;
    LAS bf16_t* VT = (LAS bf16_t*)(c.lds + 69632);
    const int q = lane >> 4, l15 = lane & 15, gbatch = grp * GB + lb;
    __syncthreads();
#pragma unroll
    for (int j = 0; j < 8; ++j) { const int e = tid + 512 * j, m = e >> 4, pc = e & 15; const bf16_t* src = KV + (size_t)(gbatch * MEMLEN + m) * DM + head * 128 + pc * 8;
        const u32x4 kr = *(const u32x4*)src, vr = *(const u32x4*)(src + BW);
        float x[8]; x[0] = bflo(kr.x); x[1] = bfhi(kr.x); x[2] = bflo(kr.y); x[3] = bfhi(kr.y); x[4] = bflo(kr.z); x[5] = bfhi(kr.z); x[6] = bflo(kr.w); x[7] = bfhi(kr.w);
        float ss = 0.f;
#pragma unroll
        for (int k = 0; k < 8; ++k) ss += x[k] * x[k];
        ss += shx(ss, 1, lane); ss += shx(ss, 2, lane); ss += shx(ss, 4, lane); ss += shx(ss, 8, lane);
        const float rstd = rsqrtf(ss * (1.f / 128.f) + 1e-6f);
        u32x4 w; w.x = pk2(x[0] * rstd * kg[pc * 8 + 0], x[1] * rstd * kg[pc * 8 + 1]); w.y = pk2(x[2] * rstd * kg[pc * 8 + 2], x[3] * rstd * kg[pc * 8 + 3]);
        w.z = pk2(x[4] * rstd * kg[pc * 8 + 4], x[5] * rstd * kg[pc * 8 + 5]); w.w = pk2(x[6] * rstd * kg[pc * 8 + 6], x[7] * rstd * kg[pc * 8 + 7]);
        *(LAS u32x4*)(Kn + m * 136 + pc * 8) = w;
        VT[(pc * 8 + 0) * 264 + m] = (bf16_t)(vr.x & 0xffffu); VT[(pc * 8 + 1) * 264 + m] = (bf16_t)(vr.x >> 16);
        VT[(pc * 8 + 2) * 264 + m] = (bf16_t)(vr.y & 0xffffu); VT[(pc * 8 + 3) * 264 + m] = (bf16_t)(vr.y >> 16);
        VT[(pc * 8 + 4) * 264 + m] = (bf16_t)(vr.z & 0xffffu); VT[(pc * 8 + 5) * 264 + m] = (bf16_t)(vr.z >> 16);
        VT[(pc * 8 + 6) * 264 + m] = (bf16_t)(vr.w & 0xffffu); VT[(pc * 8 + 7) * 264 + m] = (bf16_t)(vr.w >> 16); }
    __syncthreads();
    const float qscale = 0.08838834764831845f * 1.4426950408889634f;
    for (int qt = 0; qt < 4; ++qt) {
        const size_t row = (size_t)(lb * SEQ + qc * 512 + qt * 128 + wave * 16 + l15);
        bf16x8 qf[4];
        { float x[4][8]; float ss = 0.f;
#pragma unroll
          for (int ks = 0; ks < 4; ++ks) { const u32x4 r = *(const u32x4*)(P + row * PW + C_MQ + head * 128 + 32 * ks + 8 * q);
              x[ks][0] = bflo(r.x); x[ks][1] = bfhi(r.x); x[ks][2] = bflo(r.y); x[ks][3] = bfhi(r.y); x[ks][4] = bflo(r.z); x[ks][5] = bfhi(r.z); x[ks][6] = bflo(r.w); x[ks][7] = bfhi(r.w);
#pragma unroll
              for (int k = 0; k < 8; ++k) ss += x[ks][k] * x[ks][k]; }
          ss += shx(ss, 16, lane); ss += shx(ss, 32, lane);
          const float rs = rsqrtf(ss * (1.f / 128.f) + 1e-6f) * qscale;
#pragma unroll
          for (int ks = 0; ks < 4; ++ks) { const float* gp = qg + 32 * ks + 8 * q; u32x4 w;
              w.x = pk2m(x[ks][0] * rs * gp[0], x[ks][1] * rs * gp[1]); w.y = pk2m(x[ks][2] * rs * gp[2], x[ks][3] * rs * gp[3]);
              w.z = pk2m(x[ks][4] * rs * gp[4], x[ks][5] * rs * gp[5]); w.w = pk2m(x[ks][6] * rs * gp[6], x[ks][7] * rs * gp[7]);
              qf[ks] = __builtin_bit_cast(bf16x8, w); } }
        f32x4 s[16];
#pragma unroll
        for (int kt = 0; kt < 16; ++kt) { s[kt] = (f32x4){0.f, 0.f, 0.f, 0.f};
#pragma unroll
            for (int ks = 0; ks < 4; ++ks) s[kt] = mma16(ld_frag_l(Kn + (kt * 16 + l15) * 136, ks, q), qf[ks], s[kt]); }
        float mx = -3.0e38f;
#pragma unroll
        for (int kt = 0; kt < 16; ++kt) mx = fmaxf(fmaxf(fmaxf(s[kt][0], s[kt][1]), fmaxf(s[kt][2], s[kt][3])), mx);
        mx = fmaxf(mx, shx(mx, 16, lane)); mx = fmaxf(mx, shx(mx, 32, lane));
        float sum = 0.f;
#pragma unroll
        for (int kt = 0; kt < 16; ++kt) {
#pragma unroll
            for (int i = 0; i < 4; ++i) { const float e = __builtin_amdgcn_exp2f(s[kt][i] - mx); s[kt][i] = e; sum += e; } }
        sum += shx(sum, 16, lane); sum += shx(sum, 32, lane);
        const float inv = frcp(sum);
        f32x4 o[8];
#pragma unroll
        for (int dt = 0; dt < 8; ++dt) o[dt] = (f32x4){0.f, 0.f, 0.f, 0.f};
#pragma unroll
        for (int ks = 0; ks < 8; ++ks) { const bf16x8 pf = pack_frag(s[2 * ks], s[2 * ks + 1]);
#pragma unroll
            for (int dt = 0; dt < 8; ++dt) o[dt] = mma16(ld_frag_perm_l(VT + (dt * 16 + l15) * 264, ks, q), pf, o[dt]); }
        u32x2 grm[8];
#pragma unroll
        for (int dt = 0; dt < 8; ++dt) grm[dt] = *(const u32x2*)(P + row * PW + C_MG + head * 128 + dt * 16 + 4 * q);
        asm volatile("" ::: "memory");
#pragma unroll
        for (int dt = 0; dt < 8; ++dt) { const int ch = head * 128 + dt * 16 + 4 * q; const u32x2 gr = grm[dt];
            u32x2 w; w.x = pk2(o[dt][0] * inv * fsilu(bflo(gr.x)), o[dt][1] * inv * fsilu(bfhi(gr.x))); w.y = pk2(o[dt][2] * inv * fsilu(bflo(gr.y)), o[dt][3] * inv * fsilu(bfhi(gr.y)));
            *(u32x2*)(YS + row * YW + 4 * BW + ch) = w; }
        asm volatile("" ::: "memory");
    }
}

__device__ __forceinline__ void ssd_conv8(const bf16_t* prow_col, int tb, const float* cw  , const float* cb, int ch0, float (&y)[8]) {
#pragma unroll
    for (int k = 0; k < 8; ++k) y[k] = cb[ch0 + k];
#pragma unroll
    for (int j = 0; j < 4; ++j) { const int dt = j - 3;
        if (tb + dt >= 0) { const u32x4 r = *(const u32x4*)(prow_col + (ptrdiff_t)dt * PW);
            const f32x4 w0 = *(const f32x4*)(cw + j * 1024 + ch0), w1 = *(const f32x4*)(cw + j * 1024 + ch0 + 4);
            y[0] += w0[0] * bflo(r.x); y[1] += w0[1] * bfhi(r.x); y[2] += w0[2] * bflo(r.y); y[3] += w0[3] * bfhi(r.y);
            y[4] += w1[0] * bflo(r.z); y[5] += w1[1] * bfhi(r.z); y[6] += w1[2] * bflo(r.w); y[7] += w1[3] * bfhi(r.w); } }
#pragma unroll
    for (int k = 0; k < 8; ++k) y[k] = fsilu(y[k]);
}
__device__ __forceinline__ void ssd_conv8x2(const bf16_t* prow_col, int tb0, const float* cw, const float* cb, int ch0, float (&y0)[8], float (&y1)[8]) {
#pragma unroll
    for (int k = 0; k < 8; ++k) { y0[k] = cb[ch0 + k]; y1[k] = y0[k]; }
    f32x4 w[4][2];
#pragma unroll
    for (int j = 0; j < 4; ++j) { w[j][0] = *(const f32x4*)(cw + j * 1024 + ch0); w[j][1] = *(const f32x4*)(cw + j * 1024 + ch0 + 4); }
#pragma unroll
    for (int d = -3; d <= 1; ++d) {
        if (tb0 + d >= 0) { const u32x4 r = *(const u32x4*)(prow_col + (ptrdiff_t)d * PW);
            const float x[8] = {bflo(r.x), bfhi(r.x), bflo(r.y), bfhi(r.y), bflo(r.z), bfhi(r.z), bflo(r.w), bfhi(r.w)};
            if (d + 3 <= 3) {
#pragma unroll
                for (int k = 0; k < 8; ++k) y0[k] += w[d + 3 <= 3 ? d + 3 : 0][k >> 2][k & 3] * x[k]; }
            if (d + 2 >= 0) {
#pragma unroll
                for (int k = 0; k < 8; ++k) y1[k] += w[d + 2 >= 0 ? d + 2 : 0][k >> 2][k & 3] * x[k]; } } }
#pragma unroll
    for (int k = 0; k < 8; ++k) { y0[k] = fsilu(y0[k]); y1[k] = fsilu(y1[k]); }
}
__device__ __forceinline__ void ssd_conv8x4(const bf16_t* prow_col, int tb0, const float* cw, const float* cb, int ch0, float (&y)[4][8]) {
    f32x4 w[4][2];
#pragma unroll
    for (int j = 0; j < 4; ++j) { w[j][0] = *(const f32x4*)(cw + j * 1024 + ch0); w[j][1] = *(const f32x4*)(cw + j * 1024 + ch0 + 4); }
    const f32x4 b0 = *(const f32x4*)(cb + ch0), b1 = *(const f32x4*)(cb + ch0 + 4);
#pragma unroll
    for (int t = 0; t < 4; ++t) { y[t][0] = b0[0]; y[t][1] = b0[1]; y[t][2] = b0[2]; y[t][3] = b0[3]; y[t][4] = b1[0]; y[t][5] = b1[1]; y[t][6] = b1[2]; y[t][7] = b1[3]; }
    u32x4 r[7];
#pragma unroll
    for (int d = -3; d <= 3; ++d) r[d + 3] = (tb0 + d >= 0) ? *(const u32x4*)(prow_col + (ptrdiff_t)d * PW) : (u32x4){0u, 0u, 0u, 0u};
#pragma unroll
    for (int d = -3; d <= 3; ++d) { const u32x4 rr = r[d + 3];
        const float x[8] = {bflo(rr.x), bfhi(rr.x), bflo(rr.y), bfhi(rr.y), bflo(rr.z), bfhi(rr.z), bflo(rr.w), bfhi(rr.w)};
#pragma unroll
        for (int t = 0; t < 4; ++t) { const int j = d - t + 3;
            if (j >= 0 && j <= 3) {
#pragma unroll
                for (int k = 0; k < 8; ++k) y[t][k] += w[j][k >> 2][k & 3] * x[k]; } } }
#pragma unroll
    for (int t = 0; t < 4; ++t)
#pragma unroll
        for (int k = 0; k < 8; ++k) y[t][k] = fsilu(y[t][k]);
}
__device__ __forceinline__ void ssd_dt_tables(const Ctx& c, int layer, int lb, int n, int h0, int nh, LAS float* dtL, LAS float* csL, int tid, bool to_global) {
    const Params& p = *c.p; const bf16_t* P = (const bf16_t*)(p.ws + WS_P); float* SM = (float*)(p.ws + WS_SMALL);
    const int r0 = lb * SEQ + n * 128;
    for (int e = tid; e < 128 * nh; e += 512) { const int s = e / nh, hh = h0 + e % nh;
        const float x = bf2f(P[(size_t)(r0 + s) * PW + C_DDT + hh]) + p.in[17][layer * 8 + hh];
        const float dt = fsoftplus(x); dtL[s * nh + (hh - h0)] = dt; csL[s * nh + (hh - h0)] = dt * (-__expf(p.in[16][layer * 8 + hh])); }
    __syncthreads();
    { const int wv = tid >> 6, ln = tid & 63;
      if (wv < nh) { float a = csL[ln * nh + wv], b = csL[(ln + 64) * nh + wv];
#pragma unroll
          for (int o = 1; o < 64; o <<= 1) { const float ta = __builtin_bit_cast(float, __builtin_amdgcn_ds_bpermute((ln - o) << 2, __builtin_bit_cast(int, a))), tb = __builtin_bit_cast(float, __builtin_amdgcn_ds_bpermute((ln - o) << 2, __builtin_bit_cast(int, b)));
              if (ln >= o) { a += ta; b += tb; } }
          const float tot = __builtin_bit_cast(float, __builtin_amdgcn_ds_bpermute(63 << 2, __builtin_bit_cast(int, a)));
          b += tot; csL[ln * nh + wv] = a; csL[(ln + 64) * nh + wv] = b;
          if (to_global && ln == 63) SM[SM_SSD_CD + (lb * 8 + h0 + wv) * 32 + n] = __expf(b); } }
    __syncthreads();
}
__device__ __forceinline__ void ssd1_unit(const Ctx& c, int layer, int lb, int n, int g) {
    PHASE_TID();
    const Params& p = *c.p; const bf16_t* P = (const bf16_t*)(p.ws + WS_P);
    const float* cw = p.in[14] + (size_t)layer * 4 * 1024; const float* cbias = p.in[15] + layer * 1024;
    LAS float* dtL = (LAS float*)c.lds; LAS float* csL = (LAS float*)(c.lds + 2048);
    LAS bf16_t* bmT = (LAS bf16_t*)(c.lds + 4096);
    LAS bf16_t* xdT = (LAS bf16_t*)(c.lds + 4096 + 34816);
    const int r0 = lb * SEQ + n * 128, q = lane >> 4, l15 = lane & 15;
    __syncthreads();
    ssd_dt_tables(c, layer, lb, n, g * 4, 4, dtL, csL, tid, true);
    for (int e = tid; e < 32 * 48; e += 512) { const int sg4 = e / 48, blk = e % 48, s0 = 4 * sg4; float y[4][8];
        if (blk < 16) { const int ch0 = 512 + g * 128 + blk * 8;
            ssd_conv8x4(P + (size_t)(r0 + s0) * PW + C_DX + ch0, n * 128 + s0, cw, cbias, ch0, y);
#pragma unroll
            for (int k = 0; k < 8; ++k) { u32x2 w; w.x = pk2(y[0][k], y[1][k]); w.y = pk2(y[2][k], y[3][k]); *(LAS u32x2*)(bmT + (blk * 8 + k) * 136 + s0) = w; }
        } else { const int b2 = blk - 16, r = b2 >> 3, ch0 = (g * 4 + r) * 64 + (b2 & 7) * 8;
            ssd_conv8x4(P + (size_t)(r0 + s0) * PW + C_DX + ch0, n * 128 + s0, cw, cbias, ch0, y);
            const float cl = csL[127 * 4 + r]; float f[4];
#pragma unroll
            for (int t = 0; t < 4; ++t) f[t] = dtL[(s0 + t) * 4 + r] * __expf(cl - csL[(s0 + t) * 4 + r]);
#pragma unroll
            for (int k = 0; k < 8; ++k) { u32x2 w; w.x = pk2(y[0][k] * f[0], y[1][k] * f[1]); w.y = pk2(y[2][k] * f[2], y[3][k] * f[3]); *(LAS u32x2*)(xdT + (b2 * 8 + k) * 136 + s0) = w; } }
    }
    __syncthreads();
    f32x4 acc[2][8];
#pragma unroll
    for (int a = 0; a < 2; ++a)
#pragma unroll
        for (int m = 0; m < 8; ++m) acc[a][m] = (f32x4){0.f, 0.f, 0.f, 0.f};
#pragma unroll
    for (int ks = 0; ks < 4; ++ks) {
        const bf16x8 b0 = ld_frag_l(xdT + ((2 * wave) * 16 + l15) * 136, ks, q), b1 = ld_frag_l(xdT + ((2 * wave + 1) * 16 + l15) * 136, ks, q);
#pragma unroll
        for (int m = 0; m < 8; ++m) { const bf16x8 a = ld_frag_l(bmT + (m * 16 + l15) * 136, ks, q); acc[0][m] = mma16(a, b0, acc[0][m]); acc[1][m] = mma16(a, b1, acc[1][m]); }
    }
    bf16_t* ST = (bf16_t*)(p.ws + WS_SSD) + (size_t)(lb * 32 + n) * 8 * 8192;
#pragma unroll
    for (int a = 0; a < 2; ++a) { const int rp = (2 * wave + a) * 16 + l15, hh = g * 4 + (rp >> 6), pp = rp & 63;
#pragma unroll
        for (int m = 0; m < 8; ++m) { u32x2 w; w.x = pk2m(acc[a][m][0], acc[a][m][1]); w.y = pk2m(acc[a][m][2], acc[a][m][3]);
            *(u32x2*)(ST + (size_t)hh * 8192 + pp * 128 + m * 16 + 4 * q) = w; } }
}
__device__ __forceinline__ void ssd_scan(const Ctx& c) {
    PHASE_TID();
    const Params& p = *c.p; const float* SM = (const float*)(p.ws + WS_SMALL);
    for (int e = c.bid * 512 + tid; e < GB * 8 * 4096; e += c.G * 512) {
        const int lb = e >> 15, hh = (e >> 12) & 7, pr = e & 4095;
        unsigned* base = (unsigned*)(p.ws + WS_SSD) + (size_t)(lb * 32) * 8 * 4096 + (size_t)hh * 4096 + pr;
        unsigned v[32]; float cdv[32];
#pragma unroll
        for (int n = 0; n < 32; ++n) { v[n] = base[(size_t)n * 8 * 4096]; cdv[n] = SM[SM_SSD_CD + (lb * 8 + hh) * 32 + n]; }
        float r0 = 0.f, r1 = 0.f;
#pragma unroll
        for (int n = 0; n < 32; ++n) { base[(size_t)n * 8 * 4096] = pk2(r0, r1); r0 = cdv[n] * r0 + bflo(v[n]); r1 = cdv[n] * r1 + bfhi(v[n]); }
    }
}
__device__ __forceinline__ void ssd3_unit(const Ctx& c, int layer, int lb, int n) {
    PHASE_TID();
    const Params& p = *c.p; const bf16_t* P = (const bf16_t*)(p.ws + WS_P); bf16_t* YS = (bf16_t*)(p.ws + WS_YS);
    const float* cw = p.in[14] + (size_t)layer * 4 * 1024; const float* cbias = p.in[15] + layer * 1024;
    const float* dskip = p.in[18] + layer * 8;
    LAS float* dtL = (LAS float*)c.lds; LAS float* csL = (LAS float*)(c.lds + 4096);
    LAS bf16_t* cmL = (LAS bf16_t*)(c.lds + 8192);
    LAS bf16_t* bmL = (LAS bf16_t*)(c.lds + 8192 + 34816);
    LAS bf16_t* xdT = (LAS bf16_t*)(c.lds + 8192 + 34816);
    const int r0 = lb * SEQ + n * 128, q = lane >> 4, l15 = lane & 15;
    const size_t row = (size_t)(r0 + wave * 16 + l15);
    const bf16_t* SP = (const bf16_t*)(p.ws + WS_SSD) + (size_t)(lb * 32 + n) * 8 * 8192;
    __syncthreads();
    ssd_dt_tables(c, layer, lb, n, 0, 8, dtL, csL, tid, false);
    float ssq = 0.f;
    for (int g = 0; g < 2; ++g) {
        __syncthreads();
        for (int e = tid; e < 32 * 32; e += 512) { const int s0 = (e >> 5) * 4, blk = e & 31; float y[4][8];
            const int ch0 = (blk < 16 ? 768 : 512) + g * 128 + (blk & 15) * 8;
            ssd_conv8x4(P + (size_t)(r0 + s0) * PW + C_DX + ch0, n * 128 + s0, cw, cbias, ch0, y);
#pragma unroll
            for (int t = 0; t < 4; ++t) { u32x4 w; w.x = pk2(y[t][0], y[t][1]); w.y = pk2(y[t][2], y[t][3]); w.z = pk2(y[t][4], y[t][5]); w.w = pk2(y[t][6], y[t][7]);
                *(LAS u32x4*)((blk < 16 ? cmL : bmL) + (s0 + t) * 136 + (blk & 15) * 8) = w; } }
        __syncthreads();
        bf16x8 cmf[4];
#pragma unroll
        for (int ks = 0; ks < 4; ++ks) cmf[ks] = ld_frag_l(cmL + (wave * 16 + l15) * 136, ks, q);
        f32x4 cbT[8];
#pragma unroll
        for (int st = 0; st < 8; ++st) { cbT[st] = (f32x4){0.f, 0.f, 0.f, 0.f};
            if (st <= wave) {
#pragma unroll
                for (int ks = 0; ks < 4; ++ks) cbT[st] = mma16(ld_frag_l(bmL + (st * 16 + l15) * 136, ks, q), cmf[ks], cbT[st]); } }
        __syncthreads();
        for (int e = tid; e < 32 * 32; e += 512) { const int s0 = (e >> 5) * 4, b2 = e & 31, r = b2 >> 3, ch0 = (g * 4 + r) * 64 + (b2 & 7) * 8; float y[4][8];
            ssd_conv8x4(P + (size_t)(r0 + s0) * PW + C_DX + ch0, n * 128 + s0, cw, cbias, ch0, y);
            const float f0 = dtL[s0 * 8 + g * 4 + r], f1 = dtL[(s0 + 1) * 8 + g * 4 + r], f2 = dtL[(s0 + 2) * 8 + g * 4 + r], f3 = dtL[(s0 + 3) * 8 + g * 4 + r];
#pragma unroll
            for (int k = 0; k < 8; ++k) { u32x2 w; w.x = pk2(y[0][k] * f0, y[1][k] * f1); w.y = pk2(y[2][k] * f2, y[3][k] * f3); *(LAS u32x2*)(xdT + (b2 * 8 + k) * 136 + s0) = w; } }
        __syncthreads();
        const int cpos = wave * 16 + l15;
#pragma unroll 1
        for (int r = 0; r < 4; ++r) { const int hh = g * 4 + r; const float csc = csL[cpos * 8 + hh];
            f32x4 yd[4], yo[4];
#pragma unroll
            for (int pt = 0; pt < 4; ++pt) { yd[pt] = (f32x4){0.f, 0.f, 0.f, 0.f}; yo[pt] = (f32x4){0.f, 0.f, 0.f, 0.f}; }
#pragma unroll
            for (int ks = 0; ks < 4; ++ks) {
                if (2 * ks <= wave) {
                    f32x4 m0, m1;
#pragma unroll
                    for (int i = 0; i < 4; ++i) { const int s0 = 32 * ks + 4 * q + i, s1 = s0 + 16;
                        m0[i] = s0 <= cpos ? cbT[2 * ks][i] * __expf(fminf(csc - csL[s0 * 8 + hh], 0.f)) : 0.f;
                        m1[i] = s1 <= cpos ? cbT[2 * ks + 1][i] * __expf(fminf(csc - csL[s1 * 8 + hh], 0.f)) : 0.f; }
                    const bf16x8 mf = pack_frag(m0, m1);
#pragma unroll
                    for (int pt = 0; pt < 4; ++pt) yd[pt] = mma16(ld_frag_perm_l(xdT + (r * 64 + pt * 16 + l15) * 136, ks, q), mf, yd[pt]);
                }
#pragma unroll
                for (int pt = 0; pt < 4; ++pt) yo[pt] = mma16(ld_frag_g(SP + (size_t)hh * 8192 + (pt * 16 + l15) * 128, ks, q), cmf[ks], yo[pt]);
            }
            const float ecs = __expf(csc), dsk = dskip[hh] / dtL[cpos * 8 + hh];
            u32x2 zr4[4];
#pragma unroll
            for (int pt = 0; pt < 4; ++pt) zr4[pt] = *(const u32x2*)(P + row * PW + C_DZ + hh * 64 + pt * 16 + 4 * q);
            asm volatile("" ::: "memory");
#pragma unroll
            for (int pt = 0; pt < 4; ++pt) { const int ch = hh * 64 + pt * 16 + 4 * q;
                const u32x2 zr = zr4[pt];
                float yv[4];
#pragma unroll
                for (int i = 0; i < 4; ++i) yv[i] = yd[pt][i] + ecs * yo[pt][i] + dsk * bf2f(xdT[(r * 64 + pt * 16 + 4 * q + i) * 136 + cpos]);
                yv[0] *= fsilu(bflo(zr.x)); yv[1] *= fsilu(bfhi(zr.x)); yv[2] *= fsilu(bflo(zr.y)); yv[3] *= fsilu(bfhi(zr.y));
                ssq += (yv[0] * yv[0] + yv[1] * yv[1]) + (yv[2] * yv[2] + yv[3] * yv[3]);
                u32x2 w; w.x = pk2(yv[0], yv[1]); w.y = pk2(yv[2], yv[3]);
                *(u32x2*)(YS + row * YW + 3 * BW + ch) = w; }
        }
    }
    ssq += shx(ssq, 16, lane); ssq += shx(ssq, 32, lane);
    if (q == 0) ((float*)(p.ws + WS_SMALL))[SM_SSD_RS + row] = rsqrtf(ssq * (1.f / BW) + 1e-6f);
}

__device__ __forceinline__ float row16_sum(float v) {
    v += __builtin_bit_cast(float, __builtin_amdgcn_mov_dpp(__builtin_bit_cast(int, v), 0xB1, 0xF, 0xF, true));
    v += __builtin_bit_cast(float, __builtin_amdgcn_mov_dpp(__builtin_bit_cast(int, v), 0x4E, 0xF, 0xF, true));
    v += __builtin_bit_cast(float, __builtin_amdgcn_mov_dpp(__builtin_bit_cast(int, v), 0x141, 0xF, 0xF, true));
    v += __builtin_bit_cast(float, __builtin_amdgcn_mov_dpp(__builtin_bit_cast(int, v), 0x140, 0xF, 0xF, true));
    return v;
}
__device__ __forceinline__ void gdn_pre_unit(const Ctx& c, int layer, int lb, int n, int h) {
    PHASE_TID();
    const Params& p = *c.p; const bf16_t* P = (const bf16_t*)(p.ws + WS_P);
    const float* cw = p.in[4] + (size_t)layer * 4 * 1536;
    LAS bf16_t* qL = (LAS bf16_t*)c.lds; LAS bf16_t* kL = (LAS bf16_t*)(c.lds + 17408); LAS bf16_t* vL = (LAS bf16_t*)(c.lds + 34816);
    LAS float* Lm = (LAS float*)(c.lds + 52224);
    LAS float* gcL = (LAS float*)(c.lds + 69632); LAS float* btL = (LAS float*)(c.lds + 69888);
    LAS bf16_t* LbL = (LAS bf16_t*)(c.lds + 70144);
    LAS bf16_t* XT = (LAS bf16_t*)(c.lds + 79360);
    unsigned char* scr = p.ws + WS_GDN + (size_t)((lb * 4 + h) * 64 + n) * GDN_CH_BYTES;
    bf16_t* WK = (bf16_t*)scr; bf16_t* U0T = (bf16_t*)(scr + 16384); bf16_t* QD = (bf16_t*)(scr + 32768); bf16_t* KDT = (bf16_t*)(scr + 49152); bf16_t* QK = (bf16_t*)(scr + 65536);
    const int r0 = lb * SEQ + n * 64, q = lane >> 4, l15 = lane & 15;
    __syncthreads();
    { unsigned z0 = 0u; asm volatile("" : "+v"(z0));
      for (int i = tid; i < 2304; i += 512) *(LAS u32x4*)(c.lds + 79360 + i * 16) = (u32x4){z0, z0, z0, z0}; }
    if (wave == 0) {
        const float a_in = bf2f(P[(size_t)(r0 + lane) * PW + C_AA + h]), b_in = bf2f(P[(size_t)(r0 + lane) * PW + C_AB + h]);
        float gl = -__expf(p.in[5][layer * 4 + h]) * fsoftplus(a_in + p.in[6][layer * 4 + h]);
#pragma unroll
        for (int o = 1; o < 64; o <<= 1) { const float t = __builtin_bit_cast(float, __builtin_amdgcn_ds_bpermute((lane - o) << 2, __builtin_bit_cast(int, gl))); if (lane >= o) gl += t; }
        gcL[lane] = gl; btL[lane] = fsigmoid(b_in);
    }
#pragma unroll 1
    for (int j = 0; j < 2; ++j) { const int e = tid + 512 * j;
        if (e < 768) { const int part = e >> 8, s0 = ((e >> 4) & 15) * 4, blk = e & 15, ch0 = part * 512 + h * 128 + blk * 8, tb0 = n * 64 + s0;
            const bf16_t* src = P + (size_t)(r0 + s0) * PW + ch0;
            f32x4 w[4][2];
#pragma unroll
            for (int jj = 0; jj < 4; ++jj) { w[jj][0] = *(const f32x4*)(cw + jj * 1536 + ch0); w[jj][1] = *(const f32x4*)(cw + jj * 1536 + ch0 + 4); }
            float y[4][8];
#pragma unroll
            for (int t = 0; t < 4; ++t)
#pragma unroll
                for (int k = 0; k < 8; ++k) y[t][k] = 0.f;
            u32x4 r[7];
#pragma unroll
            for (int d = -3; d <= 3; ++d) r[d + 3] = (tb0 + d >= 0) ? *(const u32x4*)(src + (ptrdiff_t)d * PW) : (u32x4){0u, 0u, 0u, 0u};
#pragma unroll
            for (int d = -3; d <= 3; ++d) { const u32x4 rr = r[d + 3];
                const float x[8] = {bflo(rr.x), bfhi(rr.x), bflo(rr.y), bfhi(rr.y), bflo(rr.z), bfhi(rr.z), bflo(rr.w), bfhi(rr.w)};
#pragma unroll
                for (int t = 0; t < 4; ++t) { const int jj = d - t + 3;
                    if (jj >= 0 && jj <= 3) {
#pragma unroll
                        for (int k = 0; k < 8; ++k) y[t][k] += w[jj][k >> 2][k & 3] * x[k]; } } }
#pragma unroll
            for (int t = 0; t < 4; ++t) { float ss = 0.f;
#pragma unroll
                for (int k = 0; k < 8; ++k) { y[t][k] = fsilu(y[t][k]); ss += y[t][k] * y[t][k]; }
                ss = row16_sum(ss);
                const float sc = part == 2 ? 1.0f : rsqrtf(ss + 1e-6f) * (part == 0 ? 0.08838834764831845f : 1.0f);
                u32x4 wv; wv.x = pk2(y[t][0] * sc, y[t][1] * sc); wv.y = pk2(y[t][2] * sc, y[t][3] * sc); wv.z = pk2(y[t][4] * sc, y[t][5] * sc); wv.w = pk2(y[t][6] * sc, y[t][7] * sc);
                *(LAS u32x4*)((part == 0 ? qL : part == 1 ? kL : vL) + (s0 + t) * 136 + blk * 8) = wv; } } }
    __syncthreads();
    {
        const int sel = wave >> 2, ct = wave & 3, cc = ct * 16 + l15; const float gcc = gcL[cc], btc = btL[cc];
        bf16x8 bf[4];
#pragma unroll
        for (int ks = 0; ks < 4; ++ks) bf[ks] = ld_frag_l((sel ? qL : kL) + cc * 136, ks, q);
#pragma unroll
        for (int st = 0; st < 4; ++st) { f32x4 d = (f32x4){0.f, 0.f, 0.f, 0.f};
            if (st <= ct) {
#pragma unroll
                for (int ks = 0; ks < 4; ++ks) d = mma16(ld_frag_l(kL + (st * 16 + l15) * 136, ks, q), bf[ks], d); }
            f32x4 o;
#pragma unroll
            for (int i = 0; i < 4; ++i) { const int s = st * 16 + 4 * q + i; const float dec = __expf(fminf(gcc - gcL[s], 0.f));
                o[i] = sel ? (s <= cc ? d[i] * dec : 0.f) : (s < cc ? d[i] * dec * btc : 0.f); }
            if (sel) { u32x2 w; w.x = pk2(o[0], o[1]); w.y = pk2(o[2], o[3]); *(u32x2*)(QK + cc * 64 + st * 16 + 4 * q) = w; }
            else { *(LAS f32x4*)(Lm + cc * 68 + st * 16 + 4 * q) = o; u32x2 w; w.x = pk2(o[0], o[1]); w.y = pk2(o[2], o[3]); *(LAS u32x2*)(LbL + cc * 72 + st * 16 + 4 * q) = w; } }
    }
    __syncthreads();
#pragma unroll
    for (int b = 0; b < 4; ++b) {
        f32x4 U[2] = {(f32x4){0.f, 0.f, 0.f, 0.f}, (f32x4){0.f, 0.f, 0.f, 0.f}};
        if (b > 0) {
#pragma unroll
            for (int ks = 0; ks < (b + 1) / 2; ++ks) { const bf16x8 a = ld_frag_l(LbL + (16 * b + l15) * 72, ks, q);
#pragma unroll
                for (int t = 0; t < 2; ++t) U[t] = mma16(a, ld_frag_l(XT + ((2 * wave + t) * 16 + l15) * 72, ks, q), U[t]); } }
#pragma unroll
        for (int t = 0; t < 2; ++t) { const int col = (2 * wave + t) * 16 + l15; const bool isk = col < 128; const LAS bf16_t* colp = (isk ? kL : vL) + (col & 127);
            float y[4];
#pragma unroll
            for (int i = 0; i < 4; ++i) { const int cc = 16 * b + 4 * q + i; y[i] = btL[cc] * (isk ? __expf(gcL[cc]) : 1.0f) * bf2f(colp[cc * 136]) - U[t][i]; }
#pragma unroll
            for (int qq = 0; qq < 4; ++qq) {
                f32x4 lr[4];
#pragma unroll
                for (int i = 0; i < 4; ++i) lr[i] = *(const LAS f32x4*)(Lm + (16 * b + 4 * q + i) * 68 + 16 * b + 4 * qq);
                if (q == qq) { y[1] -= lr[1][0] * y[0]; y[2] -= lr[2][0] * y[0] + lr[2][1] * y[1]; y[3] -= lr[3][0] * y[0] + lr[3][1] * y[1] + lr[3][2] * y[2]; }
                float bx[4];
#pragma unroll
                for (int i = 0; i < 4; ++i) bx[i] = __builtin_bit_cast(float, __builtin_amdgcn_ds_bpermute((l15 + 16 * qq) << 2, __builtin_bit_cast(int, y[i])));
                if (q > qq) {
#pragma unroll
                    for (int i = 0; i < 4; ++i) y[i] -= (lr[i][0] * bx[0] + lr[i][1] * bx[1]) + (lr[i][2] * bx[2] + lr[i][3] * bx[3]); }
            }
            u32x2 w; w.x = pk2(y[0], y[1]); w.y = pk2(y[2], y[3]);
            *(LAS u32x2*)(XT + col * 72 + 16 * b + 4 * q) = w; }
        __syncthreads();
    }
    {
        const float g63 = gcL[63];
#pragma unroll
        for (int jj = 0; jj < 2; ++jj) { const int e = tid + 512 * jj, v = e >> 3, pc = e & 7;
            *(u32x4*)(U0T + v * 64 + pc * 8) = *(const LAS u32x4*)(XT + (128 + v) * 72 + pc * 8); }
#pragma unroll
        for (int jj = 0; jj < 2; ++jj) { const int e = tid + 512 * jj, cc = e & 63, d0 = (e >> 6) * 8; unsigned short v8[8];
#pragma unroll
            for (int i = 0; i < 8; ++i) v8[i] = XT[(d0 + i) * 72 + cc];
            u32x4 w; w.x = v8[0] | ((unsigned)v8[1] << 16); w.y = v8[2] | ((unsigned)v8[3] << 16); w.z = v8[4] | ((unsigned)v8[5] << 16); w.w = v8[6] | ((unsigned)v8[7] << 16);
            *(u32x4*)(WK + cc * 128 + d0) = w; }
#pragma unroll
        for (int jj = 0; jj < 2; ++jj) { const int e = tid + 512 * jj, s_ = e >> 4, blk = e & 15; const float sc = __expf(gcL[s_]);
            const u32x4 r = *(const LAS u32x4*)(qL + s_ * 136 + blk * 8);
            u32x4 w; w.x = pk2(bflo(r.x) * sc, bfhi(r.x) * sc); w.y = pk2(bflo(r.y) * sc, bfhi(r.y) * sc); w.z = pk2(bflo(r.z) * sc, bfhi(r.z) * sc); w.w = pk2(bflo(r.w) * sc, bfhi(r.w) * sc);
            *(u32x4*)(QD + s_ * 128 + blk * 8) = w; }
#pragma unroll
        for (int jj = 0; jj < 2; ++jj) { const int e = tid + 512 * jj, d = e & 127, s0 = (e >> 7) * 8; float v[8];
#pragma unroll
            for (int i = 0; i < 8; ++i) v[i] = bf2f(kL[(s0 + i) * 136 + d]) * __expf(g63 - gcL[s0 + i]);
            u32x4 w; w.x = pk2(v[0], v[1]); w.y = pk2(v[2], v[3]); w.z = pk2(v[4], v[5]); w.w = pk2(v[6], v[7]);
            *(u32x4*)(KDT + d * 64 + s0) = w; }
        if (tid == 0) ((float*)(p.ws + WS_SMALL))[SM_GDN_CD + (lb * 4 + h) * 64 + n] = __expf(g63);
    }
}

__device__ __forceinline__ void gdn_chain(const Ctx& c, int layer, int lb, int h, int half) {
    PHASE_TID();
    const Params& p = *c.p; bf16_t* YS = (bf16_t*)(p.ws + WS_YS);
    const float* SM = (const float*)(p.ws + WS_SMALL);
    const int q = lane >> 4, l15 = lane & 15, vcol = (half * 4 + (wave & 3)) * 16 + l15;
    const unsigned char* scr0 = p.ws + WS_GDN + (size_t)((lb * 4 + h) * 64) * GDN_CH_BYTES;
    constexpr int BUFB = 62464;
    const bool loader = wave >= 4; const int lt = tid - 256;
#define GDN_LD(r_, nn) do { const unsigned char* sc_ = scr0 + (size_t)(nn) * GDN_CH_BYTES; \
        _Pragma("unroll") for (int j = 0; j < 14; ++j) { const int idx = lt + 256 * j; \
            const size_t so = j < 4 ? (size_t)idx * 16 : j < 8 ? 32768 + (size_t)(idx - 1024) * 16 : j < 12 ? 49152 + (size_t)(idx - 2048) * 16 : 65536 + (size_t)(idx - 3072) * 16; \
            r_[j] = *(const u32x4*)(sc_ + so); } } while (0)
#define GDN_ST(r_, buf) do { ldsp_t b_ = c.lds + (buf) * BUFB; \
        _Pragma("unroll") for (int j = 0; j < 14; ++j) { const int idx = lt + 256 * j; \
            const int lo = j < 4 ? (idx >> 4) * 272 + (idx & 15) * 16 : j < 8 ? 17408 + ((idx - 1024) >> 4) * 272 + (idx & 15) * 16 \
                         : j < 12 ? 34816 + ((idx - 2048) >> 3) * 144 + (idx & 7) * 16 : 53248 + ((idx - 3072) >> 3) * 144 + (idx & 7) * 16; \
            *(LAS u32x4*)(b_ + lo) = r_[j]; } } while (0)
    f32x4 st[8];
#pragma unroll
    for (int d = 0; d < 8; ++d) st[d] = (f32x4){0.f, 0.f, 0.f, 0.f};
    u32x2 u0r[4]; float cdn = 0.f;
    __syncthreads();
    if (loader) {
        u32x4 ra[14], rb[14], rc[14];
        GDN_LD(ra, 0); GDN_LD(rb, 1); GDN_LD(rc, 2);
        GDN_ST(ra, 0); GDN_LD(ra, 3);
        __syncthreads();
#pragma unroll 1
        for (int n = 0; n < 66; n += 3) {
            if (n < 64) { if (n + 1 < 64) { GDN_ST(rb, (n + 1) & 1); if (n + 4 < 64) GDN_LD(rb, n + 4); } __syncthreads(); }
            if (n + 1 < 64) { if (n + 2 < 64) { GDN_ST(rc, (n + 2) & 1); if (n + 5 < 64) GDN_LD(rc, n + 5); } __syncthreads(); }
            if (n + 2 < 64) { if (n + 3 < 64) { GDN_ST(ra, (n + 3) & 1); if (n + 6 < 64) GDN_LD(ra, n + 6); } __syncthreads(); }
        }
        return;
    }
#pragma unroll
    for (int m = 0; m < 4; ++m) u0r[m] = *(const u32x2*)(scr0 + 16384 + (size_t)(vcol * 64 + m * 16 + 4 * q) * 2);
    cdn = SM[SM_GDN_CD + (lb * 4 + h) * 64];
    __syncthreads();
#pragma unroll 1
    for (int n = 0; n < 64; ++n) {
        {
            ldsp_t b = c.lds + (n & 1) * BUFB;
            const LAS bf16_t* wkL = (const LAS bf16_t*)b; const LAS bf16_t* qdL = (const LAS bf16_t*)(b + 17408);
            const LAS bf16_t* kdL = (const LAS bf16_t*)(b + 34816); const LAS bf16_t* qkL = (const LAS bf16_t*)(b + 53248);
            const float cd = cdn;
            f32x4 u0[4];
#pragma unroll
            for (int m = 0; m < 4; ++m) u0[m] = (f32x4){bflo(u0r[m].x), bfhi(u0r[m].x), bflo(u0r[m].y), bfhi(u0r[m].y)};
            if (n < 63) {
                const unsigned char* sn = scr0 + (size_t)(n + 1) * GDN_CH_BYTES;
#pragma unroll
                for (int m = 0; m < 4; ++m) u0r[m] = *(const u32x2*)(sn + 16384 + (size_t)(vcol * 64 + m * 16 + 4 * q) * 2);
                cdn = SM[SM_GDN_CD + (lb * 4 + h) * 64 + n + 1]; }
            bf16x8 sf[4];
#pragma unroll
            for (int ks = 0; ks < 4; ++ks) sf[ks] = pack_frag(st[2 * ks], st[2 * ks + 1]);
            f32x4 x[4], o[4];
#pragma unroll
            for (int m = 0; m < 4; ++m) { x[m] = (f32x4){0.f, 0.f, 0.f, 0.f}; o[m] = (f32x4){0.f, 0.f, 0.f, 0.f};
#pragma unroll
                for (int ks = 0; ks < 4; ++ks) { x[m] = mma16(ld_frag_perm_l(wkL + (m * 16 + l15) * 136, ks, q), sf[ks], x[m]); o[m] = mma16(ld_frag_perm_l(qdL + (m * 16 + l15) * 136, ks, q), sf[ks], o[m]); } }
#pragma unroll
            for (int m = 0; m < 4; ++m) x[m] = u0[m] - x[m];
            bf16x8 uf[2];
#pragma unroll
            for (int k2 = 0; k2 < 2; ++k2) uf[k2] = pack_frag(x[2 * k2], x[2 * k2 + 1]);
#pragma unroll
            for (int d = 0; d < 8; ++d) { st[d] = st[d] * cd;
#pragma unroll
                for (int k2 = 0; k2 < 2; ++k2) st[d] = mma16(ld_frag_perm_l(kdL + (d * 16 + l15) * 72, k2, q), uf[k2], st[d]); }
#pragma unroll
            for (int m = 0; m < 4; ++m)
#pragma unroll
                for (int k2 = 0; k2 < 2; ++k2) o[m] = mma16(ld_frag_perm_l(qkL + (m * 16 + l15) * 72, k2, q), uf[k2], o[m]);
            const size_t rowb = (size_t)(lb * SEQ + n * 64);
#pragma unroll
            for (int m = 0; m < 4; ++m)
#pragma unroll
                for (int i = 0; i < 4; ++i) YS[(rowb + m * 16 + 4 * q + i) * YW + h * 128 + vcol] = f2bfm(o[m][i]);
        }
        __syncthreads();
    }
#undef GDN_LD
#undef GDN_ST
}
__device__ __forceinline__ void gdn_post(const Ctx& c, int layer) {
    PHASE_TID();
    const Params& p = *c.p; const bf16_t* P = (const bf16_t*)(p.ws + WS_P); bf16_t* YS = (bf16_t*)(p.ws + WS_YS);
    const float* ng = p.in[7] + layer * 128;
    const int ch = lane * 8, d0 = ch & 127;
    for (int r = c.bid * 8 + wave; r < TG; r += c.G * 16) {
        u32x4 ov2[2], gr2[2];
#pragma unroll
        for (int k = 0; k < 2; ++k) { const size_t rr = (size_t)(r + k * c.G * 8); ov2[k] = *(const u32x4*)(YS + rr * YW + ch); gr2[k] = *(const u32x4*)(P + rr * PW + C_AG + ch); }
        asm volatile("" ::: "memory");
#pragma unroll
        for (int k = 0; k < 2; ++k) { const size_t rr = (size_t)(r + k * c.G * 8); const u32x4 ov = ov2[k], gr = gr2[k];
            float x[8] = {bflo(ov.x), bfhi(ov.x), bflo(ov.y), bfhi(ov.y), bflo(ov.z), bfhi(ov.z), bflo(ov.w), bfhi(ov.w)};
            const float g8[8] = {bflo(gr.x), bfhi(gr.x), bflo(gr.y), bfhi(gr.y), bflo(gr.z), bfhi(gr.z), bflo(gr.w), bfhi(gr.w)};
            float ss = 0.f;
#pragma unroll
            for (int j = 0; j < 8; ++j) ss += x[j] * x[j];
            ss = row16_sum(ss);
            const float rs = rsqrtf(ss * (1.f / 128.f) + 1e-6f);
#pragma unroll
            for (int j = 0; j < 8; ++j) x[j] = x[j] * rs * ng[d0 + j] * fsilu(g8[j]);
            u32x4 w; w.x = pk2(x[0], x[1]); w.y = pk2(x[2], x[3]); w.z = pk2(x[4], x[5]); w.w = pk2(x[6], x[7]);
            *(u32x4*)(YS + rr * YW + ch) = w; }
        asm volatile("" ::: "memory");
    }
}

__device__ __forceinline__ float row8_sum(float v) {
    v += __builtin_bit_cast(float, __builtin_amdgcn_mov_dpp(__builtin_bit_cast(int, v), 0xB1, 0xF, 0xF, true));
    v += __builtin_bit_cast(float, __builtin_amdgcn_mov_dpp(__builtin_bit_cast(int, v), 0x4E, 0xF, 0xF, true));
    v += __builtin_bit_cast(float, __builtin_amdgcn_mov_dpp(__builtin_bit_cast(int, v), 0x141, 0xF, 0xF, true));
    return v;
}
__device__ __forceinline__ void dsa_prep_unit(const Ctx& c, int layer, int lb, int tt) {
    PHASE_TID();
    const Params& p = *c.p; const bf16_t* P = (const bf16_t*)(p.ws + WS_P);
    bf16_t* DKN = (bf16_t*)(p.ws + WS_DKN) + (size_t)lb * SEQ * 64; bf16_t* DVT = (bf16_t*)(p.ws + WS_DVT) + (size_t)lb * 64 * SEQ;
    bf16_t* DVN = (bf16_t*)(p.ws + WS_VN) + (size_t)lb * SEQ * 64;
    const float* kg = p.in[13] + layer * 64;
    LAS bf16_t* vL = (LAS bf16_t*)c.lds;
    const int t = tid >> 3, pc = tid & 7, tok = tt * 64 + t;
    __syncthreads();
    const bf16_t* src = P + (size_t)(lb * SEQ + tok) * PW;
    const u32x4 kr = *(const u32x4*)(src + C_CK + pc * 8), vr = *(const u32x4*)(src + C_CV + pc * 8);
    float x[8] = {bflo(kr.x), bfhi(kr.x), bflo(kr.y), bfhi(kr.y), bflo(kr.z), bfhi(kr.z), bflo(kr.w), bfhi(kr.w)};
    float ss = 0.f;
#pragma unroll
    for (int k = 0; k < 8; ++k) ss += x[k] * x[k];
    ss = row8_sum(ss);
    const float rs = rsqrtf(ss * (1.f / 64.f) + 1e-6f);
    u32x4 w; w.x = pk2(x[0] * rs * kg[pc * 8 + 0], x[1] * rs * kg[pc * 8 + 1]); w.y = pk2(x[2] * rs * kg[pc * 8 + 2], x[3] * rs * kg[pc * 8 + 3]);
    w.z = pk2(x[4] * rs * kg[pc * 8 + 4], x[5] * rs * kg[pc * 8 + 5]); w.w = pk2(x[6] * rs * kg[pc * 8 + 6], x[7] * rs * kg[pc * 8 + 7]);
    *(u32x4*)(DKN + (size_t)tok * 64 + pc * 8) = w;
    *(u32x4*)(DVN + (size_t)tok * 64 + pc * 8) = vr;
    vL[(pc * 8 + 0) * 72 + t] = (bf16_t)(vr.x & 0xffffu); vL[(pc * 8 + 1) * 72 + t] = (bf16_t)(vr.x >> 16);
    vL[(pc * 8 + 2) * 72 + t] = (bf16_t)(vr.y & 0xffffu); vL[(pc * 8 + 3) * 72 + t] = (bf16_t)(vr.y >> 16);
    vL[(pc * 8 + 4) * 72 + t] = (bf16_t)(vr.z & 0xffffu); vL[(pc * 8 + 5) * 72 + t] = (bf16_t)(vr.z >> 16);
    vL[(pc * 8 + 6) * 72 + t] = (bf16_t)(vr.w & 0xffffu); vL[(pc * 8 + 7) * 72 + t] = (bf16_t)(vr.w >> 16);
    __syncthreads();
    { const int d = tid >> 3; *(u32x4*)(DVT + (size_t)d * SEQ + tt * 64 + pc * 8) = *(const LAS u32x4*)(vL + d * 72 + pc * 8); }
}

__device__ __forceinline__ void dsa1_unit(const Ctx& c, int layer, int lb, int qt) {
    PHASE_TID();
    const Params& p = *c.p; const bf16_t* P = (const bf16_t*)(p.ws + WS_P);
    unsigned short* SEL = (unsigned short*)(p.ws + WS_MASK) + (size_t)lb * SEQ * 256;
    unsigned* MASK = (unsigned*)(p.ws + WS_MASK) + (size_t)lb * SEQ * 128;
    LAS unsigned* hist = (LAS unsigned*)c.lds;
    LAS unsigned short* mk16 = (LAS unsigned short*)(c.lds + 16512);
    LAS float* redL = (LAS float*)(c.lds + 24704);
    LAS int* selL = (LAS int*)(c.lds + 25728);
    const int q = lane >> 4, l15 = lane & 15, t0 = qt * 16, tq = t0 + l15, nb = qt + 1;
    __syncthreads();
    if (qt < 16) {
        const int qq = tid >> 5, wl = tid & 31, t = t0 + qq;
        if (wl <= (t >> 5)) MASK[(size_t)t * 128 + wl] = wl < (t >> 5) ? 0xFFFFFFFFu : (0xFFFFFFFFu >> (31 - (t & 31)));
        return;
    }
    for (int i = tid; i < 2048; i += 512) ((LAS unsigned*)mk16)[i] = 0u;
    const bf16_t* qrow = P + (size_t)(lb * SEQ + tq) * PW;
    LAS bf16_t* iqL = (LAS bf16_t*)(c.lds + 26624);
    LAS h2_t* wqL = (LAS h2_t*)(c.lds + 45312);
    const int qq_ = tid >> 5, pc2_ = tid & 31;
    const u32x4 iqa = *(const u32x4*)(P + (size_t)(lb * SEQ + t0 + qq_) * PW + C_CIQ + pc2_ * 16), iqb = *(const u32x4*)(P + (size_t)(lb * SEQ + t0 + qq_) * PW + C_CIQ + pc2_ * 16 + 8);
    const bf16_t* kbase = P + (size_t)(lb * SEQ) * PW + C_CIK;
    bf16x8 an[2][2];
    { const bf16_t* krow = kbase + (size_t)(wave * 16 + l15) * PW; an[0][0] = ld_frag_g(krow, 0, q); an[0][1] = ld_frag_g(krow, 1, q);
      const bf16_t* kr2 = kbase + (size_t)((wave + 8) * 16 + l15) * PW; an[1][0] = ld_frag_g(kr2, 0, q); an[1][1] = ld_frag_g(kr2, 1, q); }
    const u32x4 wraw2 = *(const u32x4*)(P + (size_t)(lb * SEQ + t0 + qq_) * PW + C_CIW);
    *(LAS u32x4*)(iqL + qq_ * 584 + pc2_ * 16) = iqa; *(LAS u32x4*)(iqL + qq_ * 584 + pc2_ * 16 + 8) = iqb;
    __syncthreads();
    {
        const float w8[8] = {bflo(wraw2.x) * 0.022097086912079608f, bfhi(wraw2.x) * 0.022097086912079608f, bflo(wraw2.y) * 0.022097086912079608f, bfhi(wraw2.y) * 0.022097086912079608f,
                             bflo(wraw2.z) * 0.022097086912079608f, bfhi(wraw2.z) * 0.022097086912079608f, bflo(wraw2.w) * 0.022097086912079608f, bfhi(wraw2.w) * 0.022097086912079608f};
        float c0 = 0.f, c1 = 0.f;
#pragma unroll
        for (int h = 0; h < 8; ++h) { const unsigned v = *(const LAS unsigned*)(iqL + qq_ * 584 + h * 64 + pc2_ * 2); c0 += w8[h] * bflo(v); c1 += w8[h] * bfhi(v); }
        *(LAS unsigned*)(iqL + qq_ * 584 + 512 + pc2_ * 2) = pk2(c0, c1);
        if (pc2_ == 0) {
#pragma unroll
            for (int h = 0; h < 8; ++h) wqL[qq_ * 8 + h] = __builtin_amdgcn_cvt_pkrtz(w8[h], w8[h]); }
    }
    __syncthreads();
    const LAS bf16_t* iqrow = iqL + l15 * 584;
    const LAS h2_t* wqrow = wqL + l15 * 8;
    f32x4 sc[32];
    float mn = 3.0e38f, mx = -3.0e38f;
#ifdef REP_DSA1_SC
#pragma unroll 1
    for (int rep_ = 0; rep_ < 2; ++rep_) { mn = 3.0e38f; mx = -3.0e38f;
    { const bf16_t* krow = kbase + (size_t)(wave * 16 + l15) * PW; an[0][0] = ld_frag_g(krow, 0, q); an[0][1] = ld_frag_g(krow, 1, q);
      const bf16_t* kr2 = kbase + (size_t)((wave + 8) * 16 + l15) * PW; an[1][0] = ld_frag_g(kr2, 0, q); an[1][1] = ld_frag_g(kr2, 1, q); }
#endif
#pragma unroll
    for (int i = 0; i < 32; i += 2) { const int kb = 8 * i + wave;
        sc[i] = (f32x4){0.f, 0.f, 0.f, 0.f}; sc[i + 1] = (f32x4){0.f, 0.f, 0.f, 0.f};
        if (kb < nb) {
            const bf16x8 a00 = an[0][0], a01 = an[0][1], a10 = an[1][0], a11 = an[1][1];
            if (kb + 16 < nb) { const bf16_t* krow = kbase + (size_t)((kb + 16) * 16 + l15) * PW; an[0][0] = ld_frag_g(krow, 0, q); an[0][1] = ld_frag_g(krow, 1, q); }
            if (kb + 24 < nb) { const bf16_t* krow = kbase + (size_t)((kb + 24) * 16 + l15) * PW; an[1][0] = ld_frag_g(krow, 0, q); an[1][1] = ld_frag_g(krow, 1, q); }
            f32x4 tot0, tot1;
            { const bf16x8 c0 = ld_frag_l(iqrow + 512, 0, q), c1 = ld_frag_l(iqrow + 512, 1, q);
              tot0 = mma16(a00, c0, (f32x4){0.f, 0.f, 0.f, 0.f}); tot0 = mma16(a01, c1, tot0); tot1 = mma16(a10, c0, (f32x4){0.f, 0.f, 0.f, 0.f}); tot1 = mma16(a11, c1, tot1); }
            bf16x8 nb0 = ld_frag_l(iqrow, 0, q), nb1 = ld_frag_l(iqrow, 1, q);
            h2_t wn = wqrow[0]; h2_t t16[4] = {(h2_t){0, 0}, (h2_t){0, 0}, (h2_t){0, 0}, (h2_t){0, 0}};
#pragma unroll
            for (int h = 0; h < 8; ++h) { const bf16x8 b0 = nb0, b1 = nb1; const h2_t wh = wn;
                if (h < 7) { nb0 = ld_frag_l(iqrow + (h + 1) * 64, 0, q); nb1 = ld_frag_l(iqrow + (h + 1) * 64, 1, q); wn = wqrow[h + 1]; }
                f32x4 d0 = mma16(a00, b0, (f32x4){0.f, 0.f, 0.f, 0.f}); d0 = mma16(a01, b1, d0);
                f32x4 d1 = mma16(a10, b0, (f32x4){0.f, 0.f, 0.f, 0.f}); d1 = mma16(a11, b1, d1);
                t16[0] += wh * __builtin_elementwise_abs(__builtin_amdgcn_cvt_pkrtz(d0[0], d0[1])); t16[1] += wh * __builtin_elementwise_abs(__builtin_amdgcn_cvt_pkrtz(d0[2], d0[3]));
                t16[2] += wh * __builtin_elementwise_abs(__builtin_amdgcn_cvt_pkrtz(d1[0], d1[1])); t16[3] += wh * __builtin_elementwise_abs(__builtin_amdgcn_cvt_pkrtz(d1[2], d1[3])); }
            tot0[0] += (float)t16[0][0]; tot0[1] += (float)t16[0][1]; tot0[2] += (float)t16[1][0]; tot0[3] += (float)t16[1][1];
            tot1[0] += (float)t16[2][0]; tot1[1] += (float)t16[2][1]; tot1[2] += (float)t16[3][0]; tot1[3] += (float)t16[3][1];
            const f32x4 nan4 = (f32x4){__int_as_float(0x7fc00000), __int_as_float(0x7fc00000), __int_as_float(0x7fc00000), __int_as_float(0x7fc00000)};
            sc[i] = tot0; sc[i + 1] = (kb + 8 < nb) ? tot1 : nan4;
            if (kb + 8 >= qt) {
#pragma unroll
                for (int e = 0; e < 4; ++e) { if (kb * 16 + 4 * q + e > tq) sc[i][e] = __int_as_float(0x7fc00000); if ((kb + 8) * 16 + 4 * q + e > tq) sc[i + 1][e] = __int_as_float(0x7fc00000); } }
#pragma unroll
            for (int e = 0; e < 4; ++e) { mn = fminf(mn, fminf(sc[i][e], sc[i + 1][e])); mx = fmaxf(mx, fmaxf(sc[i][e], sc[i + 1][e])); }
        } else {
#pragma unroll
            for (int e = 0; e < 4; ++e) { sc[i][e] = __int_as_float(0x7fc00000); sc[i + 1][e] = __int_as_float(0x7fc00000); }
        }
    }
#ifdef REP_DSA1_SC
    }
#endif
    mn = fminf(mn, shx(mn, 16, lane)); mn = fminf(mn, shx(mn, 32, lane)); mx = fmaxf(mx, shx(mx, 16, lane)); mx = fmaxf(mx, shx(mx, 32, lane));
    if (q == 0) { redL[(wave * 16 + l15) * 2] = mn; redL[(wave * 16 + l15) * 2 + 1] = mx; }
    __syncthreads();
#pragma unroll
    for (int w = 0; w < 8; ++w) { mn = fminf(mn, redL[(w * 16 + l15) * 2]); mx = fmaxf(mx, redL[(w * 16 + l15) * 2 + 1]); }
    const float scale = mx > mn ? 16777215.0f / (mx - mn) : 0.f;
    const float nms = -mn * scale;
#pragma unroll
    for (int i = 0; i < 32; ++i) {
        if (8 * i + wave < nb) {
#pragma unroll
            for (int e = 0; e < 4; ++e)
                sc[i][e] = __int_as_float((int)__builtin_amdgcn_fmed3f(__builtin_fmaf(sc[i][e], scale, nms), -1.0f, 16777215.0f));
        } else sc[i] = (f32x4){__int_as_float(-1), __int_as_float(-1), __int_as_float(-1), __int_as_float(-1)}; }
    int pref = 0, krem = 256;
#ifdef REP_DSA1_SEL
#pragma unroll 1
    for (int rep_ = 0; rep_ < 2; ++rep_) { pref = 0; krem = 256; __syncthreads();
#endif
#pragma unroll 1
    for (int pass = 0; pass < 3; ++pass) { const int shift = 16 - 8 * pass;
        for (int i = tid; i < 16 * 257; i += 512) hist[i] = 0u;
        __syncthreads();
#pragma unroll
        for (int i = 0; i < 32; ++i) if (8 * i + wave < nb) {
            bool hit[4]; bool anyhit = false;
#pragma unroll
            for (int e = 0; e < 4; ++e) { hit[e] = ((unsigned)__float_as_int(sc[i][e]) >> (shift + 8)) == (unsigned)pref; anyhit |= hit[e]; }
            if (__any(anyhit)) {
#pragma unroll
                for (int e = 0; e < 4; ++e) { const unsigned key = (unsigned)__float_as_int(sc[i][e]);
                    if (hit[e]) __hip_atomic_fetch_add(hist + l15 * 257 + ((key >> shift) & 255u), 1u, __ATOMIC_RELAXED, __HIP_MEMORY_SCOPE_WORKGROUP); } } }
        __syncthreads();
        {
            const int qq = 2 * wave + (lane >> 5), hl = lane & 31; int kr = krem;
            if (pass > 0) kr = selL[qq * 2 + 1];
            unsigned cnt[8]; unsigned s8 = 0;
#pragma unroll
            for (int b = 0; b < 8; ++b) { cnt[b] = hist[qq * 257 + hl * 8 + b]; s8 += cnt[b]; }
            unsigned suf = s8;
#pragma unroll
            for (int o = 1; o < 32; o <<= 1) { const unsigned t2 = (unsigned)__builtin_amdgcn_ds_bpermute((lane + o) << 2, (int)suf); if (hl + o < 32) suf += t2; }
            const unsigned after = suf - s8;
            __syncthreads();
            if (after < (unsigned)kr && (unsigned)kr <= after + s8) { unsigned cum = after; int bsel = 0, knew = 1; bool done = false;
#pragma unroll
                for (int b = 7; b >= 0; --b) { if (!done && cum + cnt[b] >= (unsigned)kr) { bsel = hl * 8 + b; knew = kr - (int)cum; done = true; } cum += cnt[b]; }
                selL[qq * 2] = bsel; selL[qq * 2 + 1] = knew; }
        }
        __syncthreads();
        pref = (pref << 8) | selL[l15 * 2]; krem = selL[l15 * 2 + 1];
    }
#ifdef REP_DSA1_SEL
    }
#endif
#pragma unroll
    for (int i = 0; i < 32; ++i) { const int kb = 8 * i + wave;
        if (kb < nb) { unsigned nib = 0;
#pragma unroll
            for (int e = 0; e < 4; ++e) { const int key = __float_as_int(sc[i][e]); nib |= (key >= pref ? 1u : 0u) << e; }
            unsigned v = nib << (4 * q); v |= shxu(v, 16, lane); v |= shxu(v, 32, lane);
            if (q == 0) mk16[l15 * 256 + kb] = (unsigned short)v; } }
    __syncthreads();
    if (t0 < QSPLIT) {
        const int qq = tid >> 5, wl = tid & 31, t = t0 + qq; const LAS unsigned* mrow = (const LAS unsigned*)(mk16 + qq * 256);
        for (int w4 = wl; w4 <= (t >> 5); w4 += 32) MASK[(size_t)t * 128 + w4] = mrow[w4];
    } else
    {
        const int qq = tid >> 5, wl = tid & 31, t = t0 + qq; const LAS unsigned* mrow = (const LAS unsigned*)(mk16 + qq * 256);
        unsigned w[4]; int cnt = 0;
#pragma unroll
        for (int j = 0; j < 4; ++j) { w[j] = mrow[wl * 4 + j]; cnt += __builtin_popcount(w[j]); }
        int incl = cnt;
#pragma unroll
        for (int o = 1; o < 32; o <<= 1) { const int v = __builtin_amdgcn_ds_bpermute((lane - o) << 2, incl); if (wl >= o) incl += v; }
        int pos = incl - cnt;
        unsigned short* dst = SEL + (size_t)t * 256;
#pragma unroll
        for (int j = 0; j < 4; ++j) { unsigned ww = w[j];
            while (ww) { const int b = __builtin_ctz(ww); ww &= ww - 1u; if (pos < 256) dst[pos] = (unsigned short)((wl * 4 + j) * 32 + b); ++pos; } }
    }
}

__device__ __forceinline__ void dsa2_tile(const Ctx& c, int layer, int lb, int jt) {
    PHASE_TID();
    const Params& p = *c.p; const bf16_t* P = (const bf16_t*)(p.ws + WS_P); bf16_t* YS = (bf16_t*)(p.ws + WS_YS);
    const bf16_t* DKN = (const bf16_t*)(p.ws + WS_DKN) + (size_t)lb * SEQ * 64; const bf16_t* DVT = (const bf16_t*)(p.ws + WS_DVT) + (size_t)lb * 64 * SEQ;
    const unsigned* MASK = (const unsigned*)(p.ws + WS_MASK) + (size_t)lb * SEQ * 128;
    const float* qg = p.in[12] + layer * 64;
    constexpr int KVB = 35840;
    const int q = lane >> 4, l15 = lane & 15, qs = wave & 1, hp = wave >> 1, tq = jt * 32 + qs * 16 + l15, tmaxw = jt * 32 + qs * 16 + 15;
    const size_t row = (size_t)(lb * SEQ + tq);
    const int nck = (jt * 32 + 32 + 127) >> 7;
    bf16x8 qf[2][2];
#pragma unroll
    for (int hh = 0; hh < 2; ++hh) { const int h = hp * 2 + hh; float x[2][8]; float ss = 0.f;
#pragma unroll
        for (int ks = 0; ks < 2; ++ks) { const u32x4 r = *(const u32x4*)(P + row * PW + C_CQ + h * 64 + 32 * ks + 8 * q);
            x[ks][0] = bflo(r.x); x[ks][1] = bfhi(r.x); x[ks][2] = bflo(r.y); x[ks][3] = bfhi(r.y); x[ks][4] = bflo(r.z); x[ks][5] = bfhi(r.z); x[ks][6] = bflo(r.w); x[ks][7] = bfhi(r.w);
#pragma unroll
            for (int k = 0; k < 8; ++k) ss += x[ks][k] * x[ks][k]; }
        ss += shx(ss, 16, lane); ss += shx(ss, 32, lane);
        const float rs = rsqrtf(ss * (1.f / 64.f) + 1e-6f) * (0.125f * 1.4426950408889634f);
#pragma unroll
        for (int ks = 0; ks < 2; ++ks) { const float* gp = qg + 32 * ks + 8 * q; u32x4 w;
            w.x = pk2m(x[ks][0] * rs * gp[0], x[ks][1] * rs * gp[1]); w.y = pk2m(x[ks][2] * rs * gp[2], x[ks][3] * rs * gp[3]);
            w.z = pk2m(x[ks][4] * rs * gp[4], x[ks][5] * rs * gp[5]); w.w = pk2m(x[ks][6] * rs * gp[6], x[ks][7] * rs * gp[7]);
            qf[hh][ks] = __builtin_bit_cast(bf16x8, w); } }
    const float sl2[2] = {exp2f(-(float)(hp * 2 + 1)) * 1.4426950408889634f, exp2f(-(float)(hp * 2 + 2)) * 1.4426950408889634f};
    f32x4 oacc[2][4]; float mrun[2] = {-3.0e38f, -3.0e38f}, lrun[2] = {0.f, 0.f};
#pragma unroll
    for (int hh = 0; hh < 2; ++hh)
#pragma unroll
        for (int d = 0; d < 4; ++d) oacc[hh][d] = (f32x4){0.f, 0.f, 0.f, 0.f};
    u32x4 kreg[2], vreg[2];
#define DSA_LOAD(ck) do { _Pragma("unroll") for (int j = 0; j < 2; ++j) { const int idx = tid + 512 * j; \
        kreg[j] = *(const u32x4*)(DKN + (size_t)((ck) * 128 + (idx >> 3)) * 64 + (idx & 7) * 8); \
        vreg[j] = *(const u32x4*)(DVT + (size_t)(idx >> 4) * SEQ + (ck) * 128 + (idx & 15) * 8); } } while (0)
#define DSA_STORE(buf) do { ldsp_t b_ = c.lds + (buf) * KVB; _Pragma("unroll") for (int j = 0; j < 2; ++j) { const int idx = tid + 512 * j; \
        *(LAS u32x4*)(b_ + (idx >> 3) * 144 + (idx & 7) * 16) = kreg[j]; *(LAS u32x4*)(b_ + 18432 + (idx >> 4) * 272 + (idx & 15) * 16) = vreg[j]; } } while (0)
    __syncthreads();
    DSA_LOAD(0); DSA_STORE(0);
    __syncthreads();
    u32x4 mwn = *(const u32x4*)(MASK + (size_t)tq * 128);
#pragma unroll 1
    for (int ck = 0; ck < nck; ++ck) {
        const u32x4 mwc = mwn;
        if (ck + 1 < nck) { DSA_LOAD(ck + 1); mwn = *(const u32x4*)(MASK + (size_t)tq * 128 + (ck + 1) * 4); }
        ldsp_t b = c.lds + (ck & 1) * KVB; const LAS bf16_t* knL = (const LAS bf16_t*)b; const LAS bf16_t* vtL = (const LAS bf16_t*)(b + 18432);
#pragma unroll
        for (int s2 = 0; s2 < 2; ++s2) { const int key0 = ck * 128 + s2 * 64;
            if (key0 <= tmaxw) {
                unsigned w0 = s2 ? mwc.z : mwc.x, w1 = s2 ? mwc.w : mwc.y;
                w0 = key0 <= tq ? w0 : 0u; w1 = key0 + 32 <= tq ? w1 : 0u;
                bf16x8 ka[4][2];
#pragma unroll
                for (int kt = 0; kt < 4; ++kt)
#pragma unroll
                    for (int ks = 0; ks < 2; ++ks) ka[kt][ks] = ld_frag_l(knL + (s2 * 64 + kt * 16 + l15) * 72, ks, q);
                const float dbase = (float)(key0 + 4 * q - tq);
#pragma unroll
                for (int hh = 0; hh < 2; ++hh) {
                    f32x4 sv[4];
#pragma unroll
                    for (int kt = 0; kt < 4; ++kt) { sv[kt] = mma16(ka[kt][0], qf[hh][0], (f32x4){0.f, 0.f, 0.f, 0.f}); sv[kt] = mma16(ka[kt][1], qf[hh][1], sv[kt]); }
                    float tmax = -3.0e38f;
#pragma unroll
                    for (int kt = 0; kt < 4; ++kt)
#pragma unroll
                        for (int e = 0; e < 4; ++e) { const unsigned wsel = kt < 2 ? w0 : w1; const bool on = (wsel >> ((kt & 1) * 16 + 4 * q + e)) & 1u;
                            const float xv = on ? sv[kt][e] + sl2[hh] * (dbase + (float)(kt * 16 + e)) : -3.0e38f; sv[kt][e] = xv; tmax = fmaxf(tmax, xv); }
                    tmax = fmaxf(tmax, shx(tmax, 16, lane)); tmax = fmaxf(tmax, shx(tmax, 32, lane));
                    const float mnew = fmaxf(mrun[hh], tmax), corr = __builtin_amdgcn_exp2f(mrun[hh] - mnew), muse = fmaxf(mnew, -1.0e30f); mrun[hh] = mnew;
                    float ps = 0.f;
#pragma unroll
                    for (int kt = 0; kt < 4; ++kt)
#pragma unroll
                        for (int e = 0; e < 4; ++e) { const float pe = __builtin_amdgcn_exp2f(sv[kt][e] - muse); sv[kt][e] = pe; ps += pe; }
                    lrun[hh] = lrun[hh] * corr + ps;
                    const bf16x8 pf0 = pack_frag(sv[0], sv[1]), pf1 = pack_frag(sv[2], sv[3]);
                    if (!__all(corr == 1.0f)) {
#pragma unroll
                        for (int d = 0; d < 4; ++d) oacc[hh][d] = oacc[hh][d] * corr; }
#pragma unroll
                    for (int d = 0; d < 4; ++d) { oacc[hh][d] = mma16(ld_frag_perm_l(vtL + (d * 16 + l15) * 136, s2 * 2, q), pf0, oacc[hh][d]);
                        oacc[hh][d] = mma16(ld_frag_perm_l(vtL + (d * 16 + l15) * 136, s2 * 2 + 1, q), pf1, oacc[hh][d]); }
                }
            }
        }
        if (ck + 1 < nck) DSA_STORE((ck + 1) & 1);
        __syncthreads();
    }
#undef DSA_LOAD
#undef DSA_STORE
    u32x2 grd[2][4];
#pragma unroll
    for (int hh = 0; hh < 2; ++hh)
#pragma unroll
        for (int d = 0; d < 4; ++d) grd[hh][d] = *(const u32x2*)(P + row * PW + C_CG + (hp * 2 + hh) * 64 + d * 16 + 4 * q);
    asm volatile("" ::: "memory");
#pragma unroll
    for (int hh = 0; hh < 2; ++hh) { const int h = hp * 2 + hh; float l = lrun[hh]; l += shx(l, 16, lane); l += shx(l, 32, lane); const float inv = frcp(l);
#pragma unroll
        for (int d = 0; d < 4; ++d) { const int ch = h * 64 + d * 16 + 4 * q; const u32x2 gr = grd[hh][d];
            u32x2 w; w.x = pk2(oacc[hh][d][0] * inv * fsilu(bflo(gr.x)), oacc[hh][d][1] * inv * fsilu(bfhi(gr.x))); w.y = pk2(oacc[hh][d][2] * inv * fsilu(bflo(gr.y)), oacc[hh][d][3] * inv * fsilu(bfhi(gr.y)));
            *(u32x2*)(YS + row * YW + 2 * BW + ch) = w; } }
}

__device__ __forceinline__ void dsa2g_unit(const Ctx& c, int layer, int lb, int qb) {
    PHASE_TID();
    const Params& p = *c.p; const bf16_t* P = (const bf16_t*)(p.ws + WS_P); bf16_t* YS = (bf16_t*)(p.ws + WS_YS);
    const bf16_t* DKN = (const bf16_t*)(p.ws + WS_DKN) + (size_t)lb * SEQ * 64; const bf16_t* DVN = (const bf16_t*)(p.ws + WS_VN) + (size_t)lb * SEQ * 64;
    const unsigned short* SEL = (const unsigned short*)(p.ws + WS_MASK) + (size_t)lb * SEQ * 256;
    const float* qg = p.in[12] + layer * 64;
    LAS unsigned short* selW = (LAS unsigned short*)(c.lds + wave * 9216);
    LAS float* PL = (LAS float*)(c.lds + wave * 9216 + 512);
    LAS float* lL = (LAS float*)(c.lds + wave * 9216 + 512 + 8192);
    const int q = lane >> 4, l15 = lane & 15; const bool hv = l15 < 8;
    const float sl2 = hv ? exp2f(-(float)(l15 + 1)) * 1.4426950408889634f : 0.f;
    __syncthreads();
    u32x2 selnext = *(const u32x2*)(SEL + (size_t)(QSPLIT + qb * 64 + wave * 8) * 256 + lane * 4);
#pragma unroll 1
    for (int k = 0; k < 8; ++k) {
        const int t = QSPLIT + qb * 64 + wave * 8 + k; const size_t row = (size_t)(lb * SEQ + t);
        *(LAS u32x2*)(selW + lane * 4) = selnext;
        if (k < 7) selnext = *(const u32x2*)(SEL + (size_t)(t + 1) * 256 + lane * 4);
        u32x4 gr4[2];
#pragma unroll
        for (int tp = 0; tp < 2; ++tp) gr4[tp] = hv ? *(const u32x4*)(P + row * PW + C_CG + l15 * 64 + tp * 32 + 8 * q) : (u32x4){0u, 0u, 0u, 0u};
        bf16x8 qf[2];
        { float x[2][8]; float ss = 0.f;
#pragma unroll
          for (int ks = 0; ks < 2; ++ks) { u32x4 r = (u32x4){0u, 0u, 0u, 0u};
              if (hv) r = *(const u32x4*)(P + row * PW + C_CQ + l15 * 64 + 32 * ks + 8 * q);
              x[ks][0] = bflo(r.x); x[ks][1] = bfhi(r.x); x[ks][2] = bflo(r.y); x[ks][3] = bfhi(r.y); x[ks][4] = bflo(r.z); x[ks][5] = bfhi(r.z); x[ks][6] = bflo(r.w); x[ks][7] = bfhi(r.w);
#pragma unroll
              for (int j = 0; j < 8; ++j) ss += x[ks][j] * x[ks][j]; }
          ss += shx(ss, 16, lane); ss += shx(ss, 32, lane);
          const float rs = rsqrtf(ss * (1.f / 64.f) + 1e-6f) * (0.125f * 1.4426950408889634f);
#pragma unroll
          for (int ks = 0; ks < 2; ++ks) { const float* gp = qg + 32 * ks + 8 * q; u32x4 w;
              w.x = pk2m(x[ks][0] * rs * gp[0], x[ks][1] * rs * gp[1]); w.y = pk2m(x[ks][2] * rs * gp[2], x[ks][3] * rs * gp[3]);
              w.z = pk2m(x[ks][4] * rs * gp[4], x[ks][5] * rs * gp[5]); w.w = pk2m(x[ks][6] * rs * gp[6], x[ks][7] * rs * gp[7]);
              qf[ks] = __builtin_bit_cast(bf16x8, w); } }
        f32x4 s[16];
#pragma unroll
        for (int kg = 0; kg < 16; kg += 8) {
            bf16x8 ka[8][2];
#pragma unroll
            for (int j = 0; j < 8; ++j) { const int idx = selW[(kg + j) * 16 + l15]; const bf16_t* krow = DKN + (size_t)idx * 64; ka[j][0] = ld_frag_g(krow, 0, q); ka[j][1] = ld_frag_g(krow, 1, q); }
            asm volatile("" ::: "memory");
#pragma unroll
            for (int j = 0; j < 8; ++j) { s[kg + j] = mma16(ka[j][0], qf[0], (f32x4){0.f, 0.f, 0.f, 0.f}); s[kg + j] = mma16(ka[j][1], qf[1], s[kg + j]); } }
        float mx = -3.0e38f;
#pragma unroll
        for (int kt = 0; kt < 16; ++kt) { const u32x2 iv = *(const LAS u32x2*)(selW + kt * 16 + 4 * q);
            const int i0 = (int)(iv.x & 0xffffu), i1 = (int)(iv.x >> 16), i2 = (int)(iv.y & 0xffffu), i3 = (int)(iv.y >> 16);
            s[kt][0] += sl2 * (float)(i0 - t); s[kt][1] += sl2 * (float)(i1 - t); s[kt][2] += sl2 * (float)(i2 - t); s[kt][3] += sl2 * (float)(i3 - t);
            mx = fmaxf(fmaxf(fmaxf(s[kt][0], s[kt][1]), fmaxf(s[kt][2], s[kt][3])), mx); }
        mx = fmaxf(mx, shx(mx, 16, lane)); mx = fmaxf(mx, shx(mx, 32, lane));
        float sum = 0.f;
#pragma unroll
        for (int kt = 0; kt < 16; ++kt)
#pragma unroll
            for (int i = 0; i < 4; ++i) { const float e = __builtin_amdgcn_exp2f(s[kt][i] - mx); s[kt][i] = e; sum += e; }
        sum += shx(sum, 16, lane); sum += shx(sum, 32, lane);
        f32x4 oA[2], oB[2];
#pragma unroll
        for (int tp = 0; tp < 2; ++tp) { oA[tp] = (f32x4){0.f, 0.f, 0.f, 0.f}; oB[tp] = (f32x4){0.f, 0.f, 0.f, 0.f}; }
        const bf16_t* vcol = DVN + 2 * l15;
#pragma unroll 1
        for (int kh = 0; kh < 8; kh += 4) {
            unsigned vr[4][2][8];
#pragma unroll
            for (int k4 = 0; k4 < 4; ++k4) { const int ks = kh + k4;
                const u32x2 ia = *(const LAS u32x2*)(selW + 32 * ks + 4 * q), ib = *(const LAS u32x2*)(selW + 32 * ks + 16 + 4 * q);
                const int id[8] = {(int)(ia.x & 0xffffu), (int)(ia.x >> 16), (int)(ia.y & 0xffffu), (int)(ia.y >> 16), (int)(ib.x & 0xffffu), (int)(ib.x >> 16), (int)(ib.y & 0xffffu), (int)(ib.y >> 16)};
#pragma unroll
                for (int j = 0; j < 8; ++j)
#pragma unroll
                    for (int tp = 0; tp < 2; ++tp) vr[k4][tp][j] = *(const unsigned*)(vcol + (size_t)id[j] * 64 + tp * 32); }
            asm volatile("" ::: "memory");
#pragma unroll
            for (int k4 = 0; k4 < 4; ++k4) { const int ks = kh + k4;
                f32x4 p0, p1;
                switch (ks) { case 0: p0 = s[0]; p1 = s[1]; break; case 1: p0 = s[2]; p1 = s[3]; break; case 2: p0 = s[4]; p1 = s[5]; break; case 3: p0 = s[6]; p1 = s[7]; break;
                              case 4: p0 = s[8]; p1 = s[9]; break; case 5: p0 = s[10]; p1 = s[11]; break; case 6: p0 = s[12]; p1 = s[13]; break; default: p0 = s[14]; p1 = s[15]; break; }
                const bf16x8 pf = pack_frag(p0, p1);
#pragma unroll
                for (int tp = 0; tp < 2; ++tp) { u32x4 wa, wb;
                    wa.x = (vr[k4][tp][0] & 0xffffu) | (vr[k4][tp][1] << 16); wa.y = (vr[k4][tp][2] & 0xffffu) | (vr[k4][tp][3] << 16);
                    wa.z = (vr[k4][tp][4] & 0xffffu) | (vr[k4][tp][5] << 16); wa.w = (vr[k4][tp][6] & 0xffffu) | (vr[k4][tp][7] << 16);
                    wb.x = (vr[k4][tp][0] >> 16) | (vr[k4][tp][1] & 0xffff0000u); wb.y = (vr[k4][tp][2] >> 16) | (vr[k4][tp][3] & 0xffff0000u);
                    wb.z = (vr[k4][tp][4] >> 16) | (vr[k4][tp][5] & 0xffff0000u); wb.w = (vr[k4][tp][6] >> 16) | (vr[k4][tp][7] & 0xffff0000u);
                    oA[tp] = mma16(__builtin_bit_cast(bf16x8, wa), pf, oA[tp]); oB[tp] = mma16(__builtin_bit_cast(bf16x8, wb), pf, oB[tp]); } }
        }
        if (hv) { const float inv = frcp(sum);
#pragma unroll
            for (int tp = 0; tp < 2; ++tp) { const int ch = l15 * 64 + tp * 32 + 8 * q; const u32x4 gr = gr4[tp];
                u32x4 w;
                w.x = pk2(oA[tp][0] * inv * fsilu(bflo(gr.x)), oB[tp][0] * inv * fsilu(bfhi(gr.x))); w.y = pk2(oA[tp][1] * inv * fsilu(bflo(gr.y)), oB[tp][1] * inv * fsilu(bfhi(gr.y)));
                w.z = pk2(oA[tp][2] * inv * fsilu(bflo(gr.z)), oB[tp][2] * inv * fsilu(bfhi(gr.z))); w.w = pk2(oA[tp][3] * inv * fsilu(bflo(gr.w)), oB[tp][3] * inv * fsilu(bfhi(gr.w)));
                *(u32x4*)(YS + row * YW + 2 * BW + ch) = w; } }
    }
}

constexpr size_t CTL_QUEUE = 32768;
__device__ __forceinline__ int next_unit(const Ctx& c, int layer, int grp, int stage, int tid) {
    LAS int* slot = (LAS int*)(c.lds + LDS_MISC + 64);
    __syncthreads();
    if (tid == 0) { unsigned* ctr = (unsigned*)(c.p->ws + WS_CTL + CTL_QUEUE) + (size_t)(((layer * NGRP + grp) * 8 + stage) * 64);
        *slot = (int)__hip_atomic_fetch_add(ctr, 1u, __ATOMIC_RELAXED, __HIP_MEMORY_SCOPE_AGENT); }
    __syncthreads();
    return *slot;
}
#define QUEUE_LOOP(stage_, total_) for (int u = next_unit(c, layer, grp, stage_, tid); u < (total_); u = next_unit(c, layer, grp, stage_, tid))
__device__ __forceinline__ void phase_s1(const Ctx& c, int layer, int grp, int rep = 0) {
    PHASE_TID();
    QUEUE_LOOP(0 + 4 * rep, 1536) {
        if (u < 1024) { gdn_pre_unit(c, layer, u >> 8, (u >> 2) & 63, u & 3);
#ifdef REP_U_GDNPRE
            gdn_pre_unit(c, layer, u >> 8, (u >> 2) & 63, u & 3);
#endif
            }
        else if (u < 1280) { const int v = u - 1024; { ssd1_unit(c, layer, v >> 6, (v >> 1) & 31, v & 1);
#ifdef REP_U_SSD1
            ssd1_unit(c, layer, v >> 6, (v >> 1) & 31, v & 1);
#endif
            } }
        else { const int v = u - 1280; { dsa_prep_unit(c, layer, v >> 6, v & 63);
#ifdef REP_U_PREP
            dsa_prep_unit(c, layer, v >> 6, v & 63);
#endif
            } }
    }
}
__device__ __forceinline__ void phase_s2(const Ctx& c, int layer, int grp, int rep = 0) {
    PHASE_TID();
    QUEUE_LOOP(1 + 4 * rep, 32 + 1280) {
        if (u < 32) { gdn_chain(c, layer, u >> 3, (u >> 1) & 3, u & 1);
#ifdef REP_U_CHAIN
            gdn_chain(c, layer, u >> 3, (u >> 1) & 3, u & 1);
#endif
            }
        else { const int v = u - 32;
            if (v < 128) sg_unit(c, layer, v >> 5, v & 31);
            else if (v < 256) { const int w = v - 128; mem_unit(c, layer, grp, w >> 5, (w >> 3) & 3, w & 7);
#ifdef REP_U_MEM
                mem_unit(c, layer, grp, w >> 5, (w >> 3) & 3, w & 7);
#endif
            }
            else { const int w = v - 256; dsa1_unit(c, layer, w & 3, 255 - (w >> 2));
#ifdef REP_U_DSA1
                dsa1_unit(c, layer, w & 3, 255 - (w >> 2));
#endif
            } }
    }
    ssd_scan(c);
}
__device__ __forceinline__ void phase_s3a(const Ctx& c, int layer, int grp, int rep = 0) {
    PHASE_TID();
    constexpr int NGU = (SEQ - QSPLIT) / 64 * GB, NDT = QSPLIT / 32 * GB;
    QUEUE_LOOP(2 + 4 * rep, 128 + NGU + NDT) {
        if (u < 128) ssd3_unit(c, layer, u >> 5, u & 31);
        else if (u < 128 + NGU) { const int v = u - 128; dsa2g_unit(c, layer, v & 3, v >> 2); }
        else { const int v = u - 128 - NGU; dsa2_tile(c, layer, v & 3, QSPLIT / 32 - 1 - (v >> 2)); }
    }
}
__device__ __forceinline__ void phase_s3(const Ctx& c, int layer, int grp) { phase_s3a(c, layer, grp); gdn_post(c, layer);
#ifndef NO_H8
    h8_rows(c);
#endif
}

__global__ void __launch_bounds__(512, 2) hybrid_fwd(Params prm) {
    extern __shared__ __attribute__((aligned(16))) unsigned char lds_raw[];
    Ctx c;
    c.lds = (ldsp_t)lds_raw; c.bid = blockIdx.x; c.wv = __builtin_amdgcn_readfirstlane((int)threadIdx.x >> 6); c.p = &prm;
    for (int u = threadIdx.x; u < (LDS_BYTES - LDS_MISC) / 4; u += 512) ((LAS unsigned*)(c.lds + LDS_MISC))[u] = 0u;
    __syncthreads();
    XcdBarrier bar = xcd_barrier_post((unsigned*)(prm.ws + WS_CTL), (volatile LAS unsigned*)(c.lds + LDS_MISC));
    unsigned char* ws = prm.ws;
    bf16_t* H = (bf16_t*)(ws + WS_H); bf16_t* P = (bf16_t*)(ws + WS_P); bf16_t* YS = (bf16_t*)(ws + WS_YS);
    bf16_t* GS = (bf16_t*)(ws + WS_P);
    bf16_t* MG = (bf16_t*)(ws + WS_GDN);

    for (int layer = 0; layer < DEPTH; ++layer) {
        phase_convert(c, layer);
#ifdef REP_CONV
        xcd_barrier(bar);
        phase_convert(c, layer);
#endif
        if (layer == 0) phase_norm(c, prm.in[0]);
        xcd_barrier(bar);
        for (int grp = 0; grp < NGRP; ++grp) {
            const float* xin = (layer == 0 ? prm.in[0] : (const float*)prm.out) + (size_t)grp * TG * DM;
            float* xout = prm.out + (size_t)grp * TG * DM;
#ifdef REP_NORM
            phase_norm(c, xin);
            xcd_barrier(bar);
#endif
#ifdef REP_BAR
            xcd_barrier(bar); xcd_barrier(bar); xcd_barrier(bar); xcd_barrier(bar);
#endif
#ifdef REP_TEST
            {
                pg8::Gemm g{H, (const bf16_t*)(ws + WS_WIN), TG, 3072, DM, DM, DM, 0, 0}; pg8::StaticOrder S; S.init(TG, 3072, c.G, c.bid);
                EpiStoreBf16<0> E{P, PW, prm.one};
                pg8::gemm_phase<EpiStoreBf16<0>, pg8::StaticOrder>(c.lds, g, S, E, nullptr, c.wv);
            }
            xcd_barrier(bar);
#endif
#if !defined(NO_P1)
#ifdef REP_G1
            for (int rep_ = 0; rep_ < 2; ++rep_)
#endif
            {
                pg8::Gemm g{H, (const bf16_t*)(ws + WS_WIN), TG, PW, DM, DM, DM, 0, 0}; pg8::StaticOrder S; S.init(TG, PW, c.G, c.bid);
                EpiStoreBf16<0> E{P, PW, prm.one};
                pg8::gemm_phase<EpiStoreBf16<0>, pg8::StaticOrder>(c.lds, g, S, E, nullptr, c.wv);
                if (grp == 0) {
                    __syncthreads();
                    pg8::Gemm g2{(const bf16_t*)(ws + WS_MEMN), (const bf16_t*)(ws + WS_WKV), BATCH * MEMLEN, DM, DM, DM, DM, 0, 0}; pg8::StaticOrder S2; S2.init(BATCH * MEMLEN, DM, c.G, (c.bid + 64) & 255);
                    EpiStoreBf16<0> E2{(bf16_t*)(ws + WS_KV), DM, prm.one};
                    pg8::gemm_phase<EpiStoreBf16<0>, pg8::StaticOrder>(c.lds, g2, S2, E2, nullptr, c.wv);
                }
            }
#endif
            xcd_barrier(bar);
            phase_s1(c, layer, grp);
            xcd_barrier(bar);
#ifdef REP_S1
            phase_s1(c, layer, grp, 1);
            xcd_barrier(bar);
#endif
            phase_s2(c, layer, grp);
            xcd_barrier(bar);
#ifdef REP_S2
            phase_s2(c, layer, grp, 1);
            xcd_barrier(bar);
#endif
#ifdef REP_S3
            phase_s3a(c, layer, grp, 1);
            xcd_barrier(bar);
#endif
            phase_s3(c, layer, grp);
            xcd_barrier(bar);
            {
                const int tile = (c.bid & 7) * (c.G / 8) + (c.bid >> 3), pm = tile >> 2, pn = tile & 3;
                EpiGateTile EG{}; EpiMergeTile EY{MG, (const float*)(ws + WS_SMALL) + SM_SSD_RS};
                pg8::gemm_gate_merge<EpiGateTile, EpiMergeTile>(c.lds, (const bf16_t*)(ws + WS_P)  , (const bf16_t*)(ws + WS_WG)  , YS, (const bf16_t*)(ws + WS_WB), pm, pn, EG, EY, c.wv);
#ifdef REP_GY
                __syncthreads();
                pg8::gemm_gate_merge<EpiGateTile, EpiMergeTile>(c.lds, (const bf16_t*)(ws + WS_P)  , (const bf16_t*)(ws + WS_WG)  , YS, (const bf16_t*)(ws + WS_WB), pm, pn, EG, EY, c.wv);
#endif
            }
            xcd_barrier(bar);
#if !defined(NO_P4)
            {
                pg8::Gemm g{MG, (const bf16_t*)(ws + WS_WO), TG, DM, DM, DM, DM, 0, 0}; pg8::StaticOrder S; S.init(TG, DM, c.G, c.bid);
                EpiResid E{xin, xout};
                pg8::gemm_phase<EpiResid, pg8::StaticOrder>(c.lds, g, S, E, nullptr, c.wv);
            }
#endif
            {
                const int nl = grp + 1 < NGRP ? layer : layer + 1, ng = grp + 1 < NGRP ? grp + 1 : 0;
                if (nl < DEPTH) phase_norm(c, (nl == 0 ? prm.in[0] : (const float*)prm.out) + (size_t)ng * TG * DM);
            }
            xcd_barrier(bar);
        }
    }
}
}

extern "C" void kernel_launch(void* const* d_in, const int* in_sizes, int n_in, void* d_out, int out_size, void* d_ws, size_t ws_size, hipStream_t stream) {
    static int grid = 0;
    if (grid == 0) {
        if (n_in != 27 || ws_size < hk::WS_END) { fprintf(stderr, "kernel_launch: expected 27 inputs and >= %zu bytes of workspace, got %d / %zu\n", (size_t)hk::WS_END, n_in, ws_size); grid = -1; return; }
        int dev = 0, cus = 0, per_cu = 0;
        if (hipGetDevice(&dev) != hipSuccess || hipDeviceGetAttribute(&cus, hipDeviceAttributeMultiprocessorCount, dev) != hipSuccess) { grid = -1; return; }
        if (hipFuncSetAttribute((const void*)hk::hybrid_fwd, hipFuncAttributeMaxDynamicSharedMemorySize, hk::LDS_BYTES) != hipSuccess) { fprintf(stderr, "kernel_launch: hipFuncSetAttribute failed\n"); grid = -1; return; }
        if (hipOccupancyMaxActiveBlocksPerMultiprocessor(&per_cu, (const void*)hk::hybrid_fwd, 512, hk::LDS_BYTES) != hipSuccess || per_cu < 1)
            fprintf(stderr, "kernel_launch: occupancy query reports %d workgroups per CU\n", per_cu);
        (void)hipGetLastError();
        if (cus < hk::Ctx::G) { fprintf(stderr, "kernel_launch: built for >= %d CUs, device has %d\n", hk::Ctx::G, cus); grid = -1; return; }
        grid = hk::Ctx::G;
    }
    if (grid < 0) return;
    (void)hipMemsetAsync((char*)d_ws + hk::WS_CTL, 0, hk::CTL_BYTES, stream);
    hk::Params p{};
    for (int i = 0; i < 27; ++i) p.in[i] = (const float*)d_in[i];
    p.out = (float*)d_out; p.ws = (unsigned char*)d_ws; p.one = 1.0f; p.pad = 0;
    hipLaunchKernelGGL(hk::hybrid_fwd, dim3(grid), dim3(512), hk::LDS_BYTES, stream, p);
}
```

```cpp
#include <hip/hip_runtime.h>
#include <cstdio>
#include <cstdint>

#define XB_TMO      128
#define XB_XCNT(j)  (256  + 64 * (j))
#define XB_XSUB(j)  (1280 + 64 * (j))
#define XB_XGEN(j)  (2304 + 64 * (j))
#define XB_TOP      3328
#define XB_TOPGEN   3392
#define XCD_BAR_WORDS 3456
#define XB_SPIN_CAP (1u << 18)
#define LAS __attribute__((address_space(3)))

__device__ __forceinline__ unsigned xb_ld(unsigned* p)              { return __hip_atomic_load(p, __ATOMIC_RELAXED, __HIP_MEMORY_SCOPE_AGENT); }
__device__ __forceinline__ unsigned xb_add(unsigned* p, unsigned v) { return __hip_atomic_fetch_add(p, v, __ATOMIC_RELAXED, __HIP_MEMORY_SCOPE_AGENT); }
__device__ __forceinline__ unsigned xb_xcc_id() { return (unsigned)__builtin_amdgcn_s_getreg((3 << 11) | 20) & 0xFu; }
#define XB_SPIN(cond, bar) do { unsigned _sp = 0; while (cond) { __builtin_amdgcn_s_sleep(1); \
    if ((++_sp & 255u) == 0u) { if (xb_ld(&(bar)[XB_TMO])) break; if (_sp > XB_SPIN_CAP) { atomicAdd(&(bar)[XB_TMO], 1u); break; } } } } while (0)

struct XcdBarrier {
    unsigned* bar; unsigned x;
    volatile LAS unsigned* st;
};

__device__ __forceinline__ XcdBarrier xcd_barrier_post(unsigned* bar, volatile LAS unsigned* st) {
    XcdBarrier b; b.bar = bar; b.x = xb_xcc_id(); b.st = st;
    if (threadIdx.x == 0) (void)xb_add(&bar[XB_XCNT(b.x)], 1u);
    return b;
}
__device__ __forceinline__ void xcd_barrier_complete(unsigned* bar, unsigned x, unsigned& nloc, unsigned& nx) {
    const unsigned G = gridDim.x * gridDim.y * gridDim.z;
    unsigned sum, cnt, mine, sp = 0u;
    for (;;) {
        sum = 0u; cnt = 0u; mine = 0u;
#pragma unroll
        for (unsigned j = 0; j < 16; ++j) { const unsigned c = xb_ld(&bar[XB_XCNT(j)]); sum += c; cnt += (c > 0u) ? 1u : 0u; mine = (j == x) ? c : mine; }
        if (sum == G) break;
        __builtin_amdgcn_s_sleep(1);
        if ((++sp & 255u) == 0u) { if (xb_ld(&bar[XB_TMO])) break; if (sp > XB_SPIN_CAP) { atomicAdd(&bar[XB_TMO], 1u); break; } }
    }
    nloc = mine > 0u ? mine : 1u; nx = cnt > 0u ? cnt : 1u;
}

__device__ __forceinline__ void xcd_barrier(const XcdBarrier& b) {
    asm volatile("s_waitcnt vmcnt(0)" ::: "memory");
    __syncthreads();
    if (threadIdx.x == 0) {
        unsigned* bar = b.bar;
        __builtin_amdgcn_s_waitcnt(0);
        unsigned nloc = b.st[0], nx = b.st[1];
        if (nloc == 0u) { xcd_barrier_complete(bar, b.x, nloc, nx); b.st[0] = nloc; b.st[1] = nx; }
        const unsigned old = xb_add(&bar[XB_XSUB(b.x)], 1u);
        const unsigned gen = old / nloc;
        if (old + 1u == (gen + 1u) * nloc) {
            __builtin_amdgcn_fence(__ATOMIC_RELEASE, "agent");
            asm volatile("s_waitcnt vmcnt(0)" ::: "memory");
            const unsigned og = xb_add(&bar[XB_TOP], 1u);
            const unsigned tg = og / nx;
            if (og + 1u == (tg + 1u) * nx) xb_add(&bar[XB_TOPGEN], 1u);
            else XB_SPIN(xb_ld(&bar[XB_TOPGEN]) == tg, bar);
            __builtin_amdgcn_fence(__ATOMIC_ACQUIRE, "agent");
            xb_add(&bar[XB_XGEN(b.x)], 1u);
            asm volatile("s_waitcnt vmcnt(0)" ::: "memory");
        } else {
            XB_SPIN(xb_ld(&bar[XB_XGEN(b.x)]) == gen, bar);
            __builtin_amdgcn_fence(__ATOMIC_ACQUIRE, "agent");
            asm volatile("s_waitcnt vmcnt(0)" ::: "memory");
        }
    }
    __syncthreads();
}

namespace pg8 {
#define PG8_LAS __attribute__((address_space(3)))
typedef unsigned short bf16_t;
typedef short bf16x8 __attribute__((ext_vector_type(8)));
typedef float f32x4 __attribute__((ext_vector_type(4)));
typedef unsigned u32x4 __attribute__((ext_vector_type(4)));
typedef int i32x8 __attribute__((ext_vector_type(8)));
typedef short bf16x16 __attribute__((ext_vector_type(16)));
constexpr int BM = 256, BK = 64, HALF = 128, HTB = HALF * BK * 2  , STAGE_BYTES = 8 * HTB, NXCD = 8, WGM = 8;

__host__ __device__ __forceinline__ int lds_byte(int r, int c) { const int st = (r >> 4) * 2 + (c >> 5), rr = r & 15, cc = c & 31, ob = rr * 64 + cc * 2; return st * 1024 + (ob ^ (((ob >> 9) & 1) << 5)); }
__host__ __device__ __forceinline__ void stage_rc(int b, int& R, int& C) { const int st = b / 1024, sb = b % 1024, swz = sb ^ (((sb >> 9) & 1) << 5); R = (st >> 1) * 16 + swz / 64; C = (st & 1) * 32 + (swz % 64) / 2; }
__host__ __device__ __forceinline__ int perm32(int rho) { const int n = rho >> 4, i = rho & 15; return 8 * (i >> 2) + 4 * n + (i & 3); }

struct Unit { int pm, pn, pz; };
struct Gemm { const bf16_t* A; const bf16_t* Bt; int M, N, K, lda, ldb; size_t a_z, b_z; };

struct StaticOrder {
    int nM, nN, nwg, G, c;
    __host__ __device__ void init(int M, int N, int G_, int c_) { nM = M / BM; nN = N / BM; nwg = nM * nN; G = G_; c = c_; }
    __host__ __device__ bool next(int i, Unit& u) const {
        const long L = (long)i * G + c; if (L >= nwg) return false;
        int wgid = (int)L; { const int q = nwg / NXCD, r = nwg % NXCD, xcd = wgid % NXCD, off = wgid / NXCD; wgid = (xcd < r ? xcd * (q + 1) : r * (q + 1) + (xcd - r) * q) + off; }
        const int nig = WGM * nN, gid = wgid / nig, fm = gid * WGM, gsz = (nM - fm) < WGM ? (nM - fm) : WGM;
        u.pm = fm + ((wgid % nig) % gsz); u.pn = (wgid % nig) / gsz; u.pz = 0; return true;
    }
    __device__ __forceinline__ void a_ready(const Unit&) const {}
    __device__ __forceinline__ void done(const Unit&) const {}
};
struct CountedOrder : StaticOrder {
    const unsigned* ready; unsigned need; unsigned* tmo;
    __device__ __forceinline__ void a_ready(const Unit& u) const {
        if (threadIdx.x < 64) {
            const unsigned long long t0 = __builtin_amdgcn_s_memrealtime(); unsigned polls = 0;
            while ((unsigned)__builtin_amdgcn_readfirstlane(__hip_atomic_load(ready + 64 * u.pm, __ATOMIC_RELAXED, __HIP_MEMORY_SCOPE_AGENT)) < need) {
                if ((++polls & 255u) == 0u && __builtin_amdgcn_readfirstlane(__hip_atomic_load(tmo, __ATOMIC_RELAXED, __HIP_MEMORY_SCOPE_AGENT)) != 0u) break;
                if (__builtin_amdgcn_s_memrealtime() - t0 > 2000000ull) {
                    if (threadIdx.x == 0) { unsigned expect = 0u; __hip_atomic_compare_exchange_strong(tmo + 1, &expect, 0x600u | (unsigned)(u.pm & 0xff), __ATOMIC_RELAXED, __ATOMIC_RELAXED, __HIP_MEMORY_SCOPE_AGENT); __hip_atomic_store(tmo, 1u, __ATOMIC_RELAXED, __HIP_MEMORY_SCOPE_AGENT); }
                    break; }
                __builtin_amdgcn_s_sleep(2); }
            __builtin_amdgcn_fence(__ATOMIC_ACQUIRE, "agent");
            asm volatile("s_waitcnt vmcnt(0)" ::: "memory");
        }
#if !defined(BROKEN_HOOK_NO_BARRIER)
        asm volatile("" ::: "memory"); __builtin_amdgcn_s_barrier(); asm volatile("" ::: "memory");
#endif
    }
};

__device__ __forceinline__ unsigned cvt_pk_bf16(float lo, float hi) { unsigned r; asm volatile("v_cvt_pk_bf16_f32 %0, %1, %2" : "=v"(r) : "v"(lo), "v"(hi)); return r; }
typedef float f32x2 __attribute__((ext_vector_type(2)));
__device__ __forceinline__ f32x2 gelu_pk(f32x2 v) {
    const f32x2 av = __builtin_elementwise_abs(v), d = av * 0.2316418882f + 1.0f;
    f32x2 t; t.x = __builtin_amdgcn_rcpf(d.x); t.y = __builtin_amdgcn_rcpf(d.y);
    f32x2 q = t * 0.5307027145f + (-0.7265760135f); q = q * t + 0.7107068705f; q = q * t + (-0.142248368f); q = q * t + 0.127414796f; q = q * t;
    const f32x2 s = (v * v) * (-0.72134752044f);
    f32x2 e; e.x = __builtin_amdgcn_exp2f(s.x); e.y = __builtin_amdgcn_exp2f(s.y);
    const f32x2 m = v * (q * e), r = v - m;
    f32x2 o; o.x = v.x < 0.f ? m.x : r.x; o.y = v.y < 0.f ? m.y : r.y; return o;
}

template <class Epi, class Sched, bool STAMP = false>
__device__ __forceinline__ void gemm_phase(PG8_LAS unsigned char* lds, const Gemm g, const Sched& S, const Epi& E, unsigned long long* stamps, int wave_uniform) {
    int tid_; asm volatile("v_mbcnt_lo_u32_b32 %0, -1, 0\n\tv_mbcnt_hi_u32_b32 %0, -1, %0" : "=v"(tid_)); tid_ += wave_uniform * 64;
    const int tid = tid_, wid = __builtin_amdgcn_readfirstlane(tid >> 6), lane = tid & 63, wr = wid >> 2, wc = wid & 3, fr = lane & 15, fq = lane >> 4;
    const int K = g.K, nt = K / BK;
    int ts_lo = 0, ts_hi = 0, nts = 0; const unsigned long long rt_entry = STAMP ? (unsigned long long)wall_clock64() : 0ull;
#define PG8_STAMP() do { if (STAMP && wid == 0 && nts < 64) { const unsigned long long _c = (unsigned long long)clock64(); \
        ts_lo = (lane == nts) ? (int)(unsigned)_c : ts_lo; ts_hi = (lane == nts) ? (int)(unsigned)(_c >> 32) : ts_hi; ++nts; } } while (0)
    PG8_STAMP();
    unsigned voffA[2], voffB[2];
#pragma unroll
    for (int i = 0; i < 2; ++i) { int R, C; stage_rc(tid * 16 + i * 8192, R, C); const int Rb = Epi::PERM ? ((R & ~31) + perm32(R & 31)) : R;
        voffA[i] = (unsigned)(R * g.lda + C) * 2u; voffB[i] = (unsigned)(Rb * g.ldb + C) * 2u; }
    const size_t kstep = (size_t)(BK * 2);
    const size_t hstepA = (size_t)HALF * g.lda * 2, hstepB = (size_t)HALF * g.ldb * 2;
    const size_t tstepA = 2 * hstepA, tstepB = 2 * hstepB;
    const unsigned ldsw = (unsigned)wid * 1024u;
    const int aoff = lds_byte(wr * 64 + fr, fq * 8), boff = lds_byte(wc * 32 + fr, fq * 8);
#define PG8_SA(b, h) (((b) * 2 + (h)) * HTB)
#define PG8_SB(b, h) ((4 + (b) * 2 + (h)) * HTB)
#define PG8_STAGE(bufoff, gbase, voff) do { const char* gb_ = (const char*)(gbase); asm volatile("" : "+s"(gb_));     \
        _Pragma("unroll") for (int _i = 0; _i < 2; ++_i) { unsigned vo_ = (voff)[_i]; asm volatile("" : "+v"(vo_)); \
        __builtin_amdgcn_global_load_lds((const unsigned*)(gb_ + vo_), (PG8_LAS unsigned*)(lds + (bufoff) + ldsw + _i * 8192), 16, 0, 0); } } while (0)
#define PG8_LDA(dst, b, h) do { _Pragma("unroll") for (int m = 0; m < 4; ++m) _Pragma("unroll") for (int k = 0; k < 2; ++k) dst[m][k] = *(const PG8_LAS bf16x8*)(lds + PG8_SA(b, h) + aoff + m * 2048 + k * 1024); } while (0)
#define PG8_LDB(dst, b, h) do { _Pragma("unroll") for (int n = 0; n < 2; ++n) _Pragma("unroll") for (int k = 0; k < 2; ++k) dst[n][k] = *(const PG8_LAS bf16x8*)(lds + PG8_SB(b, h) + boff + n * 2048 + k * 1024); } while (0)
#define PG8_MMA(ai, bj, At, Bt) do { __builtin_amdgcn_s_setprio(1); _Pragma("unroll") for (int m = 0; m < 4; ++m) _Pragma("unroll") for (int n = 0; n < 2; ++n) _Pragma("unroll") for (int k = 0; k < 2; ++k) \
        acc[ai][bj][m][n] = __builtin_amdgcn_mfma_f32_16x16x32_bf16(Bt[n][k], At[m][k], acc[ai][bj][m][n], 0, 0, 0); __builtin_amdgcn_s_setprio(0); } while (0)
#define PG8_WAIT_V(n) asm volatile("s_waitcnt vmcnt(" #n ")" ::: "memory")
#define PG8_WAIT_L(n) asm volatile("s_waitcnt lgkmcnt(" #n ")" ::: "memory")
#define PG8_BAR __builtin_amdgcn_s_barrier()
#define PG8_SCHED __builtin_amdgcn_sched_barrier(0)
    Unit cur, nxt; int ui = 0;
    if (!S.next(0, cur)) return;
    f32x4 acc[2][2][4][2];
#pragma unroll
    for (int a = 0; a < 2; ++a)
#pragma unroll
        for (int b = 0; b < 2; ++b)
#pragma unroll
            for (int m = 0; m < 4; ++m)
#pragma unroll
                for (int n = 0; n < 2; ++n) acc[a][b][m][n] = (f32x4){0.f, 0.f, 0.f, 0.f};
    bf16x8 At[4][2], B0[2][2], B1[2][2];
    const char* cA = (const char*)g.A + (size_t)cur.pm * tstepA + (size_t)cur.pz * g.a_z * 2; const char* cB = (const char*)g.Bt + (size_t)cur.pn * tstepB + (size_t)cur.pz * g.b_z * 2;
    S.a_ready(cur);
    PG8_STAGE(PG8_SB(0, 0), cB, voffB); PG8_STAGE(PG8_SA(0, 0), cA, voffA); PG8_STAGE(PG8_SB(0, 1), cB + hstepB, voffB); PG8_STAGE(PG8_SA(0, 1), cA + hstepA, voffA);
    if (wr == 1) PG8_BAR;
    PG8_WAIT_V(4); PG8_BAR;
    PG8_STAGE(PG8_SB(1, 0), cB + kstep, voffB); PG8_STAGE(PG8_SA(1, 0), cA + kstep, voffA); PG8_STAGE(PG8_SB(1, 1), cB + hstepB + kstep, voffB);
    PG8_WAIT_V(6); PG8_BAR;
    PG8_STAMP();
    for (;;) {
        const bool has_next = S.next(ui + 1, nxt);
        const char* nA = has_next ? (const char*)g.A + (size_t)nxt.pm * tstepA + (size_t)nxt.pz * g.a_z * 2 : cA; const char* nB = has_next ? (const char*)g.Bt + (size_t)nxt.pn * tstepB + (size_t)nxt.pz * g.b_z * 2 : cB;
        for (int t = 0; t < nt; t += 2) {
            const bool last = (t == nt - 2);
            const char* a1 = cA + (size_t)(t + 1) * kstep;
            const char* a2 = last ? nA : cA + (size_t)(t + 2) * kstep; const char* b2 = last ? nB : cB + (size_t)(t + 2) * kstep;
            const char* a3 = a2 + kstep; const char* b3 = b2 + kstep;
            if (last && has_next) S.a_ready(nxt);
            PG8_LDB(B0, 0, 0); PG8_SCHED; PG8_LDA(At, 0, 0); PG8_STAGE(PG8_SA(1, 1), a1 + hstepA, voffA);
            PG8_WAIT_L(8); PG8_BAR; PG8_WAIT_L(0); PG8_MMA(0, 0, At, B0); PG8_BAR; PG8_SCHED;
            PG8_LDB(B1, 0, 1); PG8_STAGE(PG8_SB(0, 0), b2, voffB);
            PG8_BAR; PG8_WAIT_L(0); PG8_MMA(0, 1, At, B1); PG8_BAR;
            PG8_LDA(At, 0, 1); PG8_STAGE(PG8_SA(0, 0), a2, voffA);
            PG8_BAR; PG8_WAIT_L(0); PG8_MMA(1, 0, At, B0); PG8_BAR; PG8_SCHED;
            PG8_STAGE(PG8_SB(0, 1), b2 + hstepB, voffB);
            PG8_WAIT_V(6); PG8_BAR; PG8_MMA(1, 1, At, B1); PG8_BAR;
            PG8_LDB(B0, 1, 0); PG8_SCHED; PG8_LDA(At, 1, 0); PG8_STAGE(PG8_SA(0, 1), a2 + hstepA, voffA);
            PG8_WAIT_L(8); PG8_BAR; PG8_WAIT_L(0); PG8_MMA(0, 0, At, B0); PG8_BAR; PG8_SCHED;
            PG8_LDB(B1, 1, 1); PG8_STAGE(PG8_SB(1, 0), b3, voffB);
            PG8_BAR; PG8_WAIT_L(0); PG8_MMA(0, 1, At, B1); PG8_BAR;
            PG8_LDA(At, 1, 1); PG8_STAGE(PG8_SA(1, 0), a3, voffA);
            PG8_BAR; PG8_WAIT_L(0); PG8_MMA(1, 0, At, B0); PG8_BAR; PG8_SCHED;
            PG8_STAGE(PG8_SB(1, 1), b3 + hstepB, voffB);
            PG8_WAIT_V(6); PG8_BAR; PG8_MMA(1, 1, At, B1); PG8_BAR;
        }
        PG8_STAMP();
        if constexpr (!Epi::AFTER_DRAIN) { E(acc, cur, wr, wc, fr, fq); S.done(cur); }
        PG8_STAMP();
        if (!has_next) break;
#pragma unroll
        for (int a = 0; a < 2; ++a)
#pragma unroll
            for (int b = 0; b < 2; ++b)
#pragma unroll
                for (int m = 0; m < 4; ++m)
#pragma unroll
                    for (int n = 0; n < 2; ++n) acc[a][b][m][n] = (f32x4){0.f, 0.f, 0.f, 0.f};
        cur = nxt; cA = nA; cB = nB; ++ui;
    }
    PG8_WAIT_V(0);
    if (wr == 0) PG8_BAR;
    PG8_BAR;
    if constexpr (Epi::AFTER_DRAIN) { E.fused(acc, cur, wr, wc, fr, fq, lds, wid, lane); S.done(cur); }
    PG8_STAMP();
    if (STAMP && wid == 0) { stamps[lane] = lane < nts ? (((unsigned long long)(unsigned)ts_hi << 32) | (unsigned)ts_lo) : 0ull;
        if (lane == 62) stamps[62] = rt_entry; if (lane == 63) stamps[63] = (unsigned long long)wall_clock64(); }
#undef PG8_STAMP
#undef PG8_SA
#undef PG8_SB
#undef PG8_STAGE
#undef PG8_LDA
#undef PG8_LDB
#undef PG8_MMA
#undef PG8_WAIT_V
#undef PG8_WAIT_L
#undef PG8_BAR
#undef PG8_SCHED
}
#define PG8_KLOOPX(NT_, VA_C, VB_C, HSA_C, HSB_C, VA_N, VB_N, HSA_N, HSB_N, LDA_, LDB_, MMA_) \
        for (int t = 0; t < NT_; t += 2) { \
            const bool last = (t == NT_ - 2); \
            const size_t hA2 = last ? HSA_N : HSA_C, hB2 = last ? HSB_N : HSB_C; \
            const unsigned vA2 = last ? VA_N : VA_C, vB2 = last ? VB_N : VB_C; \
            const char* a1 = cA + (size_t)(t + 1) * kstep; \
            const char* a2 = last ? nA : cA + (size_t)(t + 2) * kstep; const char* b2 = last ? nB : cB + (size_t)(t + 2) * kstep; \
            const char* a3 = a2 + kstep; const char* b3 = b2 + kstep; \
            LDB_(B0, 0, 0); PG8_SCHED; LDA_(At, 0, 0); PG8_STAGE(PG8_SA(1, 1), a1 + HSA_C, VA_C, HSA_C); \
            PG8_WAIT_L(8); PG8_BAR; PG8_WAIT_L(0); MMA_(0, 0, At, B0); PG8_BAR; PG8_SCHED; \
            LDB_(B1, 0, 1); PG8_STAGE(PG8_SB(0, 0), b2, vB2, hB2); \
            PG8_BAR; PG8_WAIT_L(0); MMA_(0, 1, At, B1); PG8_BAR; \
            LDA_(At, 0, 1); PG8_STAGE(PG8_SA(0, 0), a2, vA2, hA2); \
            PG8_BAR; PG8_WAIT_L(0); MMA_(1, 0, At, B0); PG8_BAR; PG8_SCHED; \
            PG8_STAGE(PG8_SB(0, 1), b2 + hB2, vB2, hB2); \
            PG8_WAIT_V(6); PG8_BAR; MMA_(1, 1, At, B1); PG8_BAR; \
            LDB_(B0, 1, 0); PG8_SCHED; LDA_(At, 1, 0); PG8_STAGE(PG8_SA(0, 1), a2 + hA2, vA2, hA2); \
            PG8_WAIT_L(8); PG8_BAR; PG8_WAIT_L(0); MMA_(0, 0, At, B0); PG8_BAR; PG8_SCHED; \
            LDB_(B1, 1, 1); PG8_STAGE(PG8_SB(1, 0), b3, vB2, hB2); \
            PG8_BAR; PG8_WAIT_L(0); MMA_(0, 1, At, B1); PG8_BAR; \
            LDA_(At, 1, 1); PG8_STAGE(PG8_SA(1, 0), a3, vA2, hA2); \
            PG8_BAR; PG8_WAIT_L(0); MMA_(1, 0, At, B0); PG8_BAR; PG8_SCHED; \
            PG8_STAGE(PG8_SB(1, 1), b3 + hB2, vB2, hB2); \
            PG8_WAIT_V(6); PG8_BAR; MMA_(1, 1, At, B1); PG8_BAR; \
        }

template <class EpiG, class EpiY>
__device__ __forceinline__ void gemm_gate_merge(PG8_LAS unsigned char* lds, const bf16_t* H, const bf16_t* WG, const bf16_t* YS, const bf16_t* WB, int pm, int pn, const EpiG& EG, const EpiY& EY, int wave_uniform) {
    int tid_; asm volatile("v_mbcnt_lo_u32_b32 %0, -1, 0\n\tv_mbcnt_hi_u32_b32 %0, -1, %0" : "=v"(tid_)); tid_ += wave_uniform * 64;
    const int tid = tid_, wid = __builtin_amdgcn_readfirstlane(tid >> 6), lane = tid & 63, wr = wid >> 2, wc = wid & 3, fr = lane & 15, fq = lane >> 4;
    constexpr int LDA0B = 15872, LDB0B = 1024, NT0 = 8, LDA1 = 2560, LDB1 = 512, NT1 = 8;
    unsigned voffA0, voffB0, voffA1, voffB1;
    { int R, C; stage_rc(tid * 16, R, C); const int Rb = (R & ~31) + perm32(R & 31);
        voffA0 = (unsigned)(R * LDA0B + C * 2); voffB0 = (unsigned)(Rb * LDB0B + C * 2); voffA1 = (unsigned)(R * LDA1 + C) * 2u; voffB1 = (unsigned)(Rb * LDB1 + C) * 2u; }
    const size_t kstep = (size_t)(BK * 2);
    constexpr size_t hsA0 = (size_t)HALF * LDA0B, hsB0 = (size_t)HALF * LDB0B, hsA1 = (size_t)HALF * LDA1 * 2, hsB1 = (size_t)HALF * LDB1 * 2;
    const unsigned ldsw = (unsigned)wid * 1024u;
#define PG8_SA(b, h) (((b) * 2 + (h)) * HTB)
#define PG8_SB(b, h) ((4 + (b) * 2 + (h)) * HTB)
#define PG8_STAGE(bufoff, gbase, voff, hs) do { _Pragma("unroll") for (int _i = 0; _i < 2; ++_i) { \
        const char* gb_ = (const char*)(gbase) + _i * ((hs) / 2); asm volatile("" : "+s"(gb_));     \
        unsigned vo_ = (voff); asm volatile("" : "+v"(vo_));                                       \
        __builtin_amdgcn_global_load_lds((const unsigned*)(gb_ + vo_), (PG8_LAS unsigned*)(lds + (bufoff) + ldsw + _i * 8192), 16, 0, 0); } } while (0)
#define PG8_LDA(dst, b, h) do { _Pragma("unroll") for (int m = 0; m < 4; ++m) _Pragma("unroll") for (int k = 0; k < 2; ++k) dst[m][k] = *(const PG8_LAS bf16x8*)(lds + PG8_SA(b, h) + aoff + m * 2048 + k * 1024); } while (0)
#define PG8_LDA8(dst, b, h) do { _Pragma("unroll") for (int m = 0; m < 4; ++m) _Pragma("unroll") for (int k = 0; k < 2; ++k) dst[m][k] = *(const PG8_LAS bf16x8*)(lds + PG8_SA(b, h) + aoff8 + m * 2048 + k * 16); } while (0)
#define PG8_LDB8(dst, b, h) do { _Pragma("unroll") for (int n = 0; n < 2; ++n) _Pragma("unroll") for (int k = 0; k < 2; ++k) dst[n][k] = *(const PG8_LAS bf16x8*)(lds + PG8_SB(b, h) + boff8 + n * 2048 + k * 16); } while (0)
#define PG8_CAT8(x) __builtin_bit_cast(i32x8, (bf16x16){x[0][0], x[0][1], x[0][2], x[0][3], x[0][4], x[0][5], x[0][6], x[0][7], x[1][0], x[1][1], x[1][2], x[1][3], x[1][4], x[1][5], x[1][6], x[1][7]})
#define PG8_MMA8(ai, bj, At, Bt) do { __builtin_amdgcn_s_setprio(1); _Pragma("unroll") for (int m = 0; m < 4; ++m) _Pragma("unroll") for (int n = 0; n < 2; ++n) \
        acc[ai][bj][m][n] = __builtin_amdgcn_mfma_scale_f32_16x16x128_f8f6f4(PG8_CAT8(Bt[n]), PG8_CAT8(At[m]), acc[ai][bj][m][n], 0, 0, 0, 0, 0, 0  ); __builtin_amdgcn_s_setprio(0); } while (0)
#define PG8_LDB(dst, b, h) do { _Pragma("unroll") for (int n = 0; n < 2; ++n) _Pragma("unroll") for (int k = 0; k < 2; ++k) dst[n][k] = *(const PG8_LAS bf16x8*)(lds + PG8_SB(b, h) + boff + n * 2048 + k * 1024); } while (0)
#define PG8_MMA(ai, bj, At, Bt) do { __builtin_amdgcn_s_setprio(1); _Pragma("unroll") for (int m = 0; m < 4; ++m) _Pragma("unroll") for (int n = 0; n < 2; ++n) _Pragma("unroll") for (int k = 0; k < 2; ++k) \
        acc[ai][bj][m][n] = __builtin_amdgcn_mfma_f32_16x16x32_bf16(Bt[n][k], At[m][k], acc[ai][bj][m][n], 0, 0, 0); __builtin_amdgcn_s_setprio(0); } while (0)
#define PG8_WAIT_V(n) asm volatile("s_waitcnt vmcnt(" #n ")" ::: "memory")
#define PG8_WAIT_L(n) asm volatile("s_waitcnt lgkmcnt(" #n ")" ::: "memory")
#define PG8_BAR __builtin_amdgcn_s_barrier()
#define PG8_SCHED __builtin_amdgcn_sched_barrier(0)
#define PG8_ZERO_ACC() do { _Pragma("unroll") for (int a = 0; a < 2; ++a) _Pragma("unroll") for (int b = 0; b < 2; ++b) _Pragma("unroll") for (int m = 0; m < 4; ++m) _Pragma("unroll") for (int n = 0; n < 2; ++n) acc[a][b][m][n] = (f32x4){0.f, 0.f, 0.f, 0.f}; } while (0)
    f32x4 acc[2][2][4][2];
    PG8_ZERO_ACC();
    bf16x8 At[4][2], B0[2][2], B1[2][2];
    unsigned gk[32];
    const char* gA = (const char*)H + (size_t)pm * 2 * hsA0; const char* yA0 = (const char*)YS + (size_t)pm * 2 * hsA1;
    const char* gB0 = (const char*)WG + (size_t)pn * 2 * hsB0; const char* yB0 = (const char*)WB + (size_t)pn * 2 * hsB1;
    const char* cA = gA; const char* cB = gB0;
    PG8_STAGE(PG8_SB(0, 0), cB, voffB0, hsB0); PG8_STAGE(PG8_SA(0, 0), cA, voffA0, hsA0); PG8_STAGE(PG8_SB(0, 1), cB + hsB0, voffB0, hsB0); PG8_STAGE(PG8_SA(0, 1), cA + hsA0, voffA0, hsA0);
    if (wr == 1) PG8_BAR;
    PG8_WAIT_V(4); PG8_BAR;
    PG8_STAGE(PG8_SB(1, 0), cB + kstep, voffB0, hsB0); PG8_STAGE(PG8_SA(1, 0), cA + kstep, voffA0, hsA0); PG8_STAGE(PG8_SB(1, 1), cB + hsB0 + kstep, voffB0, hsB0);
    PG8_WAIT_V(6); PG8_BAR;
#pragma unroll 1
    for (int pz = 0; pz < 5; ++pz) {
        Unit cur; cur.pm = pm; cur.pn = pn; cur.pz = pz;
        {
            const char* nA = yA0 + (size_t)pz * 512 * 2; const char* nB = yB0 + (size_t)pz * 1024 * 512 * 2;
            int fr1 = fr, fq1 = fq; asm volatile("" : "+v"(fr1), "+v"(fq1));
            const int aoff8 = lds_byte(wr * 64 + fr1, fq1 * 16), boff8 = lds_byte(wc * 32 + fr1, fq1 * 16);
            PG8_KLOOPX(NT0, voffA0, voffB0, hsA0, hsB0, voffA1, voffB1, hsA1, hsB1, PG8_LDA8, PG8_LDB8, PG8_MMA8)
            EG(acc, gk);
            PG8_ZERO_ACC();
            cA = nA; cB = nB;
        }
        {
            const char* nA = gA; const char* nB = gB0 + (size_t)(pz < 4 ? pz + 1 : 0) * 1024 * 1024;
            int fr1 = fr, fq1 = fq; asm volatile("" : "+v"(fr1), "+v"(fq1));
            const int aoff = lds_byte(wr * 64 + fr1, fq1 * 8), boff = lds_byte(wc * 32 + fr1, fq1 * 8);
            PG8_KLOOPX(NT1, voffA1, voffB1, hsA1, hsB1, voffA0, voffB0, hsA0, hsB0, PG8_LDA, PG8_LDB, PG8_MMA)
            { int fr2 = fr, fq2 = fq; asm volatile("" : "+v"(fr2), "+v"(fq2)); EY(acc, gk, cur, wr, wc, fr2, fq2); }
            PG8_ZERO_ACC();
            cA = nA; cB = nB;
        }
    }
    PG8_WAIT_V(0);
    if (wr == 0) PG8_BAR;
    PG8_BAR;
#undef PG8_ZERO_ACC
#undef PG8_LDA8
#undef PG8_LDB8
#undef PG8_CAT8
#undef PG8_MMA8
#undef PG8_SA
#undef PG8_SB
#undef PG8_STAGE
#undef PG8_LDA
#undef PG8_LDB
#undef PG8_MMA
#undef PG8_WAIT_V
#undef PG8_WAIT_L
#undef PG8_BAR
#undef PG8_SCHED
}
#undef PG8_KLOOPX
}


namespace hk {
typedef pg8::bf16_t bf16_t;
typedef pg8::bf16x8 bf16x8;
typedef pg8::f32x4 f32x4;
typedef pg8::u32x4 u32x4;
typedef unsigned u32x2 __attribute__((ext_vector_type(2)));
typedef float f32x2 __attribute__((ext_vector_type(2)));
typedef __fp16 h2_t __attribute__((ext_vector_type(2)));

constexpr int BATCH = 8, SEQ = 4096, DM = 1024, DEPTH = 2, MEMLEN = 256, BW = 512;
constexpr int T_ALL = BATCH * SEQ;
constexpr int GB = 4;
constexpr int NGRP = BATCH / GB;
constexpr int TG = GB * SEQ;
constexpr int IN_COLS = 7896;
constexpr int PW = 7936;
constexpr int C_AQ = 0, C_AK = 512, C_AV = 1024, C_AG = 1536;
constexpr int C_BU = 2048, C_BV = 2560, C_BG = 3072;
constexpr int C_CQ = 3584, C_CIQ = 4096, C_CG = 4608, C_CK = 5120, C_CV = 5184, C_CIK = 5248, C_CIW = 5312, C_AA = 5320, C_AB = 5324, C_DDT = 5328;
constexpr int C_DZ = 5376, C_DX = 5888, C_DB = 6400, C_DC = 6656;
constexpr int C_MQ = 6912, C_MG = 7424;
constexpr int YW = 5 * BW;
constexpr int GW = 5 * DM;

constexpr size_t WS_CTL  = 0;
constexpr size_t CTL_BYTES = 65536;
constexpr size_t WS_WIN  = WS_CTL + CTL_BYTES;
constexpr size_t WS_WG   = WS_WIN + (size_t)PW * DM * 2;
constexpr size_t WS_WB   = WS_WG + (size_t)GW * DM * 2;
constexpr size_t WS_WO   = WS_WB + (size_t)5 * DM * BW * 2;
constexpr size_t WS_WKV  = WS_WO + (size_t)DM * DM * 2;
constexpr size_t WS_MEMN = WS_WKV + (size_t)DM * DM * 2;
constexpr size_t WS_KV   = WS_MEMN + (size_t)BATCH * MEMLEN * DM * 2;
constexpr size_t WS_H    = WS_KV + (size_t)BATCH * MEMLEN * DM * 2;
constexpr size_t WS_P    = WS_H + (size_t)TG * DM * 2;
constexpr size_t WS_YS   = WS_P + (size_t)TG * PW * 2;
constexpr size_t WS_GDN  = WS_YS + (size_t)TG * YW * 2;
constexpr size_t GDN_CH_BYTES = 73728;
constexpr size_t WS_SSD  = WS_GDN + (size_t)GB * 64 * 4 * GDN_CH_BYTES;
constexpr size_t WS_MASK = WS_SSD + (size_t)GB * 32 * 8 * 64 * 128 * 2;
constexpr size_t WS_DKN  = WS_MASK + (size_t)GB * SEQ * (SEQ / 8);
constexpr size_t WS_DVT  = WS_DKN + (size_t)GB * SEQ * 64 * 2;
constexpr size_t WS_SSDQ = WS_DVT + (size_t)GB * SEQ * 64 * 2;
constexpr size_t WS_SMALL= WS_SSDQ + (size_t)GB * 8 * 8 * 64 * 128 * 2;
constexpr size_t SMALL_BYTES = 1 << 20;
constexpr size_t WS_VN   = WS_SMALL + SMALL_BYTES;
constexpr size_t WS_IKC  = WS_VN + (size_t)GB * SEQ * 64 * 2;
constexpr size_t WS_END  = WS_IKC + (size_t)GB * SEQ * 64 * 2;
constexpr int QSPLIT = 2048;
static_assert(WS_END <= (size_t)536870912, "workspace map exceeds 512 MiB");
constexpr int SM_GDN_CD = 0;
constexpr int SM_SSD_CD = 4096;
constexpr int SM_SSD_RS = 65536;
constexpr int SM_SSD_CS = 8192;
constexpr int SM_SSD_DT = 8192 + GB * SEQ * 8;

constexpr int LDS_BYTES = 147456;
constexpr int LDS_MISC = 143360;
constexpr int LDS_WORK = 143360;

#define LAS __attribute__((address_space(3)))
typedef LAS unsigned char* ldsp_t;

struct Params {
    const float* in[27];
    float* out;
    unsigned char* ws;
    float one; int pad;
};

__device__ __forceinline__ float bf2f(unsigned v) { return __uint_as_float(v << 16); }
__device__ __forceinline__ float bflo(unsigned v) { return __uint_as_float(v << 16); }
__device__ __forceinline__ float bfhi(unsigned v) { return __uint_as_float(v & 0xffff0000u); }
typedef __bf16 bf16x2_t __attribute__((ext_vector_type(2)));
__device__ __forceinline__ unsigned pk2m(float lo, float hi) { const f32x2 v = {lo, hi}; return __builtin_bit_cast(unsigned, __builtin_convertvector(v, bf16x2_t)); }
__device__ __forceinline__ unsigned pk2(float lo, float hi) { unsigned r; asm volatile("s_nop 1\n\tv_cvt_pk_bf16_f32 %0, %1, %2" : "=v"(r) : "v"(lo), "v"(hi)); return r; }
__device__ __forceinline__ bf16_t f2bf(float x) { return (bf16_t)(pk2(x, 0.f) & 0xffffu); }
__device__ __forceinline__ bf16_t f2bfm(float x) { return (bf16_t)(pk2m(x, 0.f) & 0xffffu); }
__device__ __forceinline__ float shx(float v, int m, int lane) { return __builtin_bit_cast(float, __builtin_amdgcn_ds_bpermute((lane ^ m) << 2, __builtin_bit_cast(int, v))); }
__device__ __forceinline__ unsigned shxu(unsigned v, int m, int lane) { return (unsigned)__builtin_amdgcn_ds_bpermute((lane ^ m) << 2, (int)v); }
__device__ __forceinline__ float wave_sum(float v, int lane) {
#pragma unroll
    for (int o = 1; o < 64; o <<= 1) v += shx(v, o, lane);
    return v;
}
__device__ __forceinline__ float frcp(float x) { return __builtin_amdgcn_rcpf(x); }
__device__ __forceinline__ float fsigmoid(float x) { return frcp(1.0f + __builtin_amdgcn_exp2f(-1.4426950408889634f * x)); }
__device__ __forceinline__ float fsilu(float x) { return x * frcp(1.0f + __builtin_amdgcn_exp2f(-1.4426950408889634f * x)); }
__device__ __forceinline__ float fsoftplus(float x) { return x > 20.f ? x : log1pf(__expf(x)); }
__device__ __forceinline__ float fgelu_tanh(float x) {
    const float u = 0.7978845608028654f * (x + 0.044715f * x * x * x);
    const float e = __builtin_amdgcn_exp2f(2.8853900817779268f * u);
    const float th = 1.0f - 2.0f * frcp(e + 1.0f);
    return 0.5f * x * (1.0f + th);
}
#define LDS_WAIT() asm volatile("s_waitcnt lgkmcnt(0)" ::: "memory")
#define VM_WAIT() asm volatile("s_waitcnt vmcnt(0)" ::: "memory")

__device__ __forceinline__ f32x4 mma16(bf16x8 a, bf16x8 b, f32x4 c) { return __builtin_amdgcn_mfma_f32_16x16x32_bf16(a, b, c, 0, 0, 0); }
__device__ __forceinline__ bf16x8 pack_frag(f32x4 d0, f32x4 d1) {
    u32x4 w; w.x = pk2m(d0[0], d0[1]); w.y = pk2m(d0[2], d0[3]); w.z = pk2m(d1[0], d1[1]); w.w = pk2m(d1[2], d1[3]);
    return __builtin_bit_cast(bf16x8, w);
}
__device__ __forceinline__ bf16x8 ld_frag_perm_g(const bf16_t* row, int s, int q) {
    const u32x2 lo = *(const u32x2*)(row + 32 * s + 4 * q), hi = *(const u32x2*)(row + 32 * s + 16 + 4 * q);
    u32x4 w; w.x = lo.x; w.y = lo.y; w.z = hi.x; w.w = hi.y; return __builtin_bit_cast(bf16x8, w);
}
__device__ __forceinline__ bf16x8 ld_frag_perm_l(const LAS bf16_t* row, int s, int q) {
    const u32x2 lo = *(const LAS u32x2*)(row + 32 * s + 4 * q), hi = *(const LAS u32x2*)(row + 32 * s + 16 + 4 * q);
    u32x4 w; w.x = lo.x; w.y = lo.y; w.z = hi.x; w.w = hi.y; return __builtin_bit_cast(bf16x8, w);
}
__device__ __forceinline__ bf16x8 ld_frag_g(const bf16_t* row, int s, int q) { return *(const bf16x8*)(row + 32 * s + 8 * q); }
__device__ __forceinline__ bf16x8 ld_frag_l(const LAS bf16_t* row, int s, int q) { return *(const LAS bf16x8*)(row + 32 * s + 8 * q); }

struct Ctx {
    ldsp_t lds; int bid, wv;
    static constexpr int G = 256;
    const Params* p;
};
#define PHASE_TID() int tid_o; asm volatile("v_mbcnt_lo_u32_b32 %0, -1, 0\n\tv_mbcnt_hi_u32_b32 %0, -1, %0" : "=v"(tid_o)); tid_o += c.wv * 64;      const int tid = tid_o, lane = tid & 63, wave = __builtin_amdgcn_readfirstlane(tid >> 6); (void)lane; (void)wave

template <int ACT  > struct EpiStoreBf16 {
    static constexpr bool PERM = true, AFTER_DRAIN = false;
    bf16_t* O; int ldc; float one;
    __device__ __forceinline__ void operator()(const f32x4 (&acc)[2][2][4][2], const pg8::Unit& u, int wr, int wc, int fr, int fq) const {
        const int row0 = u.pm * 256 + wr * 64 + fr, col0 = u.pn * 256 + wc * 32 + 8 * fq;
#pragma unroll
        for (int ai = 0; ai < 2; ++ai)
#pragma unroll
            for (int m = 0; m < 4; ++m) { bf16_t* rowp = O + (size_t)(row0 + ai * 128 + m * 16) * ldc + col0;
#pragma unroll
                for (int bj = 0; bj < 2; ++bj) { f32x4 v0 = acc[ai][bj][m][0], v1 = acc[ai][bj][m][1];
                    if (ACT == 1) {
#pragma unroll
                        for (int j = 0; j < 4; ++j) { v0[j] = fsigmoid(v0[j]); v1[j] = fsigmoid(v1[j]); } }
                    v0 = v0 * one; v1 = v1 * one;
                    u32x4 w; w.x = pk2(v0[0], v0[1]); w.y = pk2(v0[2], v0[3]); w.z = pk2(v1[0], v1[1]); w.w = pk2(v1[2], v1[3]);
                    *(u32x4*)(rowp + bj * 128) = w; } }
    }
};
struct EpiMerge {
    static constexpr bool PERM = true, AFTER_DRAIN = false;
    const bf16_t* Gs; bf16_t* Mg; const float* RS;
    __device__ __forceinline__ void operator()(const f32x4 (&acc)[2][2][4][2], const pg8::Unit& u, int wr, int wc, int fr, int fq) const {
        const int row0 = u.pm * 256 + wr * 64 + fr, col0 = u.pn * 256 + wc * 32 + 8 * fq, pz = u.pz;
#pragma unroll
        for (int ai = 0; ai < 2; ++ai) {
            u32x4 g[4][2], pv[4][2]; float rs[4];
#pragma unroll
            for (int m = 0; m < 4; ++m) { const size_t row = (size_t)(row0 + ai * 128 + m * 16);
                rs[m] = RS[row];
#pragma unroll
                for (int bj = 0; bj < 2; ++bj) { g[m][bj] = *(const u32x4*)(Gs + row * GW + pz * DM + col0 + bj * 128);
                    pv[m][bj] = *(const u32x4*)(Mg + row * DM + col0 + bj * 128); } }
            asm volatile("" ::: "memory");
#pragma unroll
            for (int m = 0; m < 4; ++m) { const size_t row = (size_t)(row0 + ai * 128 + m * 16); const float rsm = pz == 3 ? rs[m] : 1.0f;
#pragma unroll
                for (int bj = 0; bj < 2; ++bj) { u32x4 p4 = pv[m][bj]; if (pz == 0) p4 = (u32x4){0u, 0u, 0u, 0u};
                    const u32x4 g4 = g[m][bj]; const f32x4 v0 = acc[ai][bj][m][0] * rsm, v1 = acc[ai][bj][m][1] * rsm;
                    u32x4 w;
                    w.x = pk2(bflo(p4.x) + bflo(g4.x) * v0[0], bfhi(p4.x) + bfhi(g4.x) * v0[1]);
                    w.y = pk2(bflo(p4.y) + bflo(g4.y) * v0[2], bfhi(p4.y) + bfhi(g4.y) * v0[3]);
                    w.z = pk2(bflo(p4.z) + bflo(g4.z) * v1[0], bfhi(p4.z) + bfhi(g4.z) * v1[1]);
                    w.w = pk2(bflo(p4.w) + bflo(g4.w) * v1[2], bfhi(p4.w) + bfhi(g4.w) * v1[3]);
                    *(u32x4*)(Mg + row * DM + col0 + bj * 128) = w; } }
            asm volatile("" ::: "memory");
        }
    }
};
struct OneUnit {
    int pm, pn, pz;
    __device__ __forceinline__ bool next(int i, pg8::Unit& u) const { if (i > 0) return false; u.pm = pm; u.pn = pn; u.pz = pz; return true; }
    __device__ __forceinline__ void a_ready(const pg8::Unit&) const {}
    __device__ __forceinline__ void done(const pg8::Unit&) const {}
};
struct EpiGateTile {
    static constexpr bool PERM = true, AFTER_DRAIN = false;
    __device__ __forceinline__ void operator()(const f32x4 (&acc)[2][2][4][2], unsigned (&gk)[32]) const {
#pragma unroll
        for (int ai = 0; ai < 2; ++ai)
#pragma unroll
            for (int bj = 0; bj < 2; ++bj)
#pragma unroll
                for (int m = 0; m < 4; ++m)
#pragma unroll
                    for (int n = 0; n < 2; ++n) { const f32x4 v = acc[ai][bj][m][n]; unsigned q[4];
#pragma unroll
                        for (int j = 0; j < 4; ++j) q[j] = (unsigned)(fsigmoid(v[j] * 0.03125f) * 255.0f + 0.5f);
                        unsigned w = q[0] | (q[1] << 8) | (q[2] << 16) | (q[3] << 24); asm volatile("" : "+v"(w));
                        gk[(ai * 2 + bj) * 8 + m * 2 + n] = w; }
    }
};
struct EpiMergeTile {
    static constexpr bool PERM = true, AFTER_DRAIN = false;
    bf16_t* Mg; const float* RS;
    __device__ __forceinline__ void operator()(const f32x4 (&acc)[2][2][4][2], const unsigned (&gk)[32], const pg8::Unit& u, int wr, int wc, int fr, int fq) const {
        const int lr0 = wr * 64 + fr, lc0 = wc * 32 + 8 * fq, row0 = u.pm * 256 + lr0, col0 = u.pn * 256 + lc0, pz = u.pz;
#pragma unroll
        for (int ai = 0; ai < 2; ++ai) {
            u32x4 pv[4][2]; float rs[4];
#pragma unroll
            for (int m = 0; m < 4; ++m) { const size_t row = (size_t)(row0 + ai * 128 + m * 16);
                rs[m] = pz == 3 ? RS[row] * (1.0f / 255.0f) : (1.0f / 255.0f);
#pragma unroll
                for (int bj = 0; bj < 2; ++bj) pv[m][bj] = pz != 0 ? *(const u32x4*)(Mg + row * DM + col0 + bj * 128) : (u32x4){0u, 0u, 0u, 0u}; }
            asm volatile("" ::: "memory");
#pragma unroll
            for (int m = 0; m < 4; ++m) { const size_t row = (size_t)(row0 + ai * 128 + m * 16); const float rsm = rs[m];
#pragma unroll
                for (int bj = 0; bj < 2; ++bj) { const u32x4 p4 = pv[m][bj];
                    const unsigned g0 = gk[(ai * 2 + bj) * 8 + m * 2], g1 = gk[(ai * 2 + bj) * 8 + m * 2 + 1]; const f32x4 v0 = acc[ai][bj][m][0] * rsm, v1 = acc[ai][bj][m][1] * rsm;
                    u32x4 w;
                    w.x = pk2(bflo(p4.x) + (float)(g0 & 255u) * v0[0], bfhi(p4.x) + (float)((g0 >> 8) & 255u) * v0[1]);
                    w.y = pk2(bflo(p4.y) + (float)((g0 >> 16) & 255u) * v0[2], bfhi(p4.y) + (float)(g0 >> 24) * v0[3]);
                    w.z = pk2(bflo(p4.z) + (float)(g1 & 255u) * v1[0], bfhi(p4.z) + (float)((g1 >> 8) & 255u) * v1[1]);
                    w.w = pk2(bflo(p4.w) + (float)((g1 >> 16) & 255u) * v1[2], bfhi(p4.w) + (float)(g1 >> 24) * v1[3]);
                    *(u32x4*)(Mg + row * DM + col0 + bj * 128) = w; } }
            asm volatile("" ::: "memory");
        }
    }
};
struct EpiResid {
    static constexpr bool PERM = false, AFTER_DRAIN = false;
    const float* xin; float* out;
    __device__ __forceinline__ void operator()(const f32x4 (&acc)[2][2][4][2], const pg8::Unit& u, int wr, int wc, int fr, int fq) const {
        const int row0 = u.pm * 256 + wr * 64 + fr, col0 = u.pn * 256 + wc * 32 + 4 * fq;
#pragma unroll
        for (int ai = 0; ai < 2; ++ai)
#pragma unroll
            for (int mh = 0; mh < 2; ++mh) {
                f32x4 xv[2][2][2];
#pragma unroll
                for (int m2 = 0; m2 < 2; ++m2) { const size_t off = (size_t)(row0 + ai * 128 + (mh * 2 + m2) * 16) * DM + col0;
#pragma unroll
                    for (int bj = 0; bj < 2; ++bj)
#pragma unroll
                        for (int n = 0; n < 2; ++n) xv[m2][bj][n] = *(const f32x4*)(xin + off + bj * 128 + n * 16); }
                asm volatile("" ::: "memory");
#pragma unroll
                for (int m2 = 0; m2 < 2; ++m2) { const int m = mh * 2 + m2; const size_t off = (size_t)(row0 + ai * 128 + m * 16) * DM + col0;
#pragma unroll
                    for (int bj = 0; bj < 2; ++bj)
#pragma unroll
                        for (int n = 0; n < 2; ++n) *(f32x4*)(out + off + bj * 128 + n * 16) = xv[m2][bj][n] + acc[ai][bj][m][n]; }
                asm volatile("" ::: "memory");
            }
    }
};
struct MergeOrder {
    int G, c, ntile;
    __device__ __forceinline__ bool next(int i, pg8::Unit& u) const { const int tile = c + (i / 5) * G; if (tile >= ntile) return false; u.pm = tile >> 2; u.pn = tile & 3; u.pz = i % 5; return true; }
    __device__ __forceinline__ void a_ready(const pg8::Unit&) const {}
    __device__ __forceinline__ void done(const pg8::Unit&) const {}
};

__device__ __forceinline__ int win_src_col(int j) {
    if (j < 1536) return j;
    if (j < 2048) return 1544 + (j - 1536);
    if (j < 3584) return j + 8;
    if (j < 4096) return 3592 + (j - 3584);
    if (j < 4608) return 4232 + (j - 4096);
    if (j < 5120) return 4816 + (j - 4608);
    if (j < 5184) return 4104 + (j - 5120);
    if (j < 5248) return 4168 + (j - 5184);
    if (j < 5312) return 4744 + (j - 5248);
    if (j < 5320) return 4808 + (j - 5312);
    if (j < 5324) return 1536 + (j - 5320);
    if (j < 5328) return 1540 + (j - 5324);
    if (j < 5336) return 6864 + (j - 5328);
    if (j < 5376) return -1;
    if (j < 5888) return 5328 + (j - 5376);
    if (j < 6912) return 5840 + (j - 5888);
    if (j < 7424) return 6872 + (j - 6912);
    return 7384 + (j - 7424);
}
template <bool REMAP, bool SCALE>
__device__ __forceinline__ void tr_item(const float* W, int ldsrc, const float* scale, bf16_t* WT, int K, int k0, int n0, LAS float* scr, int lane) {
    const int n4 = (lane & 7) * 4;
    const int sc = REMAP ? win_src_col(n0 + n4) : (n0 + n4);
    f32x4 v8[8]; float s8[8];
#pragma unroll
    for (int i = 0; i < 8; ++i) { const int kk = 8 * i + (lane >> 3);
        v8[i] = (f32x4){0.f, 0.f, 0.f, 0.f};
        if (sc >= 0) v8[i] = *(const f32x4*)(W + (size_t)(k0 + kk) * ldsrc + sc);
        s8[i] = SCALE ? scale[k0 + kk] : 1.0f; }
#pragma unroll
    for (int i = 0; i < 8; ++i) { const int kk = 8 * i + (lane >> 3); const f32x4 v = SCALE ? v8[i] * s8[i] : v8[i];
        scr[kk * 33 + n4] = v[0]; scr[kk * 33 + n4 + 1] = v[1]; scr[kk * 33 + n4 + 2] = v[2]; scr[kk * 33 + n4 + 3] = v[3]; }
    LDS_WAIT();
    const int c = lane & 7;
#pragma unroll
    for (int j = 0; j < 4; ++j) { const int nn = (lane >> 3) + 8 * j; const LAS float* s = scr + (8 * c) * 33 + nn;
        u32x4 o; o.x = pk2(s[0 * 33], s[1 * 33]); o.y = pk2(s[2 * 33], s[3 * 33]); o.z = pk2(s[4 * 33], s[5 * 33]); o.w = pk2(s[6 * 33], s[7 * 33]);
        *(u32x4*)(WT + (size_t)(n0 + nn) * K + k0 + 8 * c) = o; }
    LDS_WAIT();
}
__device__ __forceinline__ unsigned pk4_fp8(float a, float b, float c, float d) {
    a = fminf(fmaxf(a, -448.f), 448.f); b = fminf(fmaxf(b, -448.f), 448.f); c = fminf(fmaxf(c, -448.f), 448.f); d = fminf(fmaxf(d, -448.f), 448.f);
    unsigned w = 0u; w = (unsigned)__builtin_amdgcn_cvt_pk_fp8_f32(a, b, (int)w, false); w = (unsigned)__builtin_amdgcn_cvt_pk_fp8_f32(c, d, (int)w, true); return w;
}
__device__ __forceinline__ void tr_item8(const float* W, int ldsrc, const float* scale, float mul, unsigned char* WT8, int K, int k0, int n0, LAS float* scr, int lane) {
    const int n4 = (lane & 7) * 4;
    f32x4 v8[8]; float s8[8];
#pragma unroll
    for (int i = 0; i < 8; ++i) { const int kk = 8 * i + (lane >> 3); v8[i] = *(const f32x4*)(W + (size_t)(k0 + kk) * ldsrc + n0 + n4); s8[i] = scale[k0 + kk] * mul; }
#pragma unroll
    for (int i = 0; i < 8; ++i) { const int kk = 8 * i + (lane >> 3); const f32x4 v = v8[i] * s8[i];
        scr[kk * 33 + n4] = v[0]; scr[kk * 33 + n4 + 1] = v[1]; scr[kk * 33 + n4 + 2] = v[2]; scr[kk * 33 + n4 + 3] = v[3]; }
    LDS_WAIT();
    const int c = lane & 7;
#pragma unroll
    for (int j = 0; j < 4; ++j) { const int nn = (lane >> 3) + 8 * j; const LAS float* s = scr + (8 * c) * 33 + nn;
        u32x2 o; o.x = pk4_fp8(s[0 * 33], s[1 * 33], s[2 * 33], s[3 * 33]); o.y = pk4_fp8(s[4 * 33], s[5 * 33], s[6 * 33], s[7 * 33]);
        *(u32x2*)(WT8 + (size_t)(n0 + nn) * K + k0 + 8 * c) = o; }
    LDS_WAIT();
}
__device__ __forceinline__ void rms_row_to_bf16(const float* xrow, bf16_t* orow, int lane) {
    const f32x4* xr = (const f32x4*)xrow + lane;
    f32x4 v[4]; float s = 0.f;
#pragma unroll
    for (int j = 0; j < 4; ++j) { v[j] = xr[64 * j]; s += (v[j].x * v[j].x + v[j].y * v[j].y) + (v[j].z * v[j].z + v[j].w * v[j].w); }
    const float rstd = rsqrtf(wave_sum(s, lane) * (1.f / DM) + 1e-6f);
    unsigned long long* o8 = (unsigned long long*)orow + lane;
#pragma unroll
    for (int j = 0; j < 4; ++j) o8[64 * j] = (unsigned long long)pk2(v[j].x * rstd, v[j].y * rstd) | ((unsigned long long)pk2(v[j].z * rstd, v[j].w * rstd) << 32);
}
__device__ __forceinline__ void phase_convert(const Ctx& c, int layer) {
    PHASE_TID();
    const Params& p = *c.p;
    LAS float* scr = (LAS float*)(c.lds + wave * 8704);
    const int gw = c.bid * 8 + wave, NGW = c.G * 8;
    bf16_t* WIN = (bf16_t*)(p.ws + WS_WIN); bf16_t* WG = (bf16_t*)(p.ws + WS_WG); bf16_t* WB = (bf16_t*)(p.ws + WS_WB); bf16_t* WO = (bf16_t*)(p.ws + WS_WO); bf16_t* WKV = (bf16_t*)(p.ws + WS_WKV);
    const float* norm_g = p.in[2] + layer * DM;
    for (int r = gw; r < 16 * (PW / 32); r += NGW) { const int kb = r / (PW / 32), nb = r % (PW / 32);
        tr_item<true, true>(p.in[3] + (size_t)layer * DM * IN_COLS, IN_COLS, norm_g, WIN, DM, kb * 64, nb * 32, scr, lane); }
    for (int r = gw; r < 5 * 512; r += NGW) { const int pz = r / 512, q = r % 512, kb = q / 32, nb = q % 32;
#ifndef NO_TR8
        tr_item8(p.in[24] + (size_t)(layer * 5 + pz) * DM * DM, DM, norm_g, 32.0f, (unsigned char*)WG + (size_t)pz * DM * DM, DM, kb * 64, nb * 32, scr, lane); }
#else
        }
#endif
    for (int r = gw; r < 4 * 256; r += NGW) { const int pi = r / 256, pz = pi < 3 ? pi : 4, q = r % 256, kb = q / 32, nb = q % 32;
        tr_item<false, false>(p.in[25] + (size_t)(layer * 5 + pz) * BW * DM, DM, nullptr, WB + (size_t)pz * DM * BW, BW, kb * 64, nb * 32, scr, lane); }
    for (int r = gw; r < 256; r += NGW) { const int kb = r / 32, nb = r % 32;
        tr_item<false, true>(p.in[25] + (size_t)(layer * 5 + 3) * BW * DM, DM, p.in[19] + layer * BW, WB + (size_t)3 * DM * BW, BW, kb * 64, nb * 32, scr, lane); }
    for (int r = gw; r < 512; r += NGW) { const int kb = r / 32, nb = r % 32;
        tr_item<false, false>(p.in[26] + (size_t)layer * DM * DM, DM, nullptr, WO, DM, kb * 64, nb * 32, scr, lane); }
    for (int r = gw; r < 512; r += NGW) { const int kb = r / 32, nb = r % 32;
        tr_item<false, true>(p.in[21] + (size_t)layer * DM * DM, DM, p.in[20] + layer * DM, WKV, DM, kb * 64, nb * 32, scr, lane); }
    if (layer == 0) {
        bf16_t* MEMN = (bf16_t*)(p.ws + WS_MEMN);
        for (int r = gw; r < BATCH * MEMLEN; r += NGW) rms_row_to_bf16(p.in[1] + (size_t)r * DM, MEMN + (size_t)r * DM, lane);
    }
}
__device__ __forceinline__ void phase_norm(const Ctx& c, const float* xin  ) {
    PHASE_TID();
    bf16_t* H = (bf16_t*)(c.p->ws + WS_H);
    const int gw = c.bid * 8 + wave, NGW = c.G * 8;
    for (int r = gw; r < TG; r += NGW) rms_row_to_bf16(xin + (size_t)r * DM, H + (size_t)r * DM, lane);
}

__device__ __forceinline__ void h8_rows(const Ctx& c) {
    PHASE_TID();
    const bf16_t* H = (const bf16_t*)(c.p->ws + WS_H); unsigned char* P8 = c.p->ws + WS_P;
    for (int r = c.bid * 8 + wave; r < TG; r += c.G * 16) {
        u32x4 a[2][2];
#pragma unroll
        for (int k = 0; k < 2; ++k) { const size_t rr = (size_t)(r + k * c.G * 8); a[k][0] = *(const u32x4*)(H + rr * DM + lane * 16); a[k][1] = *(const u32x4*)(H + rr * DM + lane * 16 + 8); }
        asm volatile("" ::: "memory");
#pragma unroll
        for (int k = 0; k < 2; ++k) { const size_t rr = (size_t)(r + k * c.G * 8); const u32x4 x = a[k][0], y = a[k][1]; u32x4 o;
            o.x = pk4_fp8(bflo(x.x), bfhi(x.x), bflo(x.y), bfhi(x.y)); o.y = pk4_fp8(bflo(x.z), bfhi(x.z), bflo(x.w), bfhi(x.w));
            o.z = pk4_fp8(bflo(y.x), bfhi(y.x), bflo(y.y), bfhi(y.y)); o.w = pk4_fp8(bflo(y.z), bfhi(y.z), bflo(y.w), bfhi(y.w));
            *(u32x4*)(P8 + rr * (size_t)(PW * 2) + lane * 16) = o; }
        asm volatile("" ::: "memory");
    }
}

__device__ __forceinline__ float sg_row16_sum(float v) {
    v += __builtin_bit_cast(float, __builtin_amdgcn_mov_dpp(__builtin_bit_cast(int, v), 0xB1, 0xF, 0xF, true));
    v += __builtin_bit_cast(float, __builtin_amdgcn_mov_dpp(__builtin_bit_cast(int, v), 0x4E, 0xF, 0xF, true));
    v += __builtin_bit_cast(float, __builtin_amdgcn_mov_dpp(__builtin_bit_cast(int, v), 0x141, 0xF, 0xF, true));
    v += __builtin_bit_cast(float, __builtin_amdgcn_mov_dpp(__builtin_bit_cast(int, v), 0x140, 0xF, 0xF, true));
    return v;
}
__device__ __forceinline__ void sg_unit(const Ctx& c, int layer, int lb, int n) {
    PHASE_TID();
    const Params& p = *c.p;
    const bf16_t* P = (const bf16_t*)(p.ws + WS_P); bf16_t* YS = (bf16_t*)(p.ws + WS_YS);
    const float* ln_g = p.in[8] + layer * BW; const float* ln_b = p.in[9] + layer * BW;
    const float* w_s = p.in[10] + (size_t)layer * 4 * 128 * 128; const float* b_s = p.in[11] + layer * 4 * 128;
    LAS float* st = (LAS float*)c.lds;
    LAS bf16_t* Wl = (LAS bf16_t*)(c.lds + 1024);
    LAS bf16_t* vT = (LAS bf16_t*)(c.lds + 1024 + 34816);
    const int r0 = lb * SEQ + n * 128, q = lane >> 4, l15 = lane & 15;
    __syncthreads();
#pragma unroll
    for (int ps = 0; ps < 4; ++ps) { const int t = wave * 16 + ps * 4 + q;
        const bf16_t* src = P + (size_t)(r0 + t) * PW + C_BV + l15 * 32;
        u32x4 raw[4];
#pragma unroll
        for (int j = 0; j < 4; ++j) raw[j] = *(const u32x4*)(src + 8 * j);
        float x[32]; float sm = 0.f;
#pragma unroll
        for (int j = 0; j < 4; ++j) { x[8 * j + 0] = bflo(raw[j].x); x[8 * j + 1] = bfhi(raw[j].x); x[8 * j + 2] = bflo(raw[j].y); x[8 * j + 3] = bfhi(raw[j].y);
            x[8 * j + 4] = bflo(raw[j].z); x[8 * j + 5] = bfhi(raw[j].z); x[8 * j + 6] = bflo(raw[j].w); x[8 * j + 7] = bfhi(raw[j].w); }
#pragma unroll
        for (int k = 0; k < 32; ++k) { x[k] = fgelu_tanh(x[k]); sm += x[k]; }
        const float mean = sg_row16_sum(sm) * (1.f / BW); float s2 = 0.f;
#pragma unroll
        for (int k = 0; k < 32; ++k) { const float d = x[k] - mean; s2 += d * d; }
        const float var = sg_row16_sum(s2) * (1.f / BW);
        if (l15 == 0) { st[t] = mean; st[128 + t] = rsqrtf(var + 1e-5f); }
    }
    for (int g = 0; g < 4; ++g) {
        __syncthreads();
        {
            const int t = tid >> 2, sb = (tid & 3) * 32; const float* src = w_s + (size_t)(g * 128 + t) * 128 + sb;
#pragma unroll
            for (int j = 0; j < 4; ++j) { const f32x4 a = *(const f32x4*)(src + 8 * j), b = *(const f32x4*)(src + 8 * j + 4); const int s0 = sb + 8 * j;
                u32x4 w; w.x = pk2(s0 + 0 <= t ? a[0] : 0.f, s0 + 1 <= t ? a[1] : 0.f); w.y = pk2(s0 + 2 <= t ? a[2] : 0.f, s0 + 3 <= t ? a[3] : 0.f);
                w.z = pk2(s0 + 4 <= t ? b[0] : 0.f, s0 + 5 <= t ? b[1] : 0.f); w.w = pk2(s0 + 6 <= t ? b[2] : 0.f, s0 + 7 <= t ? b[3] : 0.f);
                *(LAS u32x4*)(Wl + t * 136 + s0) = w; }
        }
#pragma unroll
        for (int j = 0; j < 4; ++j) { const int e = tid + 512 * j, s = e >> 4, cb = (e & 15) * 8;
            const u32x4 raw = *(const u32x4*)(P + (size_t)(r0 + s) * PW + C_BV + g * 128 + cb);
            float x[8]; x[0] = bflo(raw.x); x[1] = bfhi(raw.x); x[2] = bflo(raw.y); x[3] = bfhi(raw.y); x[4] = bflo(raw.z); x[5] = bfhi(raw.z); x[6] = bflo(raw.w); x[7] = bfhi(raw.w);
            const float mean = st[s], rstd = st[128 + s];
#pragma unroll
            for (int k = 0; k < 8; ++k) { const int ch = g * 128 + cb + k; const float y = (fgelu_tanh(x[k]) - mean) * rstd * ln_g[ch] + ln_b[ch]; vT[(cb + k) * 136 + s] = f2bf(y); } }
        __syncthreads();
        f32x4 acc[8];
#pragma unroll
        for (int ct = 0; ct < 8; ++ct) acc[ct] = (f32x4){0.f, 0.f, 0.f, 0.f};
        const int nks = (wave >> 1) + 1;
        for (int ks = 0; ks < nks; ++ks) {
            const bf16x8 bw = ld_frag_l(Wl + (wave * 16 + l15) * 136, ks, q);
#pragma unroll
            for (int ct = 0; ct < 8; ++ct) acc[ct] = mma16(ld_frag_l(vT + (ct * 16 + l15) * 136, ks, q), bw, acc[ct]);
        }
        const int t = wave * 16 + l15; const size_t row = (size_t)(r0 + t); const float bias = b_s[g * 128 + t];
        u32x2 ur[8], gr[8];
#pragma unroll
        for (int ct = 0; ct < 8; ++ct) { const int ch = g * 128 + ct * 16 + 4 * q; ur[ct] = *(const u32x2*)(P + row * PW + C_BU + ch); gr[ct] = *(const u32x2*)(P + row * PW + C_BG + ch); }
        asm volatile("" ::: "memory");
#pragma unroll
        for (int ct = 0; ct < 8; ++ct) { const int ch = g * 128 + ct * 16 + 4 * q;
            const float o0 = fgelu_tanh(bflo(ur[ct].x)) * (acc[ct][0] + bias) * fsilu(bflo(gr[ct].x)), o1 = fgelu_tanh(bfhi(ur[ct].x)) * (acc[ct][1] + bias) * fsilu(bfhi(gr[ct].x));
            const float o2 = fgelu_tanh(bflo(ur[ct].y)) * (acc[ct][2] + bias) * fsilu(bflo(gr[ct].y)), o3 = fgelu_tanh(bfhi(ur[ct].y)) * (acc[ct][3] + bias) * fsilu(bfhi(gr[ct].y));
            u32x2 w; w.x = pk2(o0, o1); w.y = pk2(o2, o3);
            *(u32x2*)(YS + row * YW + 1 * BW + ch) = w; }
        asm volatile("" ::: "memory");
    }
}

__device__ __forceinline__ void mem_unit(const Ctx& c, int layer, int grp, int lb, int head, int qc) {
    PHASE_TID();
    const Params& p = *c.p;
    const bf16_t* P = (const bf16_t*)(p.ws + WS_P); bf16_t* YS = (bf16_t*)(p.ws + WS_YS); const bf16_t* KV = (const bf16_t*)(p.ws + WS_KV);
    const float* qg = p.in[22] + layer * 128; const float* kg = p.in[23] + layer * 128;
    LAS bf16_t* Kn = (LAS bf16_t*)c.lds;
    LAS bf16_t* VT = (LAS bf16_t*)(c.lds + 69632);
    const int q = lane >> 4, l15 = lane & 15, gbatch = grp * GB + lb;
    __syncthreads();
#pragma unroll
    for (int j = 0; j < 8; ++j) { const int e = tid + 512 * j, m = e >> 4, pc = e & 15; const bf16_t* src = KV + (size_t)(gbatch * MEMLEN + m) * DM + head * 128 + pc * 8;
        const u32x4 kr = *(const u32x4*)src, vr = *(const u32x4*)(src + BW);
        float x[8]; x[0] = bflo(kr.x); x[1] = bfhi(kr.x); x[2] = bflo(kr.y); x[3] = bfhi(kr.y); x[4] = bflo(kr.z); x[5] = bfhi(kr.z); x[6] = bflo(kr.w); x[7] = bfhi(kr.w);
        float ss = 0.f;
#pragma unroll
        for (int k = 0; k < 8; ++k) ss += x[k] * x[k];
        ss += shx(ss, 1, lane); ss += shx(ss, 2, lane); ss += shx(ss, 4, lane); ss += shx(ss, 8, lane);
        const float rstd = rsqrtf(ss * (1.f / 128.f) + 1e-6f);
        u32x4 w; w.x = pk2(x[0] * rstd * kg[pc * 8 + 0], x[1] * rstd * kg[pc * 8 + 1]); w.y = pk2(x[2] * rstd * kg[pc * 8 + 2], x[3] * rstd * kg[pc * 8 + 3]);
        w.z = pk2(x[4] * rstd * kg[pc * 8 + 4], x[5] * rstd * kg[pc * 8 + 5]); w.w = pk2(x[6] * rstd * kg[pc * 8 + 6], x[7] * rstd * kg[pc * 8 + 7]);
        *(LAS u32x4*)(Kn + m * 136 + pc * 8) = w;
        VT[(pc * 8 + 0) * 264 + m] = (bf16_t)(vr.x & 0xffffu); VT[(pc * 8 + 1) * 264 + m] = (bf16_t)(vr.x >> 16);
        VT[(pc * 8 + 2) * 264 + m] = (bf16_t)(vr.y & 0xffffu); VT[(pc * 8 + 3) * 264 + m] = (bf16_t)(vr.y >> 16);
        VT[(pc * 8 + 4) * 264 + m] = (bf16_t)(vr.z & 0xffffu); VT[(pc * 8 + 5) * 264 + m] = (bf16_t)(vr.z >> 16);
        VT[(pc * 8 + 6) * 264 + m] = (bf16_t)(vr.w & 0xffffu); VT[(pc * 8 + 7) * 264 + m] = (bf16_t)(vr.w >> 16); }
    __syncthreads();
    const float qscale = 0.08838834764831845f * 1.4426950408889634f;
    for (int qt = 0; qt < 4; ++qt) {
        const size_t row = (size_t)(lb * SEQ + qc * 512 + qt * 128 + wave * 16 + l15);
        bf16x8 qf[4];
        { float x[4][8]; float ss = 0.f;
#pragma unroll
          for (int ks = 0; ks < 4; ++ks) { const u32x4 r = *(const u32x4*)(P + row * PW + C_MQ + head * 128 + 32 * ks + 8 * q);
              x[ks][0] = bflo(r.x); x[ks][1] = bfhi(r.x); x[ks][2] = bflo(r.y); x[ks][3] = bfhi(r.y); x[ks][4] = bflo(r.z); x[ks][5] = bfhi(r.z); x[ks][6] = bflo(r.w); x[ks][7] = bfhi(r.w);
#pragma unroll
              for (int k = 0; k < 8; ++k) ss += x[ks][k] * x[ks][k]; }
          ss += shx(ss, 16, lane); ss += shx(ss, 32, lane);
          const float rs = rsqrtf(ss * (1.f / 128.f) + 1e-6f) * qscale;
#pragma unroll
          for (int ks = 0; ks < 4; ++ks) { const float* gp = qg + 32 * ks + 8 * q; u32x4 w;
              w.x = pk2m(x[ks][0] * rs * gp[0], x[ks][1] * rs * gp[1]); w.y = pk2m(x[ks][2] * rs * gp[2], x[ks][3] * rs * gp[3]);
              w.z = pk2m(x[ks][4] * rs * gp[4], x[ks][5] * rs * gp[5]); w.w = pk2m(x[ks][6] * rs * gp[6], x[ks][7] * rs * gp[7]);
              qf[ks] = __builtin_bit_cast(bf16x8, w); } }
        f32x4 s[16];
#pragma unroll
        for (int kt = 0; kt < 16; ++kt) { s[kt] = (f32x4){0.f, 0.f, 0.f, 0.f};
#pragma unroll
            for (int ks = 0; ks < 4; ++ks) s[kt] = mma16(ld_frag_l(Kn + (kt * 16 + l15) * 136, ks, q), qf[ks], s[kt]); }
        float mx = -3.0e38f;
#pragma unroll
        for (int kt = 0; kt < 16; ++kt) mx = fmaxf(fmaxf(fmaxf(s[kt][0], s[kt][1]), fmaxf(s[kt][2], s[kt][3])), mx);
        mx = fmaxf(mx, shx(mx, 16, lane)); mx = fmaxf(mx, shx(mx, 32, lane));
        float sum = 0.f;
#pragma unroll
        for (int kt = 0; kt < 16; ++kt) {
#pragma unroll
            for (int i = 0; i < 4; ++i) { const float e = __builtin_amdgcn_exp2f(s[kt][i] - mx); s[kt][i] = e; sum += e; } }
        sum += shx(sum, 16, lane); sum += shx(sum, 32, lane);
        const float inv = frcp(sum);
        f32x4 o[8];
#pragma unroll
        for (int dt = 0; dt < 8; ++dt) o[dt] = (f32x4){0.f, 0.f, 0.f, 0.f};
#pragma unroll
        for (int ks = 0; ks < 8; ++ks) { const bf16x8 pf = pack_frag(s[2 * ks], s[2 * ks + 1]);
#pragma unroll
            for (int dt = 0; dt < 8; ++dt) o[dt] = mma16(ld_frag_perm_l(VT + (dt * 16 + l15) * 264, ks, q), pf, o[dt]); }
        u32x2 grm[8];
#pragma unroll
        for (int dt = 0; dt < 8; ++dt) grm[dt] = *(const u32x2*)(P + row * PW + C_MG + head * 128 + dt * 16 + 4 * q);
        asm volatile("" ::: "memory");
#pragma unroll
        for (int dt = 0; dt < 8; ++dt) { const int ch = head * 128 + dt * 16 + 4 * q; const u32x2 gr = grm[dt];
            u32x2 w; w.x = pk2(o[dt][0] * inv * fsilu(bflo(gr.x)), o[dt][1] * inv * fsilu(bfhi(gr.x))); w.y = pk2(o[dt][2] * inv * fsilu(bflo(gr.y)), o[dt][3] * inv * fsilu(bfhi(gr.y)));
            *(u32x2*)(YS + row * YW + 4 * BW + ch) = w; }
        asm volatile("" ::: "memory");
    }
}

__device__ __forceinline__ void ssd_conv8(const bf16_t* prow_col, int tb, const float* cw  , const float* cb, int ch0, float (&y)[8]) {
#pragma unroll
    for (int k = 0; k < 8; ++k) y[k] = cb[ch0 + k];
#pragma unroll
    for (int j = 0; j < 4; ++j) { const int dt = j - 3;
        if (tb + dt >= 0) { const u32x4 r = *(const u32x4*)(prow_col + (ptrdiff_t)dt * PW);
            const f32x4 w0 = *(const f32x4*)(cw + j * 1024 + ch0), w1 = *(const f32x4*)(cw + j * 1024 + ch0 + 4);
            y[0] += w0[0] * bflo(r.x); y[1] += w0[1] * bfhi(r.x); y[2] += w0[2] * bflo(r.y); y[3] += w0[3] * bfhi(r.y);
            y[4] += w1[0] * bflo(r.z); y[5] += w1[1] * bfhi(r.z); y[6] += w1[2] * bflo(r.w); y[7] += w1[3] * bfhi(r.w); } }
#pragma unroll
    for (int k = 0; k < 8; ++k) y[k] = fsilu(y[k]);
}
__device__ __forceinline__ void ssd_conv8x2(const bf16_t* prow_col, int tb0, const float* cw, const float* cb, int ch0, float (&y0)[8], float (&y1)[8]) {
#pragma unroll
    for (int k = 0; k < 8; ++k) { y0[k] = cb[ch0 + k]; y1[k] = y0[k]; }
    f32x4 w[4][2];
#pragma unroll
    for (int j = 0; j < 4; ++j) { w[j][0] = *(const f32x4*)(cw + j * 1024 + ch0); w[j][1] = *(const f32x4*)(cw + j * 1024 + ch0 + 4); }
#pragma unroll
    for (int d = -3; d <= 1; ++d) {
        if (tb0 + d >= 0) { const u32x4 r = *(const u32x4*)(prow_col + (ptrdiff_t)d * PW);
            const float x[8] = {bflo(r.x), bfhi(r.x), bflo(r.y), bfhi(r.y), bflo(r.z), bfhi(r.z), bflo(r.w), bfhi(r.w)};
            if (d + 3 <= 3) {
#pragma unroll
                for (int k = 0; k < 8; ++k) y0[k] += w[d + 3 <= 3 ? d + 3 : 0][k >> 2][k & 3] * x[k]; }
            if (d + 2 >= 0) {
#pragma unroll
                for (int k = 0; k < 8; ++k) y1[k] += w[d + 2 >= 0 ? d + 2 : 0][k >> 2][k & 3] * x[k]; } } }
#pragma unroll
    for (int k = 0; k < 8; ++k) { y0[k] = fsilu(y0[k]); y1[k] = fsilu(y1[k]); }
}
__device__ __forceinline__ void ssd_conv8x4(const bf16_t* prow_col, int tb0, const float* cw, const float* cb, int ch0, float (&y)[4][8]) {
    f32x4 w[4][2];
#pragma unroll
    for (int j = 0; j < 4; ++j) { w[j][0] = *(const f32x4*)(cw + j * 1024 + ch0); w[j][1] = *(const f32x4*)(cw + j * 1024 + ch0 + 4); }
    const f32x4 b0 = *(const f32x4*)(cb + ch0), b1 = *(const f32x4*)(cb + ch0 + 4);
#pragma unroll
    for (int t = 0; t < 4; ++t) { y[t][0] = b0[0]; y[t][1] = b0[1]; y[t][2] = b0[2]; y[t][3] = b0[3]; y[t][4] = b1[0]; y[t][5] = b1[1]; y[t][6] = b1[2]; y[t][7] = b1[3]; }
    u32x4 r[7];
#pragma unroll
    for (int d = -3; d <= 3; ++d) r[d + 3] = (tb0 + d >= 0) ? *(const u32x4*)(prow_col + (ptrdiff_t)d * PW) : (u32x4){0u, 0u, 0u, 0u};
#pragma unroll
    for (int d = -3; d <= 3; ++d) { const u32x4 rr = r[d + 3];
        const float x[8] = {bflo(rr.x), bfhi(rr.x), bflo(rr.y), bfhi(rr.y), bflo(rr.z), bfhi(rr.z), bflo(rr.w), bfhi(rr.w)};
#pragma unroll
        for (int t = 0; t < 4; ++t) { const int j = d - t + 3;
            if (j >= 0 && j <= 3) {
#pragma unroll
                for (int k = 0; k < 8; ++k) y[t][k] += w[j][k >> 2][k & 3] * x[k]; } } }
#pragma unroll
    for (int t = 0; t < 4; ++t)
#pragma unroll
        for (int k = 0; k < 8; ++k) y[t][k] = fsilu(y[t][k]);
}
__device__ __forceinline__ void ssd_dt_tables(const Ctx& c, int layer, int lb, int n, int h0, int nh, LAS float* dtL, LAS float* csL, int tid, bool to_global) {
    const Params& p = *c.p; const bf16_t* P = (const bf16_t*)(p.ws + WS_P); float* SM = (float*)(p.ws + WS_SMALL);
    const int r0 = lb * SEQ + n * 128;
    for (int e = tid; e < 128 * nh; e += 512) { const int s = e / nh, hh = h0 + e % nh;
        const float x = bf2f(P[(size_t)(r0 + s) * PW + C_DDT + hh]) + p.in[17][layer * 8 + hh];
        const float dt = fsoftplus(x); dtL[s * nh + (hh - h0)] = dt; csL[s * nh + (hh - h0)] = dt * (-__expf(p.in[16][layer * 8 + hh])); }
    __syncthreads();
    { const int wv = tid >> 6, ln = tid & 63;
      if (wv < nh) { float a = csL[ln * nh + wv], b = csL[(ln + 64) * nh + wv];
#pragma unroll
          for (int o = 1; o < 64; o <<= 1) { const float ta = __builtin_bit_cast(float, __builtin_amdgcn_ds_bpermute((ln - o) << 2, __builtin_bit_cast(int, a))), tb = __builtin_bit_cast(float, __builtin_amdgcn_ds_bpermute((ln - o) << 2, __builtin_bit_cast(int, b)));
              if (ln >= o) { a += ta; b += tb; } }
          const float tot = __builtin_bit_cast(float, __builtin_amdgcn_ds_bpermute(63 << 2, __builtin_bit_cast(int, a)));
          b += tot; csL[ln * nh + wv] = a; csL[(ln + 64) * nh + wv] = b;
          if (to_global && ln == 63) SM[SM_SSD_CD + (lb * 8 + h0 + wv) * 32 + n] = __expf(b); } }
    __syncthreads();
}
__device__ __forceinline__ void ssd1_unit(const Ctx& c, int layer, int lb, int n, int g) {
    PHASE_TID();
    const Params& p = *c.p; const bf16_t* P = (const bf16_t*)(p.ws + WS_P);
    const float* cw = p.in[14] + (size_t)layer * 4 * 1024; const float* cbias = p.in[15] + layer * 1024;
    LAS float* dtL = (LAS float*)c.lds; LAS float* csL = (LAS float*)(c.lds + 2048);
    LAS bf16_t* bmT = (LAS bf16_t*)(c.lds + 4096);
    LAS bf16_t* xdT = (LAS bf16_t*)(c.lds + 4096 + 34816);
    const int r0 = lb * SEQ + n * 128, q = lane >> 4, l15 = lane & 15;
    __syncthreads();
    ssd_dt_tables(c, layer, lb, n, g * 4, 4, dtL, csL, tid, true);
    for (int e = tid; e < 32 * 48; e += 512) { const int sg4 = e / 48, blk = e % 48, s0 = 4 * sg4; float y[4][8];
        if (blk < 16) { const int ch0 = 512 + g * 128 + blk * 8;
            ssd_conv8x4(P + (size_t)(r0 + s0) * PW + C_DX + ch0, n * 128 + s0, cw, cbias, ch0, y);
#pragma unroll
            for (int k = 0; k < 8; ++k) { u32x2 w; w.x = pk2(y[0][k], y[1][k]); w.y = pk2(y[2][k], y[3][k]); *(LAS u32x2*)(bmT + (blk * 8 + k) * 136 + s0) = w; }
        } else { const int b2 = blk - 16, r = b2 >> 3, ch0 = (g * 4 + r) * 64 + (b2 & 7) * 8;
            ssd_conv8x4(P + (size_t)(r0 + s0) * PW + C_DX + ch0, n * 128 + s0, cw, cbias, ch0, y);
            const float cl = csL[127 * 4 + r]; float f[4];
#pragma unroll
            for (int t = 0; t < 4; ++t) f[t] = dtL[(s0 + t) * 4 + r] * __expf(cl - csL[(s0 + t) * 4 + r]);
#pragma unroll
            for (int k = 0; k < 8; ++k) { u32x2 w; w.x = pk2(y[0][k] * f[0], y[1][k] * f[1]); w.y = pk2(y[2][k] * f[2], y[3][k] * f[3]); *(LAS u32x2*)(xdT + (b2 * 8 + k) * 136 + s0) = w; } }
    }
    __syncthreads();
    f32x4 acc[2][8];
#pragma unroll
    for (int a = 0; a < 2; ++a)
#pragma unroll
        for (int m = 0; m < 8; ++m) acc[a][m] = (f32x4){0.f, 0.f, 0.f, 0.f};
#pragma unroll
    for (int ks = 0; ks < 4; ++ks) {
        const bf16x8 b0 = ld_frag_l(xdT + ((2 * wave) * 16 + l15) * 136, ks, q), b1 = ld_frag_l(xdT + ((2 * wave + 1) * 16 + l15) * 136, ks, q);
#pragma unroll
        for (int m = 0; m < 8; ++m) { const bf16x8 a = ld_frag_l(bmT + (m * 16 + l15) * 136, ks, q); acc[0][m] = mma16(a, b0, acc[0][m]); acc[1][m] = mma16(a, b1, acc[1][m]); }
    }
    bf16_t* ST = (bf16_t*)(p.ws + WS_SSD) + (size_t)(lb * 32 + n) * 8 * 8192;
#pragma unroll
    for (int a = 0; a < 2; ++a) { const int rp = (2 * wave + a) * 16 + l15, hh = g * 4 + (rp >> 6), pp = rp & 63;
#pragma unroll
        for (int m = 0; m < 8; ++m) { u32x2 w; w.x = pk2m(acc[a][m][0], acc[a][m][1]); w.y = pk2m(acc[a][m][2], acc[a][m][3]);
            *(u32x2*)(ST + (size_t)hh * 8192 + pp * 128 + m * 16 + 4 * q) = w; } }
}
__device__ __forceinline__ void ssd_scan(const Ctx& c) {
    PHASE_TID();
    const Params& p = *c.p; const float* SM = (const float*)(p.ws + WS_SMALL);
    for (int e = c.bid * 512 + tid; e < GB * 8 * 4096; e += c.G * 512) {
        const int lb = e >> 15, hh = (e >> 12) & 7, pr = e & 4095;
        unsigned* base = (unsigned*)(p.ws + WS_SSD) + (size_t)(lb * 32) * 8 * 4096 + (size_t)hh * 4096 + pr;
        unsigned v[32]; float cdv[32];
#pragma unroll
        for (int n = 0; n < 32; ++n) { v[n] = base[(size_t)n * 8 * 4096]; cdv[n] = SM[SM_SSD_CD + (lb * 8 + hh) * 32 + n]; }
        float r0 = 0.f, r1 = 0.f;
#pragma unroll
        for (int n = 0; n < 32; ++n) { base[(size_t)n * 8 * 4096] = pk2(r0, r1); r0 = cdv[n] * r0 + bflo(v[n]); r1 = cdv[n] * r1 + bfhi(v[n]); }
    }
}
__device__ __forceinline__ void ssd3_unit(const Ctx& c, int layer, int lb, int n) {
    PHASE_TID();
    const Params& p = *c.p; const bf16_t* P = (const bf16_t*)(p.ws + WS_P); bf16_t* YS = (bf16_t*)(p.ws + WS_YS);
    const float* cw = p.in[14] + (size_t)layer * 4 * 1024; const float* cbias = p.in[15] + layer * 1024;
    const float* dskip = p.in[18] + layer * 8;
    LAS float* dtL = (LAS float*)c.lds; LAS float* csL = (LAS float*)(c.lds + 4096);
    LAS bf16_t* cmL = (LAS bf16_t*)(c.lds + 8192);
    LAS bf16_t* bmL = (LAS bf16_t*)(c.lds + 8192 + 34816);
    LAS bf16_t* xdT = (LAS bf16_t*)(c.lds + 8192 + 34816);
    const int r0 = lb * SEQ + n * 128, q = lane >> 4, l15 = lane & 15;
    const size_t row = (size_t)(r0 + wave * 16 + l15);
    const bf16_t* SP = (const bf16_t*)(p.ws + WS_SSD) + (size_t)(lb * 32 + n) * 8 * 8192;
    __syncthreads();
    ssd_dt_tables(c, layer, lb, n, 0, 8, dtL, csL, tid, false);
    float ssq = 0.f;
    for (int g = 0; g < 2; ++g) {
        __syncthreads();
        for (int e = tid; e < 32 * 32; e += 512) { const int s0 = (e >> 5) * 4, blk = e & 31; float y[4][8];
            const int ch0 = (blk < 16 ? 768 : 512) + g * 128 + (blk & 15) * 8;
            ssd_conv8x4(P + (size_t)(r0 + s0) * PW + C_DX + ch0, n * 128 + s0, cw, cbias, ch0, y);
#pragma unroll
            for (int t = 0; t < 4; ++t) { u32x4 w; w.x = pk2(y[t][0], y[t][1]); w.y = pk2(y[t][2], y[t][3]); w.z = pk2(y[t][4], y[t][5]); w.w = pk2(y[t][6], y[t][7]);
                *(LAS u32x4*)((blk < 16 ? cmL : bmL) + (s0 + t) * 136 + (blk & 15) * 8) = w; } }
        __syncthreads();
        bf16x8 cmf[4];
#pragma unroll
        for (int ks = 0; ks < 4; ++ks) cmf[ks] = ld_frag_l(cmL + (wave * 16 + l15) * 136, ks, q);
        f32x4 cbT[8];
#pragma unroll
        for (int st = 0; st < 8; ++st) { cbT[st] = (f32x4){0.f, 0.f, 0.f, 0.f};
            if (st <= wave) {
#pragma unroll
                for (int ks = 0; ks < 4; ++ks) cbT[st] = mma16(ld_frag_l(bmL + (st * 16 + l15) * 136, ks, q), cmf[ks], cbT[st]); } }
        __syncthreads();
        for (int e = tid; e < 32 * 32; e += 512) { const int s0 = (e >> 5) * 4, b2 = e & 31, r = b2 >> 3, ch0 = (g * 4 + r) * 64 + (b2 & 7) * 8; float y[4][8];
            ssd_conv8x4(P + (size_t)(r0 + s0) * PW + C_DX + ch0, n * 128 + s0, cw, cbias, ch0, y);
            const float f0 = dtL[s0 * 8 + g * 4 + r], f1 = dtL[(s0 + 1) * 8 + g * 4 + r], f2 = dtL[(s0 + 2) * 8 + g * 4 + r], f3 = dtL[(s0 + 3) * 8 + g * 4 + r];
#pragma unroll
            for (int k = 0; k < 8; ++k) { u32x2 w; w.x = pk2(y[0][k] * f0, y[1][k] * f1); w.y = pk2(y[2][k] * f2, y[3][k] * f3); *(LAS u32x2*)(xdT + (b2 * 8 + k) * 136 + s0) = w; } }
        __syncthreads();
        const int cpos = wave * 16 + l15;
#pragma unroll 1
        for (int r = 0; r < 4; ++r) { const int hh = g * 4 + r; const float csc = csL[cpos * 8 + hh];
            f32x4 yd[4], yo[4];
#pragma unroll
            for (int pt = 0; pt < 4; ++pt) { yd[pt] = (f32x4){0.f, 0.f, 0.f, 0.f}; yo[pt] = (f32x4){0.f, 0.f, 0.f, 0.f}; }
#pragma unroll
            for (int ks = 0; ks < 4; ++ks) {
                if (2 * ks <= wave) {
                    f32x4 m0, m1;
#pragma unroll
                    for (int i = 0; i < 4; ++i) { const int s0 = 32 * ks + 4 * q + i, s1 = s0 + 16;
                        m0[i] = s0 <= cpos ? cbT[2 * ks][i] * __expf(fminf(csc - csL[s0 * 8 + hh], 0.f)) : 0.f;
                        m1[i] = s1 <= cpos ? cbT[2 * ks + 1][i] * __expf(fminf(csc - csL[s1 * 8 + hh], 0.f)) : 0.f; }
                    const bf16x8 mf = pack_frag(m0, m1);
#pragma unroll
                    for (int pt = 0; pt < 4; ++pt) yd[pt] = mma16(ld_frag_perm_l(xdT + (r * 64 + pt * 16 + l15) * 136, ks, q), mf, yd[pt]);
                }
#pragma unroll
                for (int pt = 0; pt < 4; ++pt) yo[pt] = mma16(ld_frag_g(SP + (size_t)hh * 8192 + (pt * 16 + l15) * 128, ks, q), cmf[ks], yo[pt]);
            }
            const float ecs = __expf(csc), dsk = dskip[hh] / dtL[cpos * 8 + hh];
            u32x2 zr4[4];
#pragma unroll
            for (int pt = 0; pt < 4; ++pt) zr4[pt] = *(const u32x2*)(P + row * PW + C_DZ + hh * 64 + pt * 16 + 4 * q);
            asm volatile("" ::: "memory");
#pragma unroll
            for (int pt = 0; pt < 4; ++pt) { const int ch = hh * 64 + pt * 16 + 4 * q;
                const u32x2 zr = zr4[pt];
                float yv[4];
#pragma unroll
                for (int i = 0; i < 4; ++i) yv[i] = yd[pt][i] + ecs * yo[pt][i] + dsk * bf2f(xdT[(r * 64 + pt * 16 + 4 * q + i) * 136 + cpos]);
                yv[0] *= fsilu(bflo(zr.x)); yv[1] *= fsilu(bfhi(zr.x)); yv[2] *= fsilu(bflo(zr.y)); yv[3] *= fsilu(bfhi(zr.y));
                ssq += (yv[0] * yv[0] + yv[1] * yv[1]) + (yv[2] * yv[2] + yv[3] * yv[3]);
                u32x2 w; w.x = pk2(yv[0], yv[1]); w.y = pk2(yv[2], yv[3]);
                *(u32x2*)(YS + row * YW + 3 * BW + ch) = w; }
        }
    }
    ssq += shx(ssq, 16, lane); ssq += shx(ssq, 32, lane);
    if (q == 0) ((float*)(p.ws + WS_SMALL))[SM_SSD_RS + row] = rsqrtf(ssq * (1.f / BW) + 1e-6f);
}

__device__ __forceinline__ float row16_sum(float v) {
    v += __builtin_bit_cast(float, __builtin_amdgcn_mov_dpp(__builtin_bit_cast(int, v), 0xB1, 0xF, 0xF, true));
    v += __builtin_bit_cast(float, __builtin_amdgcn_mov_dpp(__builtin_bit_cast(int, v), 0x4E, 0xF, 0xF, true));
    v += __builtin_bit_cast(float, __builtin_amdgcn_mov_dpp(__builtin_bit_cast(int, v), 0x141, 0xF, 0xF, true));
    v += __builtin_bit_cast(float, __builtin_amdgcn_mov_dpp(__builtin_bit_cast(int, v), 0x140, 0xF, 0xF, true));
    return v;
}
__device__ __forceinline__ void gdn_pre_unit(const Ctx& c, int layer, int lb, int n, int h) {
    PHASE_TID();
    const Params& p = *c.p; const bf16_t* P = (const bf16_t*)(p.ws + WS_P);
    const float* cw = p.in[4] + (size_t)layer * 4 * 1536;
    LAS bf16_t* qL = (LAS bf16_t*)c.lds; LAS bf16_t* kL = (LAS bf16_t*)(c.lds + 17408); LAS bf16_t* vL = (LAS bf16_t*)(c.lds + 34816);
    LAS float* Lm = (LAS float*)(c.lds + 52224);
    LAS float* gcL = (LAS float*)(c.lds + 69632); LAS float* btL = (LAS float*)(c.lds + 69888);
    LAS bf16_t* LbL = (LAS bf16_t*)(c.lds + 70144);
    LAS bf16_t* XT = (LAS bf16_t*)(c.lds + 79360);
    unsigned char* scr = p.ws + WS_GDN + (size_t)((lb * 4 + h) * 64 + n) * GDN_CH_BYTES;
    bf16_t* WK = (bf16_t*)scr; bf16_t* U0T = (bf16_t*)(scr + 16384); bf16_t* QD = (bf16_t*)(scr + 32768); bf16_t* KDT = (bf16_t*)(scr + 49152); bf16_t* QK = (bf16_t*)(scr + 65536);
    const int r0 = lb * SEQ + n * 64, q = lane >> 4, l15 = lane & 15;
    __syncthreads();
    { unsigned z0 = 0u; asm volatile("" : "+v"(z0));
      for (int i = tid; i < 2304; i += 512) *(LAS u32x4*)(c.lds + 79360 + i * 16) = (u32x4){z0, z0, z0, z0}; }
    if (wave == 0) {
        const float a_in = bf2f(P[(size_t)(r0 + lane) * PW + C_AA + h]), b_in = bf2f(P[(size_t)(r0 + lane) * PW + C_AB + h]);
        float gl = -__expf(p.in[5][layer * 4 + h]) * fsoftplus(a_in + p.in[6][layer * 4 + h]);
#pragma unroll
        for (int o = 1; o < 64; o <<= 1) { const float t = __builtin_bit_cast(float, __builtin_amdgcn_ds_bpermute((lane - o) << 2, __builtin_bit_cast(int, gl))); if (lane >= o) gl += t; }
        gcL[lane] = gl; btL[lane] = fsigmoid(b_in);
    }
#pragma unroll 1
    for (int j = 0; j < 2; ++j) { const int e = tid + 512 * j;
        if (e < 768) { const int part = e >> 8, s0 = ((e >> 4) & 15) * 4, blk = e & 15, ch0 = part * 512 + h * 128 + blk * 8, tb0 = n * 64 + s0;
            const bf16_t* src = P + (size_t)(r0 + s0) * PW + ch0;
            f32x4 w[4][2];
#pragma unroll
            for (int jj = 0; jj < 4; ++jj) { w[jj][0] = *(const f32x4*)(cw + jj * 1536 + ch0); w[jj][1] = *(const f32x4*)(cw + jj * 1536 + ch0 + 4); }
            float y[4][8];
#pragma unroll
            for (int t = 0; t < 4; ++t)
#pragma unroll
                for (int k = 0; k < 8; ++k) y[t][k] = 0.f;
            u32x4 r[7];
#pragma unroll
            for (int d = -3; d <= 3; ++d) r[d + 3] = (tb0 + d >= 0) ? *(const u32x4*)(src + (ptrdiff_t)d * PW) : (u32x4){0u, 0u, 0u, 0u};
#pragma unroll
            for (int d = -3; d <= 3; ++d) { const u32x4 rr = r[d + 3];
                const float x[8] = {bflo(rr.x), bfhi(rr.x), bflo(rr.y), bfhi(rr.y), bflo(rr.z), bfhi(rr.z), bflo(rr.w), bfhi(rr.w)};
#pragma unroll
                for (int t = 0; t < 4; ++t) { const int jj = d - t + 3;
                    if (jj >= 0 && jj <= 3) {
#pragma unroll
                        for (int k = 0; k < 8; ++k) y[t][k] += w[jj][k >> 2][k & 3] * x[k]; } } }
#pragma unroll
            for (int t = 0; t < 4; ++t) { float ss = 0.f;
#pragma unroll
                for (int k = 0; k < 8; ++k) { y[t][k] = fsilu(y[t][k]); ss += y[t][k] * y[t][k]; }
                ss = row16_sum(ss);
                const float sc = part == 2 ? 1.0f : rsqrtf(ss + 1e-6f) * (part == 0 ? 0.08838834764831845f : 1.0f);
                u32x4 wv; wv.x = pk2(y[t][0] * sc, y[t][1] * sc); wv.y = pk2(y[t][2] * sc, y[t][3] * sc); wv.z = pk2(y[t][4] * sc, y[t][5] * sc); wv.w = pk2(y[t][6] * sc, y[t][7] * sc);
                *(LAS u32x4*)((part == 0 ? qL : part == 1 ? kL : vL) + (s0 + t) * 136 + blk * 8) = wv; } } }
    __syncthreads();
    {
        const int sel = wave >> 2, ct = wave & 3, cc = ct * 16 + l15; const float gcc = gcL[cc], btc = btL[cc];
        bf16x8 bf[4];
#pragma unroll
        for (int ks = 0; ks < 4; ++ks) bf[ks] = ld_frag_l((sel ? qL : kL) + cc * 136, ks, q);
#pragma unroll
        for (int st = 0; st < 4; ++st) { f32x4 d = (f32x4){0.f, 0.f, 0.f, 0.f};
            if (st <= ct) {
#pragma unroll
                for (int ks = 0; ks < 4; ++ks) d = mma16(ld_frag_l(kL + (st * 16 + l15) * 136, ks, q), bf[ks], d); }
            f32x4 o;
#pragma unroll
            for (int i = 0; i < 4; ++i) { const int s = st * 16 + 4 * q + i; const float dec = __expf(fminf(gcc - gcL[s], 0.f));
                o[i] = sel ? (s <= cc ? d[i] * dec : 0.f) : (s < cc ? d[i] * dec * btc : 0.f); }
            if (sel) { u32x2 w; w.x = pk2(o[0], o[1]); w.y = pk2(o[2], o[3]); *(u32x2*)(QK + cc * 64 + st * 16 + 4 * q) = w; }
            else { *(LAS f32x4*)(Lm + cc * 68 + st * 16 + 4 * q) = o; u32x2 w; w.x = pk2(o[0], o[1]); w.y = pk2(o[2], o[3]); *(LAS u32x2*)(LbL + cc * 72 + st * 16 + 4 * q) = w; } }
    }
    __syncthreads();
#pragma unroll
    for (int b = 0; b < 4; ++b) {
        f32x4 U[2] = {(f32x4){0.f, 0.f, 0.f, 0.f}, (f32x4){0.f, 0.f, 0.f, 0.f}};
        if (b > 0) {
#pragma unroll
            for (int ks = 0; ks < (b + 1) / 2; ++ks) { const bf16x8 a = ld_frag_l(LbL + (16 * b + l15) * 72, ks, q);
#pragma unroll
                for (int t = 0; t < 2; ++t) U[t] = mma16(a, ld_frag_l(XT + ((2 * wave + t) * 16 + l15) * 72, ks, q), U[t]); } }
#pragma unroll
        for (int t = 0; t < 2; ++t) { const int col = (2 * wave + t) * 16 + l15; const bool isk = col < 128; const LAS bf16_t* colp = (isk ? kL : vL) + (col & 127);
            float y[4];
#pragma unroll
            for (int i = 0; i < 4; ++i) { const int cc = 16 * b + 4 * q + i; y[i] = btL[cc] * (isk ? __expf(gcL[cc]) : 1.0f) * bf2f(colp[cc * 136]) - U[t][i]; }
#pragma unroll
            for (int qq = 0; qq < 4; ++qq) {
                f32x4 lr[4];
#pragma unroll
                for (int i = 0; i < 4; ++i) lr[i] = *(const LAS f32x4*)(Lm + (16 * b + 4 * q + i) * 68 + 16 * b + 4 * qq);
                if (q == qq) { y[1] -= lr[1][0] * y[0]; y[2] -= lr[2][0] * y[0] + lr[2][1] * y[1]; y[3] -= lr[3][0] * y[0] + lr[3][1] * y[1] + lr[3][2] * y[2]; }
                float bx[4];
#pragma unroll
                for (int i = 0; i < 4; ++i) bx[i] = __builtin_bit_cast(float, __builtin_amdgcn_ds_bpermute((l15 + 16 * qq) << 2, __builtin_bit_cast(int, y[i])));
                if (q > qq) {
#pragma unroll
                    for (int i = 0; i < 4; ++i) y[i] -= (lr[i][0] * bx[0] + lr[i][1] * bx[1]) + (lr[i][2] * bx[2] + lr[i][3] * bx[3]); }
            }
            u32x2 w; w.x = pk2(y[0], y[1]); w.y = pk2(y[2], y[3]);
            *(LAS u32x2*)(XT + col * 72 + 16 * b + 4 * q) = w; }
        __syncthreads();
    }
    {
        const float g63 = gcL[63];
#pragma unroll
        for (int jj = 0; jj < 2; ++jj) { const int e = tid + 512 * jj, v = e >> 3, pc = e & 7;
            *(u32x4*)(U0T + v * 64 + pc * 8) = *(const LAS u32x4*)(XT + (128 + v) * 72 + pc * 8); }
#pragma unroll
        for (int jj = 0; jj < 2; ++jj) { const int e = tid + 512 * jj, cc = e & 63, d0 = (e >> 6) * 8; unsigned short v8[8];
#pragma unroll
            for (int i = 0; i < 8; ++i) v8[i] = XT[(d0 + i) * 72 + cc];
            u32x4 w; w.x = v8[0] | ((unsigned)v8[1] << 16); w.y = v8[2] | ((unsigned)v8[3] << 16); w.z = v8[4] | ((unsigned)v8[5] << 16); w.w = v8[6] | ((unsigned)v8[7] << 16);
            *(u32x4*)(WK + cc * 128 + d0) = w; }
#pragma unroll
        for (int jj = 0; jj < 2; ++jj) { const int e = tid + 512 * jj, s_ = e >> 4, blk = e & 15; const float sc = __expf(gcL[s_]);
            const u32x4 r = *(const LAS u32x4*)(qL + s_ * 136 + blk * 8);
            u32x4 w; w.x = pk2(bflo(r.x) * sc, bfhi(r.x) * sc); w.y = pk2(bflo(r.y) * sc, bfhi(r.y) * sc); w.z = pk2(bflo(r.z) * sc, bfhi(r.z) * sc); w.w = pk2(bflo(r.w) * sc, bfhi(r.w) * sc);
            *(u32x4*)(QD + s_ * 128 + blk * 8) = w; }
#pragma unroll
        for (int jj = 0; jj < 2; ++jj) { const int e = tid + 512 * jj, d = e & 127, s0 = (e >> 7) * 8; float v[8];
#pragma unroll
            for (int i = 0; i < 8; ++i) v[i] = bf2f(kL[(s0 + i) * 136 + d]) * __expf(g63 - gcL[s0 + i]);
            u32x4 w; w.x = pk2(v[0], v[1]); w.y = pk2(v[2], v[3]); w.z = pk2(v[4], v[5]); w.w = pk2(v[6], v[7]);
            *(u32x4*)(KDT + d * 64 + s0) = w; }
        if (tid == 0) ((float*)(p.ws + WS_SMALL))[SM_GDN_CD + (lb * 4 + h) * 64 + n] = __expf(g63);
    }
}

__device__ __forceinline__ void gdn_chain(const Ctx& c, int layer, int lb, int h, int half) {
    PHASE_TID();
    const Params& p = *c.p; bf16_t* YS = (bf16_t*)(p.ws + WS_YS);
    const float* SM = (const float*)(p.ws + WS_SMALL);
    const int q = lane >> 4, l15 = lane & 15, vcol = (half * 4 + (wave & 3)) * 16 + l15;
    const unsigned char* scr0 = p.ws + WS_GDN + (size_t)((lb * 4 + h) * 64) * GDN_CH_BYTES;
    constexpr int BUFB = 62464;
    const bool loader = wave >= 4; const int lt = tid - 256;
#define GDN_LD(r_, nn) do { const unsigned char* sc_ = scr0 + (size_t)(nn) * GDN_CH_BYTES; \
        _Pragma("unroll") for (int j = 0; j < 14; ++j) { const int idx = lt + 256 * j; \
            const size_t so = j < 4 ? (size_t)idx * 16 : j < 8 ? 32768 + (size_t)(idx - 1024) * 16 : j < 12 ? 49152 + (size_t)(idx - 2048) * 16 : 65536 + (size_t)(idx - 3072) * 16; \
            r_[j] = *(const u32x4*)(sc_ + so); } } while (0)
#define GDN_ST(r_, buf) do { ldsp_t b_ = c.lds + (buf) * BUFB; \
        _Pragma("unroll") for (int j = 0; j < 14; ++j) { const int idx = lt + 256 * j; \
            const int lo = j < 4 ? (idx >> 4) * 272 + (idx & 15) * 16 : j < 8 ? 17408 + ((idx - 1024) >> 4) * 272 + (idx & 15) * 16 \
                         : j < 12 ? 34816 + ((idx - 2048) >> 3) * 144 + (idx & 7) * 16 : 53248 + ((idx - 3072) >> 3) * 144 + (idx & 7) * 16; \
            *(LAS u32x4*)(b_ + lo) = r_[j]; } } while (0)
    f32x4 st[8];
#pragma unroll
    for (int d = 0; d < 8; ++d) st[d] = (f32x4){0.f, 0.f, 0.f, 0.f};
    u32x2 u0r[4]; float cdn = 0.f;
    __syncthreads();
    if (loader) {
        u32x4 ra[14], rb[14], rc[14];
        GDN_LD(ra, 0); GDN_LD(rb, 1); GDN_LD(rc, 2);
        GDN_ST(ra, 0); GDN_LD(ra, 3);
        __syncthreads();
#pragma unroll 1
        for (int n = 0; n < 66; n += 3) {
            if (n < 64) { if (n + 1 < 64) { GDN_ST(rb, (n + 1) & 1); if (n + 4 < 64) GDN_LD(rb, n + 4); } __syncthreads(); }
            if (n + 1 < 64) { if (n + 2 < 64) { GDN_ST(rc, (n + 2) & 1); if (n + 5 < 64) GDN_LD(rc, n + 5); } __syncthreads(); }
            if (n + 2 < 64) { if (n + 3 < 64) { GDN_ST(ra, (n + 3) & 1); if (n + 6 < 64) GDN_LD(ra, n + 6); } __syncthreads(); }
        }
        return;
    }
#pragma unroll
    for (int m = 0; m < 4; ++m) u0r[m] = *(const u32x2*)(scr0 + 16384 + (size_t)(vcol * 64 + m * 16 + 4 * q) * 2);
    cdn = SM[SM_GDN_CD + (lb * 4 + h) * 64];
    __syncthreads();
#pragma unroll 1
    for (int n = 0; n < 64; ++n) {
        {
            ldsp_t b = c.lds + (n & 1) * BUFB;
            const LAS bf16_t* wkL = (const LAS bf16_t*)b; const LAS bf16_t* qdL = (const LAS bf16_t*)(b + 17408);
            const LAS bf16_t* kdL = (const LAS bf16_t*)(b + 34816); const LAS bf16_t* qkL = (const LAS bf16_t*)(b + 53248);
            const float cd = cdn;
            f32x4 u0[4];
#pragma unroll
            for (int m = 0; m < 4; ++m) u0[m] = (f32x4){bflo(u0r[m].x), bfhi(u0r[m].x), bflo(u0r[m].y), bfhi(u0r[m].y)};
            if (n < 63) {
                const unsigned char* sn = scr0 + (size_t)(n + 1) * GDN_CH_BYTES;
#pragma unroll
                for (int m = 0; m < 4; ++m) u0r[m] = *(const u32x2*)(sn + 16384 + (size_t)(vcol * 64 + m * 16 + 4 * q) * 2);
                cdn = SM[SM_GDN_CD + (lb * 4 + h) * 64 + n + 1]; }
            bf16x8 sf[4];
#pragma unroll
            for (int ks = 0; ks < 4; ++ks) sf[ks] = pack_frag(st[2 * ks], st[2 * ks + 1]);
            f32x4 x[4], o[4];
#pragma unroll
            for (int m = 0; m < 4; ++m) { x[m] = (f32x4){0.f, 0.f, 0.f, 0.f}; o[m] = (f32x4){0.f, 0.f, 0.f, 0.f};
#pragma unroll
                for (int ks = 0; ks < 4; ++ks) { x[m] = mma16(ld_frag_perm_l(wkL + (m * 16 + l15) * 136, ks, q), sf[ks], x[m]); o[m] = mma16(ld_frag_perm_l(qdL + (m * 16 + l15) * 136, ks, q), sf[ks], o[m]); } }
#pragma unroll
            for (int m = 0; m < 4; ++m) x[m] = u0[m] - x[m];
            bf16x8 uf[2];
#pragma unroll
            for (int k2 = 0; k2 < 2; ++k2) uf[k2] = pack_frag(x[2 * k2], x[2 * k2 + 1]);
#pragma unroll
            for (int d = 0; d < 8; ++d) { st[d] = st[d] * cd;
#pragma unroll
                for (int k2 = 0; k2 < 2; ++k2) st[d] = mma16(ld_frag_perm_l(kdL + (d * 16 + l15) * 72, k2, q), uf[k2], st[d]); }
#pragma unroll
            for (int m = 0; m < 4; ++m)
#pragma unroll
                for (int k2 = 0; k2 < 2; ++k2) o[m] = mma16(ld_frag_perm_l(qkL + (m * 16 + l15) * 72, k2, q), uf[k2], o[m]);
            const size_t rowb = (size_t)(lb * SEQ + n * 64);
#pragma unroll
            for (int m = 0; m < 4; ++m)
#pragma unroll
                for (int i = 0; i < 4; ++i) YS[(rowb + m * 16 + 4 * q + i) * YW + h * 128 + vcol] = f2bfm(o[m][i]);
        }
        __syncthreads();
    }
#undef GDN_LD
#undef GDN_ST
}
__device__ __forceinline__ void gdn_post(const Ctx& c, int layer) {
    PHASE_TID();
    const Params& p = *c.p; const bf16_t* P = (const bf16_t*)(p.ws + WS_P); bf16_t* YS = (bf16_t*)(p.ws + WS_YS);
    const float* ng = p.in[7] + layer * 128;
    const int ch = lane * 8, d0 = ch & 127;
    for (int r = c.bid * 8 + wave; r < TG; r += c.G * 16) {
        u32x4 ov2[2], gr2[2];
#pragma unroll
        for (int k = 0; k < 2; ++k) { const size_t rr = (size_t)(r + k * c.G * 8); ov2[k] = *(const u32x4*)(YS + rr * YW + ch); gr2[k] = *(const u32x4*)(P + rr * PW + C_AG + ch); }
        asm volatile("" ::: "memory");
#pragma unroll
        for (int k = 0; k < 2; ++k) { const size_t rr = (size_t)(r + k * c.G * 8); const u32x4 ov = ov2[k], gr = gr2[k];
            float x[8] = {bflo(ov.x), bfhi(ov.x), bflo(ov.y), bfhi(ov.y), bflo(ov.z), bfhi(ov.z), bflo(ov.w), bfhi(ov.w)};
            const float g8[8] = {bflo(gr.x), bfhi(gr.x), bflo(gr.y), bfhi(gr.y), bflo(gr.z), bfhi(gr.z), bflo(gr.w), bfhi(gr.w)};
            float ss = 0.f;
#pragma unroll
            for (int j = 0; j < 8; ++j) ss += x[j] * x[j];
            ss = row16_sum(ss);
            const float rs = rsqrtf(ss * (1.f / 128.f) + 1e-6f);
#pragma unroll
            for (int j = 0; j < 8; ++j) x[j] = x[j] * rs * ng[d0 + j] * fsilu(g8[j]);
            u32x4 w; w.x = pk2(x[0], x[1]); w.y = pk2(x[2], x[3]); w.z = pk2(x[4], x[5]); w.w = pk2(x[6], x[7]);
            *(u32x4*)(YS + rr * YW + ch) = w; }
        asm volatile("" ::: "memory");
    }
}

__device__ __forceinline__ float row8_sum(float v) {
    v += __builtin_bit_cast(float, __builtin_amdgcn_mov_dpp(__builtin_bit_cast(int, v), 0xB1, 0xF, 0xF, true));
    v += __builtin_bit_cast(float, __builtin_amdgcn_mov_dpp(__builtin_bit_cast(int, v), 0x4E, 0xF, 0xF, true));
    v += __builtin_bit_cast(float, __builtin_amdgcn_mov_dpp(__builtin_bit_cast(int, v), 0x141, 0xF, 0xF, true));
    return v;
}
__device__ __forceinline__ void dsa_prep_unit(const Ctx& c, int layer, int lb, int tt) {
    PHASE_TID();
    const Params& p = *c.p; const bf16_t* P = (const bf16_t*)(p.ws + WS_P);
    bf16_t* DKN = (bf16_t*)(p.ws + WS_DKN) + (size_t)lb * SEQ * 64; bf16_t* DVT = (bf16_t*)(p.ws + WS_DVT) + (size_t)lb * 64 * SEQ;
    bf16_t* DVN = (bf16_t*)(p.ws + WS_VN) + (size_t)lb * SEQ * 64;
    const float* kg = p.in[13] + layer * 64;
    LAS bf16_t* vL = (LAS bf16_t*)c.lds;
    const int t = tid >> 3, pc = tid & 7, tok = tt * 64 + t;
    __syncthreads();
    const bf16_t* src = P + (size_t)(lb * SEQ + tok) * PW;
    const u32x4 kr = *(const u32x4*)(src + C_CK + pc * 8), vr = *(const u32x4*)(src + C_CV + pc * 8);
    const u32x4 ikr = *(const u32x4*)(src + C_CIK + pc * 8);
    float x[8] = {bflo(kr.x), bfhi(kr.x), bflo(kr.y), bfhi(kr.y), bflo(kr.z), bfhi(kr.z), bflo(kr.w), bfhi(kr.w)};
    float ss = 0.f;
#pragma unroll
    for (int k = 0; k < 8; ++k) ss += x[k] * x[k];
    ss = row8_sum(ss);
    const float rs = rsqrtf(ss * (1.f / 64.f) + 1e-6f);
    u32x4 w; w.x = pk2(x[0] * rs * kg[pc * 8 + 0], x[1] * rs * kg[pc * 8 + 1]); w.y = pk2(x[2] * rs * kg[pc * 8 + 2], x[3] * rs * kg[pc * 8 + 3]);
    w.z = pk2(x[4] * rs * kg[pc * 8 + 4], x[5] * rs * kg[pc * 8 + 5]); w.w = pk2(x[6] * rs * kg[pc * 8 + 6], x[7] * rs * kg[pc * 8 + 7]);
    *(u32x4*)(DKN + (size_t)tok * 64 + pc * 8) = w;
    *(u32x4*)(DVN + (size_t)tok * 64 + pc * 8) = vr;
    *(u32x4*)((bf16_t*)(p.ws + WS_IKC) + (size_t)(lb * SEQ + tok) * 64 + pc * 8) = ikr;
    vL[(pc * 8 + 0) * 72 + t] = (bf16_t)(vr.x & 0xffffu); vL[(pc * 8 + 1) * 72 + t] = (bf16_t)(vr.x >> 16);
    vL[(pc * 8 + 2) * 72 + t] = (bf16_t)(vr.y & 0xffffu); vL[(pc * 8 + 3) * 72 + t] = (bf16_t)(vr.y >> 16);
    vL[(pc * 8 + 4) * 72 + t] = (bf16_t)(vr.z & 0xffffu); vL[(pc * 8 + 5) * 72 + t] = (bf16_t)(vr.z >> 16);
    vL[(pc * 8 + 6) * 72 + t] = (bf16_t)(vr.w & 0xffffu); vL[(pc * 8 + 7) * 72 + t] = (bf16_t)(vr.w >> 16);
    __syncthreads();
    { const int d = tid >> 3; *(u32x4*)(DVT + (size_t)d * SEQ + tt * 64 + pc * 8) = *(const LAS u32x4*)(vL + d * 72 + pc * 8); }
}

__device__ __forceinline__ void dsa1_unit(const Ctx& c, int layer, int lb, int qt) {
    PHASE_TID();
    const Params& p = *c.p; const bf16_t* P = (const bf16_t*)(p.ws + WS_P);
    unsigned short* SEL = (unsigned short*)(p.ws + WS_MASK) + (size_t)lb * SEQ * 256;
    unsigned* MASK = (unsigned*)(p.ws + WS_MASK) + (size_t)lb * SEQ * 128;
    LAS unsigned* hist = (LAS unsigned*)c.lds;
    LAS unsigned short* mk16 = (LAS unsigned short*)(c.lds + 16512);
    LAS float* redL = (LAS float*)(c.lds + 24704);
    LAS int* selL = (LAS int*)(c.lds + 25728);
    const int q = lane >> 4, l15 = lane & 15, t0 = qt * 16, tq = t0 + l15, nb = qt + 1;
    __syncthreads();
    if (qt < 16) {
        const int qq = tid >> 5, wl = tid & 31, t = t0 + qq;
        if (wl <= (t >> 5)) MASK[(size_t)t * 128 + wl] = wl < (t >> 5) ? 0xFFFFFFFFu : (0xFFFFFFFFu >> (31 - (t & 31)));
        return;
    }
    const bf16_t* qrow = P + (size_t)(lb * SEQ + tq) * PW;
    LAS bf16_t* iqL = (LAS bf16_t*)(c.lds + 26624);
    LAS h2_t* wqL = (LAS h2_t*)(c.lds + 45568);
    const int qq_ = tid >> 5, pc2_ = tid & 31;
    const u32x4 iqa = *(const u32x4*)(P + (size_t)(lb * SEQ + t0 + qq_) * PW + C_CIQ + pc2_ * 16), iqb = *(const u32x4*)(P + (size_t)(lb * SEQ + t0 + qq_) * PW + C_CIQ + pc2_ * 16 + 8);
    const bf16_t* kbase = (const bf16_t*)(p.ws + WS_IKC) + (size_t)(lb * SEQ) * 64;
    const u32x4 wraw2 = *(const u32x4*)(P + (size_t)(lb * SEQ + t0 + qq_) * PW + C_CIW);
    const int ring = wave < 2 ? wave * 12288 : 46336 + (wave - 2) * 12288;
    const unsigned kvoff = (unsigned)((lane >> 3) * 128 + (((lane & 7) ^ ((lane >> 3) & 7)) * 16));
    const char* kgb = (const char*)kbase;
#define KDMA(pj) do { _Pragma("unroll") for (int hf = 0; hf < 2; ++hf) { int blk = 16 * (pj) + 8 * hf + wave; blk = blk > 255 ? 255 : blk; \
        const char* gb_ = kgb + (size_t)blk * 2048; asm volatile("" : "+s"(gb_)); \
        _Pragma("unroll") for (int jj = 0; jj < 2; ++jj) __builtin_amdgcn_global_load_lds((const unsigned*)(gb_ + jj * 1024 + kvoff), (LAS unsigned*)(c.lds + ring + ((pj) % 3) * 4096 + hf * 2048 + jj * 1024), 16, 0, 0); } } while (0)
    KDMA(0); KDMA(1);
    const int fa0 = (l15 * 8 + (q ^ (l15 & 7))) * 16, fa1 = (l15 * 8 + ((4 + q) ^ (l15 & 7))) * 16;
    *(LAS u32x4*)(iqL + qq_ * 592 + pc2_ * 16) = iqa; *(LAS u32x4*)(iqL + qq_ * 592 + pc2_ * 16 + 8) = iqb;
    __syncthreads();
    {
        const float w8[8] = {bflo(wraw2.x) * 0.022097086912079608f, bfhi(wraw2.x) * 0.022097086912079608f, bflo(wraw2.y) * 0.022097086912079608f, bfhi(wraw2.y) * 0.022097086912079608f,
                             bflo(wraw2.z) * 0.022097086912079608f, bfhi(wraw2.z) * 0.022097086912079608f, bflo(wraw2.w) * 0.022097086912079608f, bfhi(wraw2.w) * 0.022097086912079608f};
        float c0 = 0.f, c1 = 0.f;
#pragma unroll
        for (int h = 0; h < 8; ++h) { const unsigned v = *(const LAS unsigned*)(iqL + qq_ * 592 + h * 64 + pc2_ * 2); c0 += w8[h] * bflo(v); c1 += w8[h] * bfhi(v); }
        *(LAS unsigned*)(iqL + qq_ * 592 + 512 + pc2_ * 2) = pk2(c0, c1);
        if (pc2_ == 0) {
#pragma unroll
            for (int h = 0; h < 8; ++h) wqL[qq_ * 9 + h] = __builtin_amdgcn_cvt_pkrtz(w8[h], w8[h]); }
    }
    __syncthreads();
    const LAS bf16_t* iqrow = iqL + l15 * 592;
    const LAS h2_t* wqrow = wqL + l15 * 9;
    f32x4 sc[32];
    float mn = 3.0e38f, mx = -3.0e38f;
#ifdef SPIN_SC
    const unsigned long long ts0_ = __builtin_amdgcn_s_memrealtime();
#endif
#pragma unroll
    for (int i = 0; i < 32; i += 2) { const int kb = 8 * i + wave;
        sc[i] = (f32x4){0.f, 0.f, 0.f, 0.f}; sc[i + 1] = (f32x4){0.f, 0.f, 0.f, 0.f};
        if (kb < nb) {
            KDMA(i / 2 + 2);
            asm volatile("s_waitcnt vmcnt(8)" ::: "memory");
            const LAS unsigned char* slot = c.lds + ring + ((i / 2) % 3) * 4096;
            const bf16x8 a00 = *(const LAS bf16x8*)(slot + fa0), a01 = *(const LAS bf16x8*)(slot + fa1), a10 = *(const LAS bf16x8*)(slot + 2048 + fa0), a11 = *(const LAS bf16x8*)(slot + 2048 + fa1);
            bf16x8 f0 = ld_frag_l(iqrow, 0, q), f1 = ld_frag_l(iqrow, 1, q);
            h2_t wn = wqrow[0]; h2_t t16[4] = {(h2_t){0, 0}, (h2_t){0, 0}, (h2_t){0, 0}, (h2_t){0, 0}};
            f32x4 e0 = mma16(a00, f0, (f32x4){0.f, 0.f, 0.f, 0.f}), e1 = mma16(a10, f0, (f32x4){0.f, 0.f, 0.f, 0.f}); e0 = mma16(a01, f1, e0); e1 = mma16(a11, f1, e1);
            f0 = ld_frag_l(iqrow + 64, 0, q); f1 = ld_frag_l(iqrow + 64, 1, q);
#pragma unroll
            for (int h = 0; h < 8; ++h) { const f32x4 d0 = e0, d1 = e1;
                const h2_t wh = wn;
                __builtin_amdgcn_sched_barrier(0);
                e0 = mma16(a00, f0, (f32x4){0.f, 0.f, 0.f, 0.f}); e1 = mma16(a10, f0, (f32x4){0.f, 0.f, 0.f, 0.f}); e0 = mma16(a01, f1, e0); e1 = mma16(a11, f1, e1);
                __builtin_amdgcn_sched_barrier(0);
                if (h < 7) { f0 = ld_frag_l(iqrow + (h + 2) * 64, 0, q); f1 = ld_frag_l(iqrow + (h + 2) * 64, 1, q); wn = wqrow[h + 1]; }
                t16[0] += wh * __builtin_elementwise_abs(__builtin_amdgcn_cvt_pkrtz(d0[0], d0[1])); t16[1] += wh * __builtin_elementwise_abs(__builtin_amdgcn_cvt_pkrtz(d0[2], d0[3]));
                t16[2] += wh * __builtin_elementwise_abs(__builtin_amdgcn_cvt_pkrtz(d1[0], d1[1])); t16[3] += wh * __builtin_elementwise_abs(__builtin_amdgcn_cvt_pkrtz(d1[2], d1[3]));
                }
            f32x4 tot0 = e0, tot1 = e1;
            tot0[0] += (float)t16[0][0]; tot0[1] += (float)t16[0][1]; tot0[2] += (float)t16[1][0]; tot0[3] += (float)t16[1][1];
            tot1[0] += (float)t16[2][0]; tot1[1] += (float)t16[2][1]; tot1[2] += (float)t16[3][0]; tot1[3] += (float)t16[3][1];
            const f32x4 nan4 = (f32x4){__int_as_float(0x7fc00000), __int_as_float(0x7fc00000), __int_as_float(0x7fc00000), __int_as_float(0x7fc00000)};
            sc[i] = tot0; sc[i + 1] = (kb + 8 < nb) ? tot1 : nan4;
            if (kb + 8 >= qt) {
#pragma unroll
                for (int e = 0; e < 4; ++e) { if (kb * 16 + 4 * q + e > tq) sc[i][e] = __int_as_float(0x7fc00000); if ((kb + 8) * 16 + 4 * q + e > tq) sc[i + 1][e] = __int_as_float(0x7fc00000); } }
#pragma unroll
            for (int e = 0; e < 4; ++e) { mn = fminf(mn, fminf(sc[i][e], sc[i + 1][e])); mx = fmaxf(mx, fmaxf(sc[i][e], sc[i + 1][e])); }
        } else {
#pragma unroll
            for (int e = 0; e < 4; ++e) { sc[i][e] = __int_as_float(0x7fc00000); sc[i + 1][e] = __int_as_float(0x7fc00000); }
        }
    }
    asm volatile("s_waitcnt vmcnt(0)" ::: "memory");
#undef KDMA
#ifdef SPIN_SC
    { const unsigned long long ts1_ = __builtin_amdgcn_s_memrealtime(), dt_ = ts1_ - ts0_; while (__builtin_amdgcn_s_memrealtime() - ts1_ < dt_) __builtin_amdgcn_s_sleep(1); }
#endif
    mn = fminf(mn, shx(mn, 16, lane)); mn = fminf(mn, shx(mn, 32, lane)); mx = fmaxf(mx, shx(mx, 16, lane)); mx = fmaxf(mx, shx(mx, 32, lane));
    if (q == 0) { redL[(wave * 16 + l15) * 2] = mn; redL[(wave * 16 + l15) * 2 + 1] = mx; }
    __syncthreads();
#pragma unroll
    for (int w = 0; w < 8; ++w) { mn = fminf(mn, redL[(w * 16 + l15) * 2]); mx = fmaxf(mx, redL[(w * 16 + l15) * 2 + 1]); }
    const float scale = mx > mn ? 16777215.0f / (mx - mn) : 0.f;
    const float nms = -mn * scale;
#pragma unroll
    for (int i = 0; i < 32; ++i) {
        if (8 * i + wave < nb) {
#pragma unroll
            for (int e = 0; e < 4; ++e)
                sc[i][e] = __int_as_float((int)__builtin_amdgcn_fmed3f(__builtin_fmaf(sc[i][e], scale, nms), -1.0f, 16777215.0f));
        } else sc[i] = (f32x4){__int_as_float(-1), __int_as_float(-1), __int_as_float(-1), __int_as_float(-1)}; }
    for (int i = tid; i < 2048; i += 512) ((LAS unsigned*)mk16)[i] = 0u;
    int pref = 0, krem = 256;
#ifdef REP_DSA1_SEL
#pragma unroll 1
    for (int rep_ = 0; rep_ < 2; ++rep_) { pref = 0; krem = 256; __syncthreads();
#endif
#pragma unroll 1
    for (int pass = 0; pass < 3; ++pass) { const int shift = 16 - 8 * pass;
        for (int i = tid; i < 16 * 257; i += 512) hist[i] = 0u;
        __syncthreads();
#pragma unroll
        for (int i = 0; i < 32; ++i) if (8 * i + wave < nb) {
            bool hit[4]; bool anyhit = false;
#pragma unroll
            for (int e = 0; e < 4; ++e) { hit[e] = ((unsigned)__float_as_int(sc[i][e]) >> (shift + 8)) == (unsigned)pref; anyhit |= hit[e]; }
            if (__any(anyhit)) {
#pragma unroll
                for (int e = 0; e < 4; ++e) { const unsigned key = (unsigned)__float_as_int(sc[i][e]);
                    if (hit[e]) __hip_atomic_fetch_add(hist + l15 * 257 + ((key >> shift) & 255u), 1u, __ATOMIC_RELAXED, __HIP_MEMORY_SCOPE_WORKGROUP); } } }
        __syncthreads();
        {
            const int qq = 2 * wave + (lane >> 5), hl = lane & 31; int kr = krem;
            if (pass > 0) kr = selL[qq * 2 + 1];
            unsigned cnt[8]; unsigned s8 = 0;
#pragma unroll
            for (int b = 0; b < 8; ++b) { cnt[b] = hist[qq * 257 + hl * 8 + b]; s8 += cnt[b]; }
            unsigned suf = s8;
#pragma unroll
            for (int o = 1; o < 32; o <<= 1) { const unsigned t2 = (unsigned)__builtin_amdgcn_ds_bpermute((lane + o) << 2, (int)suf); if (hl + o < 32) suf += t2; }
            const unsigned after = suf - s8;
            __syncthreads();
            if (after < (unsigned)kr && (unsigned)kr <= after + s8) { unsigned cum = after; int bsel = 0, knew = 1; bool done = false;
#pragma unroll
                for (int b = 7; b >= 0; --b) { if (!done && cum + cnt[b] >= (unsigned)kr) { bsel = hl * 8 + b; knew = kr - (int)cum; done = true; } cum += cnt[b]; }
                selL[qq * 2] = bsel; selL[qq * 2 + 1] = knew; }
        }
        __syncthreads();
        pref = (pref << 8) | selL[l15 * 2]; krem = selL[l15 * 2 + 1];
    }
#ifdef REP_DSA1_SEL
    }
#endif
#ifdef REP_DSA1_TAIL
#pragma unroll 1
    for (int rep_ = 0; rep_ < 2; ++rep_) { __syncthreads();
#endif
#pragma unroll
    for (int i = 0; i < 32; ++i) { const int kb = 8 * i + wave;
        if (kb < nb) { unsigned nib = 0;
#pragma unroll
            for (int e = 0; e < 4; ++e) { const int key = __float_as_int(sc[i][e]); nib |= (key >= pref ? 1u : 0u) << e; }
            unsigned v = nib << (4 * q); v |= shxu(v, 16, lane); v |= shxu(v, 32, lane);
            if (q == 0) mk16[l15 * 256 + kb] = (unsigned short)v; } }
    __syncthreads();
    if (t0 < QSPLIT) {
        const int qq = tid >> 5, wl = tid & 31, t = t0 + qq; const LAS unsigned* mrow = (const LAS unsigned*)(mk16 + qq * 256);
        for (int w4 = wl; w4 <= (t >> 5); w4 += 32) MASK[(size_t)t * 128 + w4] = mrow[w4];
    } else
    {
        const int qq = tid >> 5, wl = tid & 31, t = t0 + qq; const LAS unsigned* mrow = (const LAS unsigned*)(mk16 + qq * 256);
        unsigned w[4]; int cnt = 0;
#pragma unroll
        for (int j = 0; j < 4; ++j) { w[j] = mrow[wl * 4 + j]; cnt += __builtin_popcount(w[j]); }
        int incl = cnt;
#pragma unroll
        for (int o = 1; o < 32; o <<= 1) { const int v = __builtin_amdgcn_ds_bpermute((lane - o) << 2, incl); if (wl >= o) incl += v; }
        int pos = incl - cnt;
        unsigned short* dst = SEL + (size_t)t * 256;
#pragma unroll
        for (int j = 0; j < 4; ++j) { unsigned ww = w[j];
            while (ww) { const int b = __builtin_ctz(ww); ww &= ww - 1u; if (pos < 256) dst[pos] = (unsigned short)((wl * 4 + j) * 32 + b); ++pos; } }
    }
#ifdef REP_DSA1_TAIL
    }
#endif
}

__device__ __forceinline__ void dsa2_tile(const Ctx& c, int layer, int lb, int jt) {
    PHASE_TID();
    const Params& p = *c.p; const bf16_t* P = (const bf16_t*)(p.ws + WS_P); bf16_t* YS = (bf16_t*)(p.ws + WS_YS);
    const bf16_t* DKN = (const bf16_t*)(p.ws + WS_DKN) + (size_t)lb * SEQ * 64; const bf16_t* DVT = (const bf16_t*)(p.ws + WS_DVT) + (size_t)lb * 64 * SEQ;
    const unsigned* MASK = (const unsigned*)(p.ws + WS_MASK) + (size_t)lb * SEQ * 128;
    const float* qg = p.in[12] + layer * 64;
    constexpr int KVB = 35840;
    const int q = lane >> 4, l15 = lane & 15, qs = wave & 1, hp = wave >> 1, tq = jt * 32 + qs * 16 + l15, tmaxw = jt * 32 + qs * 16 + 15;
    const size_t row = (size_t)(lb * SEQ + tq);
    const int nck = (jt * 32 + 32 + 127) >> 7;
    bf16x8 qf[2][2];
#pragma unroll
    for (int hh = 0; hh < 2; ++hh) { const int h = hp * 2 + hh; float x[2][8]; float ss = 0.f;
#pragma unroll
        for (int ks = 0; ks < 2; ++ks) { const u32x4 r = *(const u32x4*)(P + row * PW + C_CQ + h * 64 + 32 * ks + 8 * q);
            x[ks][0] = bflo(r.x); x[ks][1] = bfhi(r.x); x[ks][2] = bflo(r.y); x[ks][3] = bfhi(r.y); x[ks][4] = bflo(r.z); x[ks][5] = bfhi(r.z); x[ks][6] = bflo(r.w); x[ks][7] = bfhi(r.w);
#pragma unroll
            for (int k = 0; k < 8; ++k) ss += x[ks][k] * x[ks][k]; }
        ss += shx(ss, 16, lane); ss += shx(ss, 32, lane);
        const float rs = rsqrtf(ss * (1.f / 64.f) + 1e-6f) * (0.125f * 1.4426950408889634f);
#pragma unroll
        for (int ks = 0; ks < 2; ++ks) { const float* gp = qg + 32 * ks + 8 * q; u32x4 w;
            w.x = pk2m(x[ks][0] * rs * gp[0], x[ks][1] * rs * gp[1]); w.y = pk2m(x[ks][2] * rs * gp[2], x[ks][3] * rs * gp[3]);
            w.z = pk2m(x[ks][4] * rs * gp[4], x[ks][5] * rs * gp[5]); w.w = pk2m(x[ks][6] * rs * gp[6], x[ks][7] * rs * gp[7]);
            qf[hh][ks] = __builtin_bit_cast(bf16x8, w); } }
    const float sl2[2] = {exp2f(-(float)(hp * 2 + 1)) * 1.4426950408889634f, exp2f(-(float)(hp * 2 + 2)) * 1.4426950408889634f};
    f32x4 oacc[2][4]; float mrun[2] = {-3.0e38f, -3.0e38f}, lrun[2] = {0.f, 0.f};
#pragma unroll
    for (int hh = 0; hh < 2; ++hh)
#pragma unroll
        for (int d = 0; d < 4; ++d) oacc[hh][d] = (f32x4){0.f, 0.f, 0.f, 0.f};
    u32x4 kreg[2], vreg[2];
#define DSA_LOAD(ck) do { _Pragma("unroll") for (int j = 0; j < 2; ++j) { const int idx = tid + 512 * j; \
        kreg[j] = *(const u32x4*)(DKN + (size_t)((ck) * 128 + (idx >> 3)) * 64 + (idx & 7) * 8); \
        vreg[j] = *(const u32x4*)(DVT + (size_t)(idx >> 4) * SEQ + (ck) * 128 + (idx & 15) * 8); } } while (0)
#define DSA_STORE(buf) do { ldsp_t b_ = c.lds + (buf) * KVB; _Pragma("unroll") for (int j = 0; j < 2; ++j) { const int idx = tid + 512 * j; \
        *(LAS u32x4*)(b_ + (idx >> 3) * 144 + (idx & 7) * 16) = kreg[j]; *(LAS u32x4*)(b_ + 18432 + (idx >> 4) * 272 + (idx & 15) * 16) = vreg[j]; } } while (0)
    __syncthreads();
    DSA_LOAD(0); DSA_STORE(0);
    __syncthreads();
    u32x4 mwn = *(const u32x4*)(MASK + (size_t)tq * 128);
#pragma unroll 1
    for (int ck = 0; ck < nck; ++ck) {
        const u32x4 mwc = mwn;
        if (ck + 1 < nck) { DSA_LOAD(ck + 1); mwn = *(const u32x4*)(MASK + (size_t)tq * 128 + (ck + 1) * 4); }
        ldsp_t b = c.lds + (ck & 1) * KVB; const LAS bf16_t* knL = (const LAS bf16_t*)b; const LAS bf16_t* vtL = (const LAS bf16_t*)(b + 18432);
#pragma unroll
        for (int s2 = 0; s2 < 2; ++s2) { const int key0 = ck * 128 + s2 * 64;
            if (key0 <= tmaxw) {
                unsigned w0 = s2 ? mwc.z : mwc.x, w1 = s2 ? mwc.w : mwc.y;
                w0 = key0 <= tq ? w0 : 0u; w1 = key0 + 32 <= tq ? w1 : 0u;
                bf16x8 ka[4][2];
#pragma unroll
                for (int kt = 0; kt < 4; ++kt)
#pragma unroll
                    for (int ks = 0; ks < 2; ++ks) ka[kt][ks] = ld_frag_l(knL + (s2 * 64 + kt * 16 + l15) * 72, ks, q);
                const float dbase = (float)(key0 + 4 * q - tq);
#pragma unroll
                for (int hh = 0; hh < 2; ++hh) {
                    f32x4 sv[4];
#pragma unroll
                    for (int kt = 0; kt < 4; ++kt) { sv[kt] = mma16(ka[kt][0], qf[hh][0], (f32x4){0.f, 0.f, 0.f, 0.f}); sv[kt] = mma16(ka[kt][1], qf[hh][1], sv[kt]); }
                    float tmax = -3.0e38f;
#pragma unroll
                    for (int kt = 0; kt < 4; ++kt)
#pragma unroll
                        for (int e = 0; e < 4; ++e) { const unsigned wsel = kt < 2 ? w0 : w1; const bool on = (wsel >> ((kt & 1) * 16 + 4 * q + e)) & 1u;
                            const float xv = on ? sv[kt][e] + sl2[hh] * (dbase + (float)(kt * 16 + e)) : -3.0e38f; sv[kt][e] = xv; tmax = fmaxf(tmax, xv); }
                    tmax = fmaxf(tmax, shx(tmax, 16, lane)); tmax = fmaxf(tmax, shx(tmax, 32, lane));
                    const float mnew = fmaxf(mrun[hh], tmax), corr = __builtin_amdgcn_exp2f(mrun[hh] - mnew), muse = fmaxf(mnew, -1.0e30f); mrun[hh] = mnew;
                    float ps = 0.f;
#pragma unroll
                    for (int kt = 0; kt < 4; ++kt)
#pragma unroll
                        for (int e = 0; e < 4; ++e) { const float pe = __builtin_amdgcn_exp2f(sv[kt][e] - muse); sv[kt][e] = pe; ps += pe; }
                    lrun[hh] = lrun[hh] * corr + ps;
                    const bf16x8 pf0 = pack_frag(sv[0], sv[1]), pf1 = pack_frag(sv[2], sv[3]);
                    if (!__all(corr == 1.0f)) {
#pragma unroll
                        for (int d = 0; d < 4; ++d) oacc[hh][d] = oacc[hh][d] * corr; }
#pragma unroll
                    for (int d = 0; d < 4; ++d) { oacc[hh][d] = mma16(ld_frag_perm_l(vtL + (d * 16 + l15) * 136, s2 * 2, q), pf0, oacc[hh][d]);
                        oacc[hh][d] = mma16(ld_frag_perm_l(vtL + (d * 16 + l15) * 136, s2 * 2 + 1, q), pf1, oacc[hh][d]); }
                }
            }
        }
        if (ck + 1 < nck) DSA_STORE((ck + 1) & 1);
        __syncthreads();
    }
#undef DSA_LOAD
#undef DSA_STORE
    u32x2 grd[2][4];
#pragma unroll
    for (int hh = 0; hh < 2; ++hh)
#pragma unroll
        for (int d = 0; d < 4; ++d) grd[hh][d] = *(const u32x2*)(P + row * PW + C_CG + (hp * 2 + hh) * 64 + d * 16 + 4 * q);
    asm volatile("" ::: "memory");
#pragma unroll
    for (int hh = 0; hh < 2; ++hh) { const int h = hp * 2 + hh; float l = lrun[hh]; l += shx(l, 16, lane); l += shx(l, 32, lane); const float inv = frcp(l);
#pragma unroll
        for (int d = 0; d < 4; ++d) { const int ch = h * 64 + d * 16 + 4 * q; const u32x2 gr = grd[hh][d];
            u32x2 w; w.x = pk2(oacc[hh][d][0] * inv * fsilu(bflo(gr.x)), oacc[hh][d][1] * inv * fsilu(bfhi(gr.x))); w.y = pk2(oacc[hh][d][2] * inv * fsilu(bflo(gr.y)), oacc[hh][d][3] * inv * fsilu(bfhi(gr.y)));
            *(u32x2*)(YS + row * YW + 2 * BW + ch) = w; } }
}

__device__ __forceinline__ void dsa2g_unit(const Ctx& c, int layer, int lb, int qb) {
    PHASE_TID();
    const Params& p = *c.p; const bf16_t* P = (const bf16_t*)(p.ws + WS_P); bf16_t* YS = (bf16_t*)(p.ws + WS_YS);
    const bf16_t* DKN = (const bf16_t*)(p.ws + WS_DKN) + (size_t)lb * SEQ * 64; const bf16_t* DVN = (const bf16_t*)(p.ws + WS_VN) + (size_t)lb * SEQ * 64;
    const unsigned short* SEL = (const unsigned short*)(p.ws + WS_MASK) + (size_t)lb * SEQ * 256;
    const float* qg = p.in[12] + layer * 64;
    LAS unsigned short* selW = (LAS unsigned short*)(c.lds + wave * 9216);
    LAS float* PL = (LAS float*)(c.lds + wave * 9216 + 512);
    LAS float* lL = (LAS float*)(c.lds + wave * 9216 + 512 + 8192);
    const int q = lane >> 4, l15 = lane & 15; const bool hv = l15 < 8;
    const float sl2 = hv ? exp2f(-(float)(l15 + 1)) * 1.4426950408889634f : 0.f;
    __syncthreads();
    u32x2 selnext = *(const u32x2*)(SEL + (size_t)(QSPLIT + qb * 64 + wave * 8) * 256 + lane * 4);
#pragma unroll 1
    for (int k = 0; k < 8; ++k) {
        const int t = QSPLIT + qb * 64 + wave * 8 + k; const size_t row = (size_t)(lb * SEQ + t);
        *(LAS u32x2*)(selW + lane * 4) = selnext;
        if (k < 7) selnext = *(const u32x2*)(SEL + (size_t)(t + 1) * 256 + lane * 4);
        u32x4 gr4[2];
#pragma unroll
        for (int tp = 0; tp < 2; ++tp) gr4[tp] = hv ? *(const u32x4*)(P + row * PW + C_CG + l15 * 64 + tp * 32 + 8 * q) : (u32x4){0u, 0u, 0u, 0u};
        bf16x8 qf[2];
        { float x[2][8]; float ss = 0.f;
#pragma unroll
          for (int ks = 0; ks < 2; ++ks) { u32x4 r = (u32x4){0u, 0u, 0u, 0u};
              if (hv) r = *(const u32x4*)(P + row * PW + C_CQ + l15 * 64 + 32 * ks + 8 * q);
              x[ks][0] = bflo(r.x); x[ks][1] = bfhi(r.x); x[ks][2] = bflo(r.y); x[ks][3] = bfhi(r.y); x[ks][4] = bflo(r.z); x[ks][5] = bfhi(r.z); x[ks][6] = bflo(r.w); x[ks][7] = bfhi(r.w);
#pragma unroll
              for (int j = 0; j < 8; ++j) ss += x[ks][j] * x[ks][j]; }
          ss += shx(ss, 16, lane); ss += shx(ss, 32, lane);
          const float rs = rsqrtf(ss * (1.f / 64.f) + 1e-6f) * (0.125f * 1.4426950408889634f);
#pragma unroll
          for (int ks = 0; ks < 2; ++ks) { const float* gp = qg + 32 * ks + 8 * q; u32x4 w;
              w.x = pk2m(x[ks][0] * rs * gp[0], x[ks][1] * rs * gp[1]); w.y = pk2m(x[ks][2] * rs * gp[2], x[ks][3] * rs * gp[3]);
              w.z = pk2m(x[ks][4] * rs * gp[4], x[ks][5] * rs * gp[5]); w.w = pk2m(x[ks][6] * rs * gp[6], x[ks][7] * rs * gp[7]);
              qf[ks] = __builtin_bit_cast(bf16x8, w); } }
        f32x4 s[16];
#pragma unroll
        for (int kg = 0; kg < 16; kg += 8) {
            bf16x8 ka[8][2];
#pragma unroll
            for (int j = 0; j < 8; ++j) { const int idx = selW[(kg + j) * 16 + l15]; const bf16_t* krow = DKN + (size_t)idx * 64; ka[j][0] = ld_frag_g(krow, 0, q); ka[j][1] = ld_frag_g(krow, 1, q); }
            asm volatile("" ::: "memory");
#pragma unroll
            for (int j = 0; j < 8; ++j) { s[kg + j] = mma16(ka[j][0], qf[0], (f32x4){0.f, 0.f, 0.f, 0.f}); s[kg + j] = mma16(ka[j][1], qf[1], s[kg + j]); } }
        float mx = -3.0e38f;
#pragma unroll
        for (int kt = 0; kt < 16; ++kt) { const u32x2 iv = *(const LAS u32x2*)(selW + kt * 16 + 4 * q);
            const int i0 = (int)(iv.x & 0xffffu), i1 = (int)(iv.x >> 16), i2 = (int)(iv.y & 0xffffu), i3 = (int)(iv.y >> 16);
            s[kt][0] += sl2 * (float)(i0 - t); s[kt][1] += sl2 * (float)(i1 - t); s[kt][2] += sl2 * (float)(i2 - t); s[kt][3] += sl2 * (float)(i3 - t);
            mx = fmaxf(fmaxf(fmaxf(s[kt][0], s[kt][1]), fmaxf(s[kt][2], s[kt][3])), mx); }
        mx = fmaxf(mx, shx(mx, 16, lane)); mx = fmaxf(mx, shx(mx, 32, lane));
        float sum = 0.f;
#pragma unroll
        for (int kt = 0; kt < 16; ++kt)
#pragma unroll
            for (int i = 0; i < 4; ++i) { const float e = __builtin_amdgcn_exp2f(s[kt][i] - mx); s[kt][i] = e; sum += e; }
        sum += shx(sum, 16, lane); sum += shx(sum, 32, lane);
        f32x4 oA[2], oB[2];
#pragma unroll
        for (int tp = 0; tp < 2; ++tp) { oA[tp] = (f32x4){0.f, 0.f, 0.f, 0.f}; oB[tp] = (f32x4){0.f, 0.f, 0.f, 0.f}; }
        const bf16_t* vcol = DVN + 2 * l15;
#pragma unroll 1
        for (int kh = 0; kh < 8; kh += 4) {
            unsigned vr[4][2][8];
#pragma unroll
            for (int k4 = 0; k4 < 4; ++k4) { const int ks = kh + k4;
                const u32x2 ia = *(const LAS u32x2*)(selW + 32 * ks + 4 * q), ib = *(const LAS u32x2*)(selW + 32 * ks + 16 + 4 * q);
                const int id[8] = {(int)(ia.x & 0xffffu), (int)(ia.x >> 16), (int)(ia.y & 0xffffu), (int)(ia.y >> 16), (int)(ib.x & 0xffffu), (int)(ib.x >> 16), (int)(ib.y & 0xffffu), (int)(ib.y >> 16)};
#pragma unroll
                for (int j = 0; j < 8; ++j)
#pragma unroll
                    for (int tp = 0; tp < 2; ++tp) vr[k4][tp][j] = *(const unsigned*)(vcol + (size_t)id[j] * 64 + tp * 32); }
            asm volatile("" ::: "memory");
#pragma unroll
            for (int k4 = 0; k4 < 4; ++k4) { const int ks = kh + k4;
                f32x4 p0, p1;
                switch (ks) { case 0: p0 = s[0]; p1 = s[1]; break; case 1: p0 = s[2]; p1 = s[3]; break; case 2: p0 = s[4]; p1 = s[5]; break; case 3: p0 = s[6]; p1 = s[7]; break;
                              case 4: p0 = s[8]; p1 = s[9]; break; case 5: p0 = s[10]; p1 = s[11]; break; case 6: p0 = s[12]; p1 = s[13]; break; default: p0 = s[14]; p1 = s[15]; break; }
                const bf16x8 pf = pack_frag(p0, p1);
#pragma unroll
                for (int tp = 0; tp < 2; ++tp) { u32x4 wa, wb;
                    wa.x = (vr[k4][tp][0] & 0xffffu) | (vr[k4][tp][1] << 16); wa.y = (vr[k4][tp][2] & 0xffffu) | (vr[k4][tp][3] << 16);
                    wa.z = (vr[k4][tp][4] & 0xffffu) | (vr[k4][tp][5] << 16); wa.w = (vr[k4][tp][6] & 0xffffu) | (vr[k4][tp][7] << 16);
                    wb.x = (vr[k4][tp][0] >> 16) | (vr[k4][tp][1] & 0xffff0000u); wb.y = (vr[k4][tp][2] >> 16) | (vr[k4][tp][3] & 0xffff0000u);
                    wb.z = (vr[k4][tp][4] >> 16) | (vr[k4][tp][5] & 0xffff0000u); wb.w = (vr[k4][tp][6] >> 16) | (vr[k4][tp][7] & 0xffff0000u);
                    oA[tp] = mma16(__builtin_bit_cast(bf16x8, wa), pf, oA[tp]); oB[tp] = mma16(__builtin_bit_cast(bf16x8, wb), pf, oB[tp]); } }
        }
        if (hv) { const float inv = frcp(sum);
#pragma unroll
            for (int tp = 0; tp < 2; ++tp) { const int ch = l15 * 64 + tp * 32 + 8 * q; const u32x4 gr = gr4[tp];
                u32x4 w;
                w.x = pk2(oA[tp][0] * inv * fsilu(bflo(gr.x)), oB[tp][0] * inv * fsilu(bfhi(gr.x))); w.y = pk2(oA[tp][1] * inv * fsilu(bflo(gr.y)), oB[tp][1] * inv * fsilu(bfhi(gr.y)));
                w.z = pk2(oA[tp][2] * inv * fsilu(bflo(gr.z)), oB[tp][2] * inv * fsilu(bfhi(gr.z))); w.w = pk2(oA[tp][3] * inv * fsilu(bflo(gr.w)), oB[tp][3] * inv * fsilu(bfhi(gr.w)));
                *(u32x4*)(YS + row * YW + 2 * BW + ch) = w; } }
    }
}

constexpr size_t CTL_QUEUE = 32768;
__device__ __forceinline__ int next_unit(const Ctx& c, int layer, int grp, int stage, int tid) {
    LAS int* slot = (LAS int*)(c.lds + LDS_MISC + 64);
    __syncthreads();
    if (tid == 0) { unsigned* ctr = (unsigned*)(c.p->ws + WS_CTL + CTL_QUEUE) + (size_t)(((layer * NGRP + grp) * 8 + stage) * 64);
        *slot = (int)__hip_atomic_fetch_add(ctr, 1u, __ATOMIC_RELAXED, __HIP_MEMORY_SCOPE_AGENT); }
    __syncthreads();
    return *slot;
}
#define QUEUE_LOOP(stage_, total_) for (int u = next_unit(c, layer, grp, stage_, tid); u < (total_); u = next_unit(c, layer, grp, stage_, tid))
__device__ __forceinline__ void phase_s1(const Ctx& c, int layer, int grp, int rep = 0) {
    PHASE_TID();
    QUEUE_LOOP(0 + 4 * rep, 1536) {
        if (u < 1024) { gdn_pre_unit(c, layer, u >> 8, (u >> 2) & 63, u & 3);
#ifdef REP_U_GDNPRE
            gdn_pre_unit(c, layer, u >> 8, (u >> 2) & 63, u & 3);
#endif
            }
        else if (u < 1280) { const int v = u - 1024; { ssd1_unit(c, layer, v >> 6, (v >> 1) & 31, v & 1);
#ifdef REP_U_SSD1
            ssd1_unit(c, layer, v >> 6, (v >> 1) & 31, v & 1);
#endif
            } }
        else { const int v = u - 1280; { dsa_prep_unit(c, layer, v >> 6, v & 63);
#ifdef REP_U_PREP
            dsa_prep_unit(c, layer, v >> 6, v & 63);
#endif
            } }
    }
}
__device__ __forceinline__ void phase_s2(const Ctx& c, int layer, int grp, int rep = 0) {
    PHASE_TID();
    QUEUE_LOOP(1 + 4 * rep, 32 + 1280) {
        if (u < 32) { gdn_chain(c, layer, u >> 3, (u >> 1) & 3, u & 1);
#ifdef REP_U_CHAIN
            gdn_chain(c, layer, u >> 3, (u >> 1) & 3, u & 1);
#endif
            }
        else { const int v = u - 32;
            if (v < 128) sg_unit(c, layer, v >> 5, v & 31);
            else if (v < 256) { const int w = v - 128; mem_unit(c, layer, grp, w >> 5, (w >> 3) & 3, w & 7);
#ifdef REP_U_MEM
                mem_unit(c, layer, grp, w >> 5, (w >> 3) & 3, w & 7);
#endif
            }
            else { const int w = v - 256; dsa1_unit(c, layer, w & 3, 255 - (w >> 2));
#ifdef REP_U_DSA1
                dsa1_unit(c, layer, w & 3, 255 - (w >> 2));
#endif
            } }
    }
    ssd_scan(c);
}
__device__ __forceinline__ void phase_s3a(const Ctx& c, int layer, int grp, int rep = 0) {
    PHASE_TID();
    constexpr int NGU = (SEQ - QSPLIT) / 64 * GB, NDT = QSPLIT / 32 * GB;
    QUEUE_LOOP(2 + 4 * rep, 128 + NGU + NDT) {
        if (u < 128) ssd3_unit(c, layer, u >> 5, u & 31);
        else if (u < 128 + NGU) { const int v = u - 128; dsa2g_unit(c, layer, v & 3, v >> 2); }
        else { const int v = u - 128 - NGU; dsa2_tile(c, layer, v & 3, QSPLIT / 32 - 1 - (v >> 2)); }
    }
}
__device__ __forceinline__ void phase_s3(const Ctx& c, int layer, int grp) { phase_s3a(c, layer, grp); gdn_post(c, layer);
#ifndef NO_H8
    h8_rows(c);
#endif
}

__global__ void __launch_bounds__(512, 2) hybrid_fwd(Params prm) {
    extern __shared__ __attribute__((aligned(16))) unsigned char lds_raw[];
    Ctx c;
    c.lds = (ldsp_t)lds_raw; c.bid = blockIdx.x; c.wv = __builtin_amdgcn_readfirstlane((int)threadIdx.x >> 6); c.p = &prm;
    for (int u = threadIdx.x; u < (LDS_BYTES - LDS_MISC) / 4; u += 512) ((LAS unsigned*)(c.lds + LDS_MISC))[u] = 0u;
    __syncthreads();
    XcdBarrier bar = xcd_barrier_post((unsigned*)(prm.ws + WS_CTL), (volatile LAS unsigned*)(c.lds + LDS_MISC));
    unsigned char* ws = prm.ws;
    bf16_t* H = (bf16_t*)(ws + WS_H); bf16_t* P = (bf16_t*)(ws + WS_P); bf16_t* YS = (bf16_t*)(ws + WS_YS);
    bf16_t* GS = (bf16_t*)(ws + WS_P);
    bf16_t* MG = (bf16_t*)(ws + WS_GDN);

    for (int layer = 0; layer < DEPTH; ++layer) {
        phase_convert(c, layer);
#ifdef REP_CONV
        xcd_barrier(bar);
        phase_convert(c, layer);
#endif
        if (layer == 0) phase_norm(c, prm.in[0]);
        xcd_barrier(bar);
        for (int grp = 0; grp < NGRP; ++grp) {
            const float* xin = (layer == 0 ? prm.in[0] : (const float*)prm.out) + (size_t)grp * TG * DM;
            float* xout = prm.out + (size_t)grp * TG * DM;
#ifdef REP_NORM
            phase_norm(c, xin);
            xcd_barrier(bar);
#endif
#ifdef REP_BAR
            xcd_barrier(bar); xcd_barrier(bar); xcd_barrier(bar); xcd_barrier(bar);
#endif
#ifdef REP_TEST
            {
                pg8::Gemm g{H, (const bf16_t*)(ws + WS_WIN), TG, 3072, DM, DM, DM, 0, 0}; pg8::StaticOrder S; S.init(TG, 3072, c.G, c.bid);
                EpiStoreBf16<0> E{P, PW, prm.one};
                pg8::gemm_phase<EpiStoreBf16<0>, pg8::StaticOrder>(c.lds, g, S, E, nullptr, c.wv);
            }
            xcd_barrier(bar);
#endif
#if !defined(NO_P1)
#ifdef REP_G1
            for (int rep_ = 0; rep_ < 2; ++rep_)
#endif
            {
                pg8::Gemm g{H, (const bf16_t*)(ws + WS_WIN), TG, PW, DM, DM, DM, 0, 0}; pg8::StaticOrder S; S.init(TG, PW, c.G, c.bid);
                EpiStoreBf16<0> E{P, PW, prm.one};
                pg8::gemm_phase<EpiStoreBf16<0>, pg8::StaticOrder>(c.lds, g, S, E, nullptr, c.wv);
                if (grp == 0) {
                    __syncthreads();
                    pg8::Gemm g2{(const bf16_t*)(ws + WS_MEMN), (const bf16_t*)(ws + WS_WKV), BATCH * MEMLEN, DM, DM, DM, DM, 0, 0}; pg8::StaticOrder S2; S2.init(BATCH * MEMLEN, DM, c.G, (c.bid + 64) & 255);
                    EpiStoreBf16<0> E2{(bf16_t*)(ws + WS_KV), DM, prm.one};
                    pg8::gemm_phase<EpiStoreBf16<0>, pg8::StaticOrder>(c.lds, g2, S2, E2, nullptr, c.wv);
                }
            }
#endif
            xcd_barrier(bar);
            phase_s1(c, layer, grp);
            xcd_barrier(bar);
#ifdef REP_S1
            phase_s1(c, layer, grp, 1);
            xcd_barrier(bar);
#endif
            phase_s2(c, layer, grp);
            xcd_barrier(bar);
#ifdef REP_S2
            phase_s2(c, layer, grp, 1);
            xcd_barrier(bar);
#endif
#ifdef REP_S3
            phase_s3a(c, layer, grp, 1);
            xcd_barrier(bar);
#endif
            phase_s3(c, layer, grp);
            xcd_barrier(bar);
            {
                const int tile = (c.bid & 7) * (c.G / 8) + (c.bid >> 3), pm = tile >> 2, pn = tile & 3;
                EpiGateTile EG{}; EpiMergeTile EY{MG, (const float*)(ws + WS_SMALL) + SM_SSD_RS};
                pg8::gemm_gate_merge<EpiGateTile, EpiMergeTile>(c.lds, (const bf16_t*)(ws + WS_P)  , (const bf16_t*)(ws + WS_WG)  , YS, (const bf16_t*)(ws + WS_WB), pm, pn, EG, EY, c.wv);
#ifdef REP_GY
                __syncthreads();
                pg8::gemm_gate_merge<EpiGateTile, EpiMergeTile>(c.lds, (const bf16_t*)(ws + WS_P)  , (const bf16_t*)(ws + WS_WG)  , YS, (const bf16_t*)(ws + WS_WB), pm, pn, EG, EY, c.wv);
#endif
            }
            xcd_barrier(bar);
#if !defined(NO_P4)
            {
                pg8::Gemm g{MG, (const bf16_t*)(ws + WS_WO), TG, DM, DM, DM, DM, 0, 0}; pg8::StaticOrder S; S.init(TG, DM, c.G, c.bid);
                EpiResid E{xin, xout};
                pg8::gemm_phase<EpiResid, pg8::StaticOrder>(c.lds, g, S, E, nullptr, c.wv);
            }
#endif
            {
                const int nl = grp + 1 < NGRP ? layer : layer + 1, ng = grp + 1 < NGRP ? grp + 1 : 0;
                if (nl < DEPTH) phase_norm(c, (nl == 0 ? prm.in[0] : (const float*)prm.out) + (size_t)ng * TG * DM);
            }
            xcd_barrier(bar);
        }
    }
}
}

extern "C" void kernel_launch(void* const* d_in, const int* in_sizes, int n_in, void* d_out, int out_size, void* d_ws, size_t ws_size, hipStream_t stream) {
    static int grid = 0;
    if (grid == 0) {
        if (n_in != 27 || ws_size < hk::WS_END) { fprintf(stderr, "kernel_launch: expected 27 inputs and >= %zu bytes of workspace, got %d / %zu\n", (size_t)hk::WS_END, n_in, ws_size); grid = -1; return; }
        int dev = 0, cus = 0, per_cu = 0;
        if (hipGetDevice(&dev) != hipSuccess || hipDeviceGetAttribute(&cus, hipDeviceAttributeMultiprocessorCount, dev) != hipSuccess) { grid = -1; return; }
        if (hipFuncSetAttribute((const void*)hk::hybrid_fwd, hipFuncAttributeMaxDynamicSharedMemorySize, hk::LDS_BYTES) != hipSuccess) { fprintf(stderr, "kernel_launch: hipFuncSetAttribute failed\n"); grid = -1; return; }
        if (hipOccupancyMaxActiveBlocksPerMultiprocessor(&per_cu, (const void*)hk::hybrid_fwd, 512, hk::LDS_BYTES) != hipSuccess || per_cu < 1)
            fprintf(stderr, "kernel_launch: occupancy query reports %d workgroups per CU\n", per_cu);
        (void)hipGetLastError();
        if (cus < hk::Ctx::G) { fprintf(stderr, "kernel_launch: built for >= %d CUs, device has %d\n", hk::Ctx::G, cus); grid = -1; return; }
        grid = hk::Ctx::G;
    }
    if (grid < 0) return;
    (void)hipMemsetAsync((char*)d_ws + hk::WS_CTL, 0, hk::CTL_BYTES, stream);
    hk::Params p{};
    for (int i = 0; i < 27; ++i) p.in[i] = (const float*)d_in[i];
    p.out = (float*)d_out; p.ws = (unsigned char*)d_ws; p.one = 1.0f; p.pad = 0;
    hipLaunchKernelGGL(hk::hybrid_fwd, dim3(grid), dim3(512), hk::LDS_BYTES, stream, p);
}
```

```cpp
#include <hip/hip_runtime.h>
#include <cstdio>
#include <cstdint>

#define XB_TMO      128
#define XB_XCNT(j)  (256  + 64 * (j))
#define XB_XSUB(j)  (1280 + 64 * (j))
#define XB_XGEN(j)  (2304 + 64 * (j))
#define XB_TOP      3328
#define XB_TOPGEN   3392
#define XCD_BAR_WORDS 3456
#define XB_SPIN_CAP (1u << 18)
#define LAS __attribute__((address_space(3)))

__device__ __forceinline__ unsigned xb_ld(unsigned* p)              { return __hip_atomic_load(p, __ATOMIC_RELAXED, __HIP_MEMORY_SCOPE_AGENT); }
__device__ __forceinline__ unsigned xb_add(unsigned* p, unsigned v) { return __hip_atomic_fetch_add(p, v, __ATOMIC_RELAXED, __HIP_MEMORY_SCOPE_AGENT); }
__device__ __forceinline__ unsigned xb_xcc_id() { return (unsigned)__builtin_amdgcn_s_getreg((3 << 11) | 20) & 0xFu; }
#define XB_SPIN(cond, bar) do { unsigned _sp = 0; while (cond) { __builtin_amdgcn_s_sleep(1); \
    if ((++_sp & 255u) == 0u) { if (xb_ld(&(bar)[XB_TMO])) break; if (_sp > XB_SPIN_CAP) { atomicAdd(&(bar)[XB_TMO], 1u); break; } } } } while (0)

struct XcdBarrier {
    unsigned* bar; unsigned x;
    volatile LAS unsigned* st;
};

__device__ __forceinline__ XcdBarrier xcd_barrier_post(unsigned* bar, volatile LAS unsigned* st) {
    XcdBarrier b; b.bar = bar; b.x = xb_xcc_id(); b.st = st;
    if (threadIdx.x == 0) (void)xb_add(&bar[XB_XCNT(b.x)], 1u);
    return b;
}
__device__ __forceinline__ void xcd_barrier_complete(unsigned* bar, unsigned x, unsigned& nloc, unsigned& nx) {
    const unsigned G = gridDim.x * gridDim.y * gridDim.z;
    unsigned sum, cnt, mine, sp = 0u;
    for (;;) {
        sum = 0u; cnt = 0u; mine = 0u;
#pragma unroll
        for (unsigned j = 0; j < 16; ++j) { const unsigned c = xb_ld(&bar[XB_XCNT(j)]); sum += c; cnt += (c > 0u) ? 1u : 0u; mine = (j == x) ? c : mine; }
        if (sum == G) break;
        __builtin_amdgcn_s_sleep(1);
        if ((++sp & 255u) == 0u) { if (xb_ld(&bar[XB_TMO])) break; if (sp > XB_SPIN_CAP) { atomicAdd(&bar[XB_TMO], 1u); break; } }
    }
    nloc = mine > 0u ? mine : 1u; nx = cnt > 0u ? cnt : 1u;
}

__device__ __forceinline__ void xcd_barrier(const XcdBarrier& b) {
    asm volatile("s_waitcnt vmcnt(0)" ::: "memory");
    __syncthreads();
    if (threadIdx.x == 0) {
        unsigned* bar = b.bar;
        __builtin_amdgcn_s_waitcnt(0);
        unsigned nloc = b.st[0], nx = b.st[1];
        if (nloc == 0u) { xcd_barrier_complete(bar, b.x, nloc, nx); b.st[0] = nloc; b.st[1] = nx; }
        const unsigned old = xb_add(&bar[XB_XSUB(b.x)], 1u);
        const unsigned gen = old / nloc;
        if (old + 1u == (gen + 1u) * nloc) {
            __builtin_amdgcn_fence(__ATOMIC_RELEASE, "agent");
            asm volatile("s_waitcnt vmcnt(0)" ::: "memory");
            const unsigned og = xb_add(&bar[XB_TOP], 1u);
            const unsigned tg = og / nx;
            if (og + 1u == (tg + 1u) * nx) xb_add(&bar[XB_TOPGEN], 1u);
            else XB_SPIN(xb_ld(&bar[XB_TOPGEN]) == tg, bar);
            __builtin_amdgcn_fence(__ATOMIC_ACQUIRE, "agent");
            xb_add(&bar[XB_XGEN(b.x)], 1u);
            asm volatile("s_waitcnt vmcnt(0)" ::: "memory");
        } else {
            XB_SPIN(xb_ld(&bar[XB_XGEN(b.x)]) == gen, bar);
            __builtin_amdgcn_fence(__ATOMIC_ACQUIRE, "agent");
            asm volatile("s_waitcnt vmcnt(0)" ::: "memory");
        }
    }
    __syncthreads();
}

namespace pg8 {
#define PG8_LAS __attribute__((address_space(3)))
typedef unsigned short bf16_t;
typedef short bf16x8 __attribute__((ext_vector_type(8)));
typedef float f32x4 __attribute__((ext_vector_type(4)));
typedef unsigned u32x4 __attribute__((ext_vector_type(4)));
typedef int i32x8 __attribute__((ext_vector_type(8)));
typedef short bf16x16 __attribute__((ext_vector_type(16)));
constexpr int BM = 256, BK = 64, HALF = 128, HTB = HALF * BK * 2  , STAGE_BYTES = 8 * HTB, NXCD = 8, WGM = 8;

__host__ __device__ __forceinline__ int lds_byte(int r, int c) { const int st = (r >> 4) * 2 + (c >> 5), rr = r & 15, cc = c & 31, ob = rr * 64 + cc * 2; return st * 1024 + (ob ^ (((ob >> 9) & 1) << 5)); }
__host__ __device__ __forceinline__ void stage_rc(int b, int& R, int& C) { const int st = b / 1024, sb = b % 1024, swz = sb ^ (((sb >> 9) & 1) << 5); R = (st >> 1) * 16 + swz / 64; C = (st & 1) * 32 + (swz % 64) / 2; }
__host__ __device__ __forceinline__ int perm32(int rho) { const int n = rho >> 4, i = rho & 15; return 8 * (i >> 2) + 4 * n + (i & 3); }

struct Unit { int pm, pn, pz; };
struct Gemm { const bf16_t* A; const bf16_t* Bt; int M, N, K, lda, ldb; size_t a_z, b_z; };

struct StaticOrder {
    int nM, nN, nwg, G, c;
    __host__ __device__ void init(int M, int N, int G_, int c_) { nM = M / BM; nN = N / BM; nwg = nM * nN; G = G_; c = c_; }
    __host__ __device__ bool next(int i, Unit& u) const {
        const long L = (long)i * G + c; if (L >= nwg) return false;
        int wgid = (int)L; { const int q = nwg / NXCD, r = nwg % NXCD, xcd = wgid % NXCD, off = wgid / NXCD; wgid = (xcd < r ? xcd * (q + 1) : r * (q + 1) + (xcd - r) * q) + off; }
        const int nig = WGM * nN, gid = wgid / nig, fm = gid * WGM, gsz = (nM - fm) < WGM ? (nM - fm) : WGM;
        u.pm = fm + ((wgid % nig) % gsz); u.pn = (wgid % nig) / gsz; u.pz = 0; return true;
    }
    __device__ __forceinline__ void a_ready(const Unit&) const {}
    __device__ __forceinline__ void done(const Unit&) const {}
};
struct CountedOrder : StaticOrder {
    const unsigned* ready; unsigned need; unsigned* tmo;
    __device__ __forceinline__ void a_ready(const Unit& u) const {
        if (threadIdx.x < 64) {
            const unsigned long long t0 = __builtin_amdgcn_s_memrealtime(); unsigned polls = 0;
            while ((unsigned)__builtin_amdgcn_readfirstlane(__hip_atomic_load(ready + 64 * u.pm, __ATOMIC_RELAXED, __HIP_MEMORY_SCOPE_AGENT)) < need) {
                if ((++polls & 255u) == 0u && __builtin_amdgcn_readfirstlane(__hip_atomic_load(tmo, __ATOMIC_RELAXED, __HIP_MEMORY_SCOPE_AGENT)) != 0u) break;
                if (__builtin_amdgcn_s_memrealtime() - t0 > 2000000ull) {
                    if (threadIdx.x == 0) { unsigned expect = 0u; __hip_atomic_compare_exchange_strong(tmo + 1, &expect, 0x600u | (unsigned)(u.pm & 0xff), __ATOMIC_RELAXED, __ATOMIC_RELAXED, __HIP_MEMORY_SCOPE_AGENT); __hip_atomic_store(tmo, 1u, __ATOMIC_RELAXED, __HIP_MEMORY_SCOPE_AGENT); }
                    break; }
                __builtin_amdgcn_s_sleep(2); }
            __builtin_amdgcn_fence(__ATOMIC_ACQUIRE, "agent");
            asm volatile("s_waitcnt vmcnt(0)" ::: "memory");
        }
#if !defined(BROKEN_HOOK_NO_BARRIER)
        asm volatile("" ::: "memory"); __builtin_amdgcn_s_barrier(); asm volatile("" ::: "memory");
#endif
    }
};

__device__ __forceinline__ unsigned cvt_pk_bf16(float lo, float hi) { unsigned r; asm volatile("v_cvt_pk_bf16_f32 %0, %1, %2" : "=v"(r) : "v"(lo), "v"(hi)); return r; }
typedef float f32x2 __attribute__((ext_vector_type(2)));
__device__ __forceinline__ f32x2 gelu_pk(f32x2 v) {
    const f32x2 av = __builtin_elementwise_abs(v), d = av * 0.2316418882f + 1.0f;
    f32x2 t; t.x = __builtin_amdgcn_rcpf(d.x); t.y = __builtin_amdgcn_rcpf(d.y);
    f32x2 q = t * 0.5307027145f + (-0.7265760135f); q = q * t + 0.7107068705f; q = q * t + (-0.142248368f); q = q * t + 0.127414796f; q = q * t;
    const f32x2 s = (v * v) * (-0.72134752044f);
    f32x2 e; e.x = __builtin_amdgcn_exp2f(s.x); e.y = __builtin_amdgcn_exp2f(s.y);
    const f32x2 m = v * (q * e), r = v - m;
    f32x2 o; o.x = v.x < 0.f ? m.x : r.x; o.y = v.y < 0.f ? m.y : r.y; return o;
}

template <class Epi, class Sched, bool STAMP = false>
__device__ __forceinline__ void gemm_phase(PG8_LAS unsigned char* lds, const Gemm g, const Sched& S, const Epi& E, unsigned long long* stamps, int wave_uniform) {
    int tid_; asm volatile("v_mbcnt_lo_u32_b32 %0, -1, 0\n\tv_mbcnt_hi_u32_b32 %0, -1, %0" : "=v"(tid_)); tid_ += wave_uniform * 64;
    const int tid = tid_, wid = __builtin_amdgcn_readfirstlane(tid >> 6), lane = tid & 63, wr = wid >> 2, wc = wid & 3, fr = lane & 15, fq = lane >> 4;
    const int K = g.K, nt = K / BK;
    int ts_lo = 0, ts_hi = 0, nts = 0; const unsigned long long rt_entry = STAMP ? (unsigned long long)wall_clock64() : 0ull;
#define PG8_STAMP() do { if (STAMP && wid == 0 && nts < 64) { const unsigned long long _c = (unsigned long long)clock64(); \
        ts_lo = (lane == nts) ? (int)(unsigned)_c : ts_lo; ts_hi = (lane == nts) ? (int)(unsigned)(_c >> 32) : ts_hi; ++nts; } } while (0)
    PG8_STAMP();
    unsigned voffA[2], voffB[2];
#pragma unroll
    for (int i = 0; i < 2; ++i) { int R, C; stage_rc(tid * 16 + i * 8192, R, C); const int Rb = Epi::PERM ? ((R & ~31) + perm32(R & 31)) : R;
        voffA[i] = (unsigned)(R * g.lda + C) * 2u; voffB[i] = (unsigned)(Rb * g.ldb + C) * 2u; }
    const size_t kstep = (size_t)(BK * 2);
    const size_t hstepA = (size_t)HALF * g.lda * 2, hstepB = (size_t)HALF * g.ldb * 2;
    const size_t tstepA = 2 * hstepA, tstepB = 2 * hstepB;
    const unsigned ldsw = (unsigned)wid * 1024u;
    const int aoff = lds_byte(wr * 64 + fr, fq * 8), boff = lds_byte(wc * 32 + fr, fq * 8);
#define PG8_SA(b, h) (((b) * 2 + (h)) * HTB)
#define PG8_SB(b, h) ((4 + (b) * 2 + (h)) * HTB)
#define PG8_STAGE(bufoff, gbase, voff) do { const char* gb_ = (const char*)(gbase); asm volatile("" : "+s"(gb_));     \
        _Pragma("unroll") for (int _i = 0; _i < 2; ++_i) \
        __builtin_amdgcn_global_load_lds((const unsigned*)(gb_ + (voff)[_i]), (PG8_LAS unsigned*)(lds + (bufoff) + ldsw + _i * 8192), 16, 0, 0); } while (0)
#define PG8_LDA(dst, b, h) do { _Pragma("unroll") for (int m = 0; m < 4; ++m) _Pragma("unroll") for (int k = 0; k < 2; ++k) dst[m][k] = *(const PG8_LAS bf16x8*)(lds + PG8_SA(b, h) + aoff + m * 2048 + k * 1024); } while (0)
#define PG8_LDB(dst, b, h) do { _Pragma("unroll") for (int n = 0; n < 2; ++n) _Pragma("unroll") for (int k = 0; k < 2; ++k) dst[n][k] = *(const PG8_LAS bf16x8*)(lds + PG8_SB(b, h) + boff + n * 2048 + k * 1024); } while (0)
#define PG8_MMA(ai, bj, At, Bt) do { __builtin_amdgcn_s_setprio(1); _Pragma("unroll") for (int m = 0; m < 4; ++m) _Pragma("unroll") for (int n = 0; n < 2; ++n) _Pragma("unroll") for (int k = 0; k < 2; ++k) \
        acc[ai][bj][m][n] = __builtin_amdgcn_mfma_f32_16x16x32_bf16(Bt[n][k], At[m][k], acc[ai][bj][m][n], 0, 0, 0); __builtin_amdgcn_s_setprio(0); } while (0)
#define PG8_WAIT_V(n) asm volatile("s_waitcnt vmcnt(" #n ")" ::: "memory")
#define PG8_WAIT_L(n) asm volatile("s_waitcnt lgkmcnt(" #n ")" ::: "memory")
#define PG8_BAR __builtin_amdgcn_s_barrier()
#define PG8_SCHED __builtin_amdgcn_sched_barrier(0)
    Unit cur, nxt; int ui = 0;
    if (!S.next(0, cur)) return;
    f32x4 acc[2][2][4][2];
#pragma unroll
    for (int a = 0; a < 2; ++a)
#pragma unroll
        for (int b = 0; b < 2; ++b)
#pragma unroll
            for (int m = 0; m < 4; ++m)
#pragma unroll
                for (int n = 0; n < 2; ++n) acc[a][b][m][n] = (f32x4){0.f, 0.f, 0.f, 0.f};
    bf16x8 At[4][2], B0[2][2], B1[2][2];
    const char* cA = (const char*)g.A + (size_t)cur.pm * tstepA + (size_t)cur.pz * g.a_z * 2; const char* cB = (const char*)g.Bt + (size_t)cur.pn * tstepB + (size_t)cur.pz * g.b_z * 2;
    S.a_ready(cur);
    PG8_STAGE(PG8_SB(0, 0), cB, voffB); PG8_STAGE(PG8_SA(0, 0), cA, voffA); PG8_STAGE(PG8_SB(0, 1), cB + hstepB, voffB); PG8_STAGE(PG8_SA(0, 1), cA + hstepA, voffA);
    if (wr == 1) PG8_BAR;
    PG8_WAIT_V(4); PG8_BAR;
    PG8_STAGE(PG8_SB(1, 0), cB + kstep, voffB); PG8_STAGE(PG8_SA(1, 0), cA + kstep, voffA); PG8_STAGE(PG8_SB(1, 1), cB + hstepB + kstep, voffB);
    PG8_WAIT_V(6); PG8_BAR;
    PG8_STAMP();
    for (;;) {
        const bool has_next = S.next(ui + 1, nxt);
        const char* nA = has_next ? (const char*)g.A + (size_t)nxt.pm * tstepA + (size_t)nxt.pz * g.a_z * 2 : cA; const char* nB = has_next ? (const char*)g.Bt + (size_t)nxt.pn * tstepB + (size_t)nxt.pz * g.b_z * 2 : cB;
        for (int t = 0; t < nt; t += 2) {
            asm volatile("" : "+v"(voffA[0]), "+v"(voffA[1]), "+v"(voffB[0]), "+v"(voffB[1]));
            const bool last = (t == nt - 2);
            const char* a1 = cA + (size_t)(t + 1) * kstep;
            const char* a2 = last ? nA : cA + (size_t)(t + 2) * kstep; const char* b2 = last ? nB : cB + (size_t)(t + 2) * kstep;
            const char* a3 = a2 + kstep; const char* b3 = b2 + kstep;
            if (last && has_next) S.a_ready(nxt);
            PG8_LDB(B0, 0, 0); PG8_SCHED; PG8_LDA(At, 0, 0); PG8_STAGE(PG8_SA(1, 1), a1 + hstepA, voffA);
            PG8_WAIT_L(8); PG8_BAR; PG8_WAIT_L(0); PG8_MMA(0, 0, At, B0); PG8_BAR; PG8_SCHED;
            PG8_LDB(B1, 0, 1); PG8_STAGE(PG8_SB(0, 0), b2, voffB);
            PG8_BAR; PG8_WAIT_L(0); PG8_MMA(0, 1, At, B1); PG8_BAR;
            PG8_LDA(At, 0, 1); PG8_STAGE(PG8_SA(0, 0), a2, voffA);
            PG8_BAR; PG8_WAIT_L(0); PG8_MMA(1, 0, At, B0); PG8_BAR; PG8_SCHED;
            PG8_STAGE(PG8_SB(0, 1), b2 + hstepB, voffB);
            PG8_WAIT_V(6); PG8_BAR; PG8_MMA(1, 1, At, B1); PG8_BAR;
            PG8_LDB(B0, 1, 0); PG8_SCHED; PG8_LDA(At, 1, 0); PG8_STAGE(PG8_SA(0, 1), a2 + hstepA, voffA);
            PG8_WAIT_L(8); PG8_BAR; PG8_WAIT_L(0); PG8_MMA(0, 0, At, B0); PG8_BAR; PG8_SCHED;
            PG8_LDB(B1, 1, 1); PG8_STAGE(PG8_SB(1, 0), b3, voffB);
            PG8_BAR; PG8_WAIT_L(0); PG8_MMA(0, 1, At, B1); PG8_BAR;
            PG8_LDA(At, 1, 1); PG8_STAGE(PG8_SA(1, 0), a3, voffA);
            PG8_BAR; PG8_WAIT_L(0); PG8_MMA(1, 0, At, B0); PG8_BAR; PG8_SCHED;
            PG8_STAGE(PG8_SB(1, 1), b3 + hstepB, voffB);
            PG8_WAIT_V(6); PG8_BAR; PG8_MMA(1, 1, At, B1); PG8_BAR;
        }
        PG8_STAMP();
        if constexpr (!Epi::AFTER_DRAIN) { E(acc, cur, wr, wc, fr, fq); S.done(cur); }
        PG8_STAMP();
        if (!has_next) break;
#pragma unroll
        for (int a = 0; a < 2; ++a)
#pragma unroll
            for (int b = 0; b < 2; ++b)
#pragma unroll
                for (int m = 0; m < 4; ++m)
#pragma unroll
                    for (int n = 0; n < 2; ++n) acc[a][b][m][n] = (f32x4){0.f, 0.f, 0.f, 0.f};
        cur = nxt; cA = nA; cB = nB; ++ui;
    }
    PG8_WAIT_V(0);
    if (wr == 0) PG8_BAR;
    PG8_BAR;
    if constexpr (Epi::AFTER_DRAIN) { E.fused(acc, cur, wr, wc, fr, fq, lds, wid, lane); S.done(cur); }
    PG8_STAMP();
    if (STAMP && wid == 0) { stamps[lane] = lane < nts ? (((unsigned long long)(unsigned)ts_hi << 32) | (unsigned)ts_lo) : 0ull;
        if (lane == 62) stamps[62] = rt_entry; if (lane == 63) stamps[63] = (unsigned long long)wall_clock64(); }
#undef PG8_STAMP
#undef PG8_SA
#undef PG8_SB
#undef PG8_STAGE
#undef PG8_LDA
#undef PG8_LDB
#undef PG8_MMA
#undef PG8_WAIT_V
#undef PG8_WAIT_L
#undef PG8_BAR
#undef PG8_SCHED
}
#define PG8_KLOOPX(NT_, VA_C, VB_C, HSA_C, HSB_C, VA_N, VB_N, HSA_N, HSB_N, LDA_, LDB_, MMA_) \
        for (int t = 0; t < NT_; t += 2) { \
            asm volatile("" : "+v"(VA_C), "+v"(VB_C), "+v"(VA_N), "+v"(VB_N));        \
            const bool last = (t == NT_ - 2); \
            const size_t hA2 = last ? HSA_N : HSA_C, hB2 = last ? HSB_N : HSB_C; \
            const unsigned vA2 = last ? VA_N : VA_C, vB2 = last ? VB_N : VB_C; \
            const char* a1 = cA + (size_t)(t + 1) * kstep; \
            const char* a2 = last ? nA : cA + (size_t)(t + 2) * kstep; const char* b2 = last ? nB : cB + (size_t)(t + 2) * kstep; \
            const char* a3 = a2 + kstep; const char* b3 = b2 + kstep; \
            LDB_(B0, 0, 0); PG8_SCHED; LDA_(At, 0, 0); PG8_STAGE(PG8_SA(1, 1), a1 + HSA_C, VA_C, HSA_C); \
            PG8_WAIT_L(8); PG8_BAR; PG8_WAIT_L(0); MMA_(0, 0, At, B0); PG8_BAR; PG8_SCHED; \
            LDB_(B1, 0, 1); PG8_STAGE(PG8_SB(0, 0), b2, vB2, hB2); \
            PG8_BAR; PG8_WAIT_L(0); MMA_(0, 1, At, B1); PG8_BAR; \
            LDA_(At, 0, 1); PG8_STAGE(PG8_SA(0, 0), a2, vA2, hA2); \
            PG8_BAR; PG8_WAIT_L(0); MMA_(1, 0, At, B0); PG8_BAR; PG8_SCHED; \
            PG8_STAGE(PG8_SB(0, 1), b2 + hB2, vB2, hB2); \
            PG8_WAIT_V(6); PG8_BAR; MMA_(1, 1, At, B1); PG8_BAR; \
            LDB_(B0, 1, 0); PG8_SCHED; LDA_(At, 1, 0); PG8_STAGE(PG8_SA(0, 1), a2 + hA2, vA2, hA2); \
            PG8_WAIT_L(8); PG8_BAR; PG8_WAIT_L(0); MMA_(0, 0, At, B0); PG8_BAR; PG8_SCHED; \
            LDB_(B1, 1, 1); PG8_STAGE(PG8_SB(1, 0), b3, vB2, hB2); \
            PG8_BAR; PG8_WAIT_L(0); MMA_(0, 1, At, B1); PG8_BAR; \
            LDA_(At, 1, 1); PG8_STAGE(PG8_SA(1, 0), a3, vA2, hA2); \
            PG8_BAR; PG8_WAIT_L(0); MMA_(1, 0, At, B0); PG8_BAR; PG8_SCHED; \
            PG8_STAGE(PG8_SB(1, 1), b3 + hB2, vB2, hB2); \
            PG8_WAIT_V(6); PG8_BAR; MMA_(1, 1, At, B1); PG8_BAR; \
        }

template <class EpiG, class EpiY>
__device__ __forceinline__ void gemm_gate_merge(PG8_LAS unsigned char* lds, const bf16_t* H, const bf16_t* WG, const bf16_t* YS, const bf16_t* WB, int pm, int pn, const EpiG& EG, const EpiY& EY, int wave_uniform) {
    int tid_; asm volatile("v_mbcnt_lo_u32_b32 %0, -1, 0\n\tv_mbcnt_hi_u32_b32 %0, -1, %0" : "=v"(tid_)); tid_ += wave_uniform * 64;
    const int tid = tid_, wid = __builtin_amdgcn_readfirstlane(tid >> 6), lane = tid & 63, wr = wid >> 2, wc = wid & 3, fr = lane & 15, fq = lane >> 4;
    constexpr int LDA0B = 15872, LDB0B = 1024, NT0 = 8, LDA1 = 2560, LDB1 = 512, NT1 = 8;
    unsigned voffA0, voffB0, voffA1, voffB1;
    { int R, C; stage_rc(tid * 16, R, C); const int Rb = (R & ~31) + perm32(R & 31);
        voffA0 = (unsigned)(R * LDA0B + C * 2); voffB0 = (unsigned)(Rb * LDB0B + C * 2); voffA1 = (unsigned)(R * LDA1 + C) * 2u; voffB1 = (unsigned)(Rb * LDB1 + C) * 2u; }
    const size_t kstep = (size_t)(BK * 2);
    constexpr size_t hsA0 = (size_t)HALF * LDA0B, hsB0 = (size_t)HALF * LDB0B, hsA1 = (size_t)HALF * LDA1 * 2, hsB1 = (size_t)HALF * LDB1 * 2;
    const unsigned ldsw = (unsigned)wid * 1024u;
#define PG8_SA(b, h) (((b) * 2 + (h)) * HTB)
#define PG8_SB(b, h) ((4 + (b) * 2 + (h)) * HTB)
#define PG8_STAGE(bufoff, gbase, voff, hs) do { _Pragma("unroll") for (int _i = 0; _i < 2; ++_i) { \
        const char* gb_ = (const char*)(gbase) + _i * ((hs) / 2); asm volatile("" : "+s"(gb_));     \
        __builtin_amdgcn_global_load_lds((const unsigned*)(gb_ + (voff)), (PG8_LAS unsigned*)(lds + (bufoff) + ldsw + _i * 8192), 16, 0, 0); } } while (0)
#define PG8_LDA(dst, b, h) do { _Pragma("unroll") for (int m = 0; m < 4; ++m) _Pragma("unroll") for (int k = 0; k < 2; ++k) dst[m][k] = *(const PG8_LAS bf16x8*)(lds + PG8_SA(b, h) + aoff + m * 2048 + k * 1024); } while (0)
#define PG8_LDA8(dst, b, h) do { _Pragma("unroll") for (int m = 0; m < 4; ++m) _Pragma("unroll") for (int k = 0; k < 2; ++k) dst[m][k] = *(const PG8_LAS bf16x8*)(lds + PG8_SA(b, h) + aoff8 + m * 2048 + k * 16); } while (0)
#define PG8_LDB8(dst, b, h) do { _Pragma("unroll") for (int n = 0; n < 2; ++n) _Pragma("unroll") for (int k = 0; k < 2; ++k) dst[n][k] = *(const PG8_LAS bf16x8*)(lds + PG8_SB(b, h) + boff8 + n * 2048 + k * 16); } while (0)
#define PG8_CAT8(x) __builtin_bit_cast(i32x8, (bf16x16){x[0][0], x[0][1], x[0][2], x[0][3], x[0][4], x[0][5], x[0][6], x[0][7], x[1][0], x[1][1], x[1][2], x[1][3], x[1][4], x[1][5], x[1][6], x[1][7]})
#define PG8_MMA8(ai, bj, At, Bt) do { __builtin_amdgcn_s_setprio(1); _Pragma("unroll") for (int m = 0; m < 4; ++m) _Pragma("unroll") for (int n = 0; n < 2; ++n) \
        acc[ai][bj][m][n] = __builtin_amdgcn_mfma_scale_f32_16x16x128_f8f6f4(PG8_CAT8(Bt[n]), PG8_CAT8(At[m]), acc[ai][bj][m][n], 0, 0, 0, 0, 0, 0  ); __builtin_amdgcn_s_setprio(0); } while (0)
#define PG8_LDB(dst, b, h) do { _Pragma("unroll") for (int n = 0; n < 2; ++n) _Pragma("unroll") for (int k = 0; k < 2; ++k) dst[n][k] = *(const PG8_LAS bf16x8*)(lds + PG8_SB(b, h) + boff + n * 2048 + k * 1024); } while (0)
#define PG8_MMA(ai, bj, At, Bt) do { __builtin_amdgcn_s_setprio(1); _Pragma("unroll") for (int m = 0; m < 4; ++m) _Pragma("unroll") for (int n = 0; n < 2; ++n) _Pragma("unroll") for (int k = 0; k < 2; ++k) \
        acc[ai][bj][m][n] = __builtin_amdgcn_mfma_f32_16x16x32_bf16(Bt[n][k], At[m][k], acc[ai][bj][m][n], 0, 0, 0); __builtin_amdgcn_s_setprio(0); } while (0)
#define PG8_WAIT_V(n) asm volatile("s_waitcnt vmcnt(" #n ")" ::: "memory")
#define PG8_WAIT_L(n) asm volatile("s_waitcnt lgkmcnt(" #n ")" ::: "memory")
#define PG8_BAR __builtin_amdgcn_s_barrier()
#define PG8_SCHED __builtin_amdgcn_sched_barrier(0)
#define PG8_ZERO_ACC() do { _Pragma("unroll") for (int a = 0; a < 2; ++a) _Pragma("unroll") for (int b = 0; b < 2; ++b) _Pragma("unroll") for (int m = 0; m < 4; ++m) _Pragma("unroll") for (int n = 0; n < 2; ++n) acc[a][b][m][n] = (f32x4){0.f, 0.f, 0.f, 0.f}; } while (0)
    f32x4 acc[2][2][4][2];
    PG8_ZERO_ACC();
    bf16x8 At[4][2], B0[2][2], B1[2][2];
    unsigned gk[32];
    const char* gA = (const char*)H + (size_t)pm * 2 * hsA0; const char* yA0 = (const char*)YS + (size_t)pm * 2 * hsA1;
    const char* gB0 = (const char*)WG + (size_t)pn * 2 * hsB0; const char* yB0 = (const char*)WB + (size_t)pn * 2 * hsB1;
    const char* cA = gA; const char* cB = gB0;
    PG8_STAGE(PG8_SB(0, 0), cB, voffB0, hsB0); PG8_STAGE(PG8_SA(0, 0), cA, voffA0, hsA0); PG8_STAGE(PG8_SB(0, 1), cB + hsB0, voffB0, hsB0); PG8_STAGE(PG8_SA(0, 1), cA + hsA0, voffA0, hsA0);
    if (wr == 1) PG8_BAR;
    PG8_WAIT_V(4); PG8_BAR;
    PG8_STAGE(PG8_SB(1, 0), cB + kstep, voffB0, hsB0); PG8_STAGE(PG8_SA(1, 0), cA + kstep, voffA0, hsA0); PG8_STAGE(PG8_SB(1, 1), cB + hsB0 + kstep, voffB0, hsB0);
    PG8_WAIT_V(6); PG8_BAR;
#pragma unroll 1
    for (int pz = 0; pz < 5; ++pz) {
        Unit cur; cur.pm = pm; cur.pn = pn; cur.pz = pz;
        {
            const char* nA = yA0 + (size_t)pz * 512 * 2; const char* nB = yB0 + (size_t)pz * 1024 * 512 * 2;
            int fr1 = fr, fq1 = fq; asm volatile("" : "+v"(fr1), "+v"(fq1));
            const int aoff8 = lds_byte(wr * 64 + fr1, fq1 * 16), boff8 = lds_byte(wc * 32 + fr1, fq1 * 16);
            PG8_KLOOPX(NT0, voffA0, voffB0, hsA0, hsB0, voffA1, voffB1, hsA1, hsB1, PG8_LDA8, PG8_LDB8, PG8_MMA8)
            EG(acc, gk);
            PG8_ZERO_ACC();
            cA = nA; cB = nB;
        }
        {
            const char* nA = gA; const char* nB = gB0 + (size_t)(pz < 4 ? pz + 1 : 0) * 1024 * 1024;
            int fr1 = fr, fq1 = fq; asm volatile("" : "+v"(fr1), "+v"(fq1));
            const int aoff = lds_byte(wr * 64 + fr1, fq1 * 8), boff = lds_byte(wc * 32 + fr1, fq1 * 8);
            PG8_KLOOPX(NT1, voffA1, voffB1, hsA1, hsB1, voffA0, voffB0, hsA0, hsB0, PG8_LDA, PG8_LDB, PG8_MMA)
            { int fr2 = fr, fq2 = fq; asm volatile("" : "+v"(fr2), "+v"(fq2)); EY(acc, gk, cur, wr, wc, fr2, fq2); }
            PG8_ZERO_ACC();
            cA = nA; cB = nB;
        }
    }
    PG8_WAIT_V(0);
    if (wr == 0) PG8_BAR;
    PG8_BAR;
#undef PG8_ZERO_ACC
#undef PG8_LDA8
#undef PG8_LDB8
#undef PG8_CAT8
#undef PG8_MMA8
#undef PG8_SA
#undef PG8_SB
#undef PG8_STAGE
#undef PG8_LDA
#undef PG8_LDB
#undef PG8_MMA
#undef PG8_WAIT_V
#undef PG8_WAIT_L
#undef PG8_BAR
#undef PG8_SCHED
}
#undef PG8_KLOOPX
}


namespace hk {
typedef pg8::bf16_t bf16_t;
typedef pg8::bf16x8 bf16x8;
typedef pg8::f32x4 f32x4;
typedef pg8::u32x4 u32x4;
typedef unsigned u32x2 __attribute__((ext_vector_type(2)));
typedef float f32x2 __attribute__((ext_vector_type(2)));
typedef __fp16 h2_t __attribute__((ext_vector_type(2)));

constexpr int BATCH = 8, SEQ = 4096, DM = 1024, DEPTH = 2, MEMLEN = 256, BW = 512;
constexpr int T_ALL = BATCH * SEQ;
constexpr int GB = 4;
constexpr int NGRP = BATCH / GB;
constexpr int TG = GB * SEQ;
constexpr int IN_COLS = 7896;
constexpr int PW = 7936;
constexpr int C_AQ = 0, C_AK = 512, C_AV = 1024, C_AG = 1536;
constexpr int C_BU = 2048, C_BV = 2560, C_BG = 3072;
constexpr int C_CQ = 3584, C_CIQ = 4096, C_CG = 4608, C_CK = 5120, C_CV = 5184, C_CIK = 5248, C_CIW = 5312, C_AA = 5320, C_AB = 5324, C_DDT = 5328;
constexpr int C_DZ = 5376, C_DX = 5888, C_DB = 6400, C_DC = 6656;
constexpr int C_MQ = 6912, C_MG = 7424;
constexpr int YW = 5 * BW;
constexpr int GW = 5 * DM;

constexpr size_t WS_CTL  = 0;
constexpr size_t CTL_BYTES = 65536;
constexpr size_t WS_WIN  = WS_CTL + CTL_BYTES;
constexpr size_t WS_WG   = WS_WIN + (size_t)PW * DM * 2;
constexpr size_t WS_WB   = WS_WG + (size_t)GW * DM * 2;
constexpr size_t WS_WO   = WS_WB + (size_t)5 * DM * BW * 2;
constexpr size_t WS_WKV  = WS_WO + (size_t)DM * DM * 2;
constexpr size_t WS_MEMN = WS_WKV + (size_t)DM * DM * 2;
constexpr size_t WS_KV   = WS_MEMN + (size_t)BATCH * MEMLEN * DM * 2;
constexpr size_t WS_H    = WS_KV + (size_t)BATCH * MEMLEN * DM * 2;
constexpr size_t WS_P    = WS_H + (size_t)TG * DM * 2;
constexpr size_t WS_YS   = WS_P + (size_t)TG * PW * 2;
constexpr size_t WS_GDN  = WS_YS + (size_t)TG * YW * 2;
constexpr size_t GDN_CH_BYTES = 73728;
constexpr size_t WS_SSD  = WS_GDN + (size_t)GB * 64 * 4 * GDN_CH_BYTES;
constexpr size_t WS_MASK = WS_SSD + (size_t)GB * 32 * 8 * 64 * 128 * 2;
constexpr size_t WS_DKN  = WS_MASK + (size_t)GB * SEQ * (SEQ / 8);
constexpr size_t WS_DVT  = WS_DKN + (size_t)GB * SEQ * 64 * 2;
constexpr size_t WS_SSDQ = WS_DVT + (size_t)GB * SEQ * 64 * 2;
constexpr size_t WS_SMALL= WS_SSDQ + (size_t)GB * 8 * 8 * 64 * 128 * 2;
constexpr size_t SMALL_BYTES = 1 << 20;
constexpr size_t WS_VN   = WS_SMALL + SMALL_BYTES;
constexpr size_t WS_IKC  = WS_VN + (size_t)GB * SEQ * 64 * 2;
constexpr size_t WS_END  = WS_IKC + (size_t)GB * SEQ * 64 * 2;
constexpr int QSPLIT = 2048;
static_assert(WS_END <= (size_t)536870912, "workspace map exceeds 512 MiB");
constexpr int SM_GDN_CD = 0;
constexpr int SM_SSD_CD = 4096;
constexpr int SM_SSD_RS = 65536;
constexpr int SM_SSD_CS = 8192;
constexpr int SM_SSD_DT = 8192 + GB * SEQ * 8;

constexpr int LDS_BYTES = 147456;
constexpr int LDS_MISC = 143360;
constexpr int LDS_WORK = 143360;

#define LAS __attribute__((address_space(3)))
typedef LAS unsigned char* ldsp_t;

struct Params {
    const float* in[27];
    float* out;
    unsigned char* ws;
    float one; int pad;
};

__device__ __forceinline__ float bf2f(unsigned v) { return __uint_as_float(v << 16); }
__device__ __forceinline__ float bflo(unsigned v) { return __uint_as_float(v << 16); }
__device__ __forceinline__ float bfhi(unsigned v) { return __uint_as_float(v & 0xffff0000u); }
typedef __bf16 bf16x2_t __attribute__((ext_vector_type(2)));
__device__ __forceinline__ unsigned pk2m(float lo, float hi) { const f32x2 v = {lo, hi}; return __builtin_bit_cast(unsigned, __builtin_convertvector(v, bf16x2_t)); }
__device__ __forceinline__ unsigned pk2(float lo, float hi) { unsigned r; asm volatile("s_nop 1\n\tv_cvt_pk_bf16_f32 %0, %1, %2" : "=v"(r) : "v"(lo), "v"(hi)); return r; }
__device__ __forceinline__ bf16_t f2bf(float x) { return (bf16_t)(pk2(x, 0.f) & 0xffffu); }
__device__ __forceinline__ bf16_t f2bfm(float x) { return (bf16_t)(pk2m(x, 0.f) & 0xffffu); }
__device__ __forceinline__ float shx(float v, int m, int lane) { return __builtin_bit_cast(float, __builtin_amdgcn_ds_bpermute((lane ^ m) << 2, __builtin_bit_cast(int, v))); }
__device__ __forceinline__ unsigned shxu(unsigned v, int m, int lane) { return (unsigned)__builtin_amdgcn_ds_bpermute((lane ^ m) << 2, (int)v); }
__device__ __forceinline__ float wave_sum(float v, int lane) {
#pragma unroll
    for (int o = 1; o < 64; o <<= 1) v += shx(v, o, lane);
    return v;
}
__device__ __forceinline__ float frcp(float x) { return __builtin_amdgcn_rcpf(x); }
__device__ __forceinline__ float fsigmoid(float x) { return frcp(1.0f + __builtin_amdgcn_exp2f(-1.4426950408889634f * x)); }
__device__ __forceinline__ float fsilu(float x) { return x * frcp(1.0f + __builtin_amdgcn_exp2f(-1.4426950408889634f * x)); }
__device__ __forceinline__ float fsoftplus(float x) { return x > 20.f ? x : log1pf(__expf(x)); }
__device__ __forceinline__ float fgelu_tanh(float x) {
    const float u = 0.7978845608028654f * (x + 0.044715f * x * x * x);
    const float e = __builtin_amdgcn_exp2f(2.8853900817779268f * u);
    const float th = 1.0f - 2.0f * frcp(e + 1.0f);
    return 0.5f * x * (1.0f + th);
}
#define LDS_WAIT() asm volatile("s_waitcnt lgkmcnt(0)" ::: "memory")
#define VM_WAIT() asm volatile("s_waitcnt vmcnt(0)" ::: "memory")

__device__ __forceinline__ f32x4 mma16(bf16x8 a, bf16x8 b, f32x4 c) { return __builtin_amdgcn_mfma_f32_16x16x32_bf16(a, b, c, 0, 0, 0); }
__device__ __forceinline__ bf16x8 pack_frag(f32x4 d0, f32x4 d1) {
    u32x4 w; w.x = pk2m(d0[0], d0[1]); w.y = pk2m(d0[2], d0[3]); w.z = pk2m(d1[0], d1[1]); w.w = pk2m(d1[2], d1[3]);
    return __builtin_bit_cast(bf16x8, w);
}
__device__ __forceinline__ bf16x8 ld_frag_perm_g(const bf16_t* row, int s, int q) {
    const u32x2 lo = *(const u32x2*)(row + 32 * s + 4 * q), hi = *(const u32x2*)(row + 32 * s + 16 + 4 * q);
    u32x4 w; w.x = lo.x; w.y = lo.y; w.z = hi.x; w.w = hi.y; return __builtin_bit_cast(bf16x8, w);
}
__device__ __forceinline__ bf16x8 ld_frag_perm_l(const LAS bf16_t* row, int s, int q) {
    const u32x2 lo = *(const LAS u32x2*)(row + 32 * s + 4 * q), hi = *(const LAS u32x2*)(row + 32 * s + 16 + 4 * q);
    u32x4 w; w.x = lo.x; w.y = lo.y; w.z = hi.x; w.w = hi.y; return __builtin_bit_cast(bf16x8, w);
}
__device__ __forceinline__ bf16x8 ld_frag_g(const bf16_t* row, int s, int q) { return *(const bf16x8*)(row + 32 * s + 8 * q); }
__device__ __forceinline__ bf16x8 ld_frag_l(const LAS bf16_t* row, int s, int q) { return *(const LAS bf16x8*)(row + 32 * s + 8 * q); }

struct Ctx {
    ldsp_t lds; int bid, wv;
    static constexpr int G = 256;
    const Params* p;
};
#define PHASE_TID() int tid_o; asm volatile("v_mbcnt_lo_u32_b32 %0, -1, 0\n\tv_mbcnt_hi_u32_b32 %0, -1, %0" : "=v"(tid_o)); tid_o += c.wv * 64;      const int tid = tid_o, lane = tid & 63, wave = __builtin_amdgcn_readfirstlane(tid >> 6); (void)lane; (void)wave

template <int ACT  , int NT = 0  > struct EpiStoreBf16 {
    static constexpr bool PERM = true, AFTER_DRAIN = false;
    bf16_t* O; int ldc; float one;
    __device__ __forceinline__ void operator()(const f32x4 (&acc)[2][2][4][2], const pg8::Unit& u, int wr, int wc, int fr, int fq) const {
        const int row0 = u.pm * 256 + wr * 64 + fr, col0 = u.pn * 256 + wc * 32 + 8 * fq;
#pragma unroll
        for (int ai = 0; ai < 2; ++ai)
#pragma unroll
            for (int m = 0; m < 4; ++m) { bf16_t* rowp = O + (size_t)(row0 + ai * 128 + m * 16) * ldc + col0;
#pragma unroll
                for (int bj = 0; bj < 2; ++bj) { f32x4 v0 = acc[ai][bj][m][0], v1 = acc[ai][bj][m][1];
                    if (ACT == 1) {
#pragma unroll
                        for (int j = 0; j < 4; ++j) { v0[j] = fsigmoid(v0[j]); v1[j] = fsigmoid(v1[j]); } }
                    u32x4 w;
                    if (ACT == 1) { v0 = v0 * one; v1 = v1 * one;
                        w.x = pk2(v0[0], v0[1]); w.y = pk2(v0[2], v0[3]); w.z = pk2(v1[0], v1[1]); w.w = pk2(v1[2], v1[3]); }
                    else { w.x = pk2m(v0[0], v0[1]); w.y = pk2m(v0[2], v0[3]); w.z = pk2m(v1[0], v1[1]); w.w = pk2m(v1[2], v1[3]); }
                    if (NT) __builtin_nontemporal_store(w, (u32x4*)(rowp + bj * 128)); else *(u32x4*)(rowp + bj * 128) = w; } }
    }
};
struct EpiMerge {
    static constexpr bool PERM = true, AFTER_DRAIN = false;
    const bf16_t* Gs; bf16_t* Mg; const float* RS;
    __device__ __forceinline__ void operator()(const f32x4 (&acc)[2][2][4][2], const pg8::Unit& u, int wr, int wc, int fr, int fq) const {
        const int row0 = u.pm * 256 + wr * 64 + fr, col0 = u.pn * 256 + wc * 32 + 8 * fq, pz = u.pz;
#pragma unroll
        for (int ai = 0; ai < 2; ++ai) {
            u32x4 g[4][2], pv[4][2]; float rs[4];
#pragma unroll
            for (int m = 0; m < 4; ++m) { const size_t row = (size_t)(row0 + ai * 128 + m * 16);
                rs[m] = RS[row];
#pragma unroll
                for (int bj = 0; bj < 2; ++bj) { g[m][bj] = *(const u32x4*)(Gs + row * GW + pz * DM + col0 + bj * 128);
                    pv[m][bj] = *(const u32x4*)(Mg + row * DM + col0 + bj * 128); } }
            asm volatile("" ::: "memory");
#pragma unroll
            for (int m = 0; m < 4; ++m) { const size_t row = (size_t)(row0 + ai * 128 + m * 16); const float rsm = pz == 3 ? rs[m] : 1.0f;
#pragma unroll
                for (int bj = 0; bj < 2; ++bj) { u32x4 p4 = pv[m][bj]; if (pz == 0) p4 = (u32x4){0u, 0u, 0u, 0u};
                    const u32x4 g4 = g[m][bj]; const f32x4 v0 = acc[ai][bj][m][0] * rsm, v1 = acc[ai][bj][m][1] * rsm;
                    u32x4 w;
                    w.x = pk2(bflo(p4.x) + bflo(g4.x) * v0[0], bfhi(p4.x) + bfhi(g4.x) * v0[1]);
                    w.y = pk2(bflo(p4.y) + bflo(g4.y) * v0[2], bfhi(p4.y) + bfhi(g4.y) * v0[3]);
                    w.z = pk2(bflo(p4.z) + bflo(g4.z) * v1[0], bfhi(p4.z) + bfhi(g4.z) * v1[1]);
                    w.w = pk2(bflo(p4.w) + bflo(g4.w) * v1[2], bfhi(p4.w) + bfhi(g4.w) * v1[3]);
                    *(u32x4*)(Mg + row * DM + col0 + bj * 128) = w; } }
            asm volatile("" ::: "memory");
        }
    }
};
struct OneUnit {
    int pm, pn, pz;
    __device__ __forceinline__ bool next(int i, pg8::Unit& u) const { if (i > 0) return false; u.pm = pm; u.pn = pn; u.pz = pz; return true; }
    __device__ __forceinline__ void a_ready(const pg8::Unit&) const {}
    __device__ __forceinline__ void done(const pg8::Unit&) const {}
};
struct EpiGateTile {
    static constexpr bool PERM = true, AFTER_DRAIN = false;
    __device__ __forceinline__ void operator()(const f32x4 (&acc)[2][2][4][2], unsigned (&gk)[32]) const {
#pragma unroll
        for (int ai = 0; ai < 2; ++ai)
#pragma unroll
            for (int bj = 0; bj < 2; ++bj)
#pragma unroll
                for (int m = 0; m < 4; ++m)
#pragma unroll
                    for (int n = 0; n < 2; ++n) { const f32x4 v = acc[ai][bj][m][n]; unsigned q[4];
#pragma unroll
                        for (int j = 0; j < 4; ++j) q[j] = (unsigned)(fsigmoid(v[j] * 0.03125f) * 255.0f + 0.5f);
                        unsigned w = q[0] | (q[1] << 8) | (q[2] << 16) | (q[3] << 24); asm volatile("" : "+v"(w));
                        gk[(ai * 2 + bj) * 8 + m * 2 + n] = w; }
    }
};
struct EpiMergeTile {
    static constexpr bool PERM = true, AFTER_DRAIN = false;
    bf16_t* Mg; const float* RS;
    __device__ __forceinline__ void operator()(const f32x4 (&acc)[2][2][4][2], const unsigned (&gk)[32], const pg8::Unit& u, int wr, int wc, int fr, int fq) const {
        const int lr0 = wr * 64 + fr, lc0 = wc * 32 + 8 * fq, row0 = u.pm * 256 + lr0, col0 = u.pn * 256 + lc0, pz = u.pz;
#pragma unroll
        for (int ai = 0; ai < 2; ++ai) {
            u32x4 pv[4][2]; float rs[4];
#pragma unroll
            for (int m = 0; m < 4; ++m) { const size_t row = (size_t)(row0 + ai * 128 + m * 16);
                rs[m] = pz == 3 ? RS[row] * (1.0f / 255.0f) : (1.0f / 255.0f);
#pragma unroll
                for (int bj = 0; bj < 2; ++bj) pv[m][bj] = pz != 0 ? *(const u32x4*)(Mg + row * DM + col0 + bj * 128) : (u32x4){0u, 0u, 0u, 0u}; }
            asm volatile("" ::: "memory");
#pragma unroll
            for (int m = 0; m < 4; ++m) { const size_t row = (size_t)(row0 + ai * 128 + m * 16); const float rsm = rs[m];
#pragma unroll
                for (int bj = 0; bj < 2; ++bj) { const u32x4 p4 = pv[m][bj];
                    const unsigned g0 = gk[(ai * 2 + bj) * 8 + m * 2], g1 = gk[(ai * 2 + bj) * 8 + m * 2 + 1]; const f32x4 v0 = acc[ai][bj][m][0] * rsm, v1 = acc[ai][bj][m][1] * rsm;
                    u32x4 w;
                    w.x = pk2(bflo(p4.x) + (float)(g0 & 255u) * v0[0], bfhi(p4.x) + (float)((g0 >> 8) & 255u) * v0[1]);
                    w.y = pk2(bflo(p4.y) + (float)((g0 >> 16) & 255u) * v0[2], bfhi(p4.y) + (float)(g0 >> 24) * v0[3]);
                    w.z = pk2(bflo(p4.z) + (float)(g1 & 255u) * v1[0], bfhi(p4.z) + (float)((g1 >> 8) & 255u) * v1[1]);
                    w.w = pk2(bflo(p4.w) + (float)((g1 >> 16) & 255u) * v1[2], bfhi(p4.w) + (float)(g1 >> 24) * v1[3]);
                    *(u32x4*)(Mg + row * DM + col0 + bj * 128) = w; } }
            asm volatile("" ::: "memory");
        }
    }
};
struct EpiResid {
    static constexpr bool PERM = false, AFTER_DRAIN = false;
    const float* xin; float* out;
    __device__ __forceinline__ void operator()(const f32x4 (&acc)[2][2][4][2], const pg8::Unit& u, int wr, int wc, int fr, int fq) const {
        const int row0 = u.pm * 256 + wr * 64 + fr, col0 = u.pn * 256 + wc * 32 + 4 * fq;
#pragma unroll
        for (int ai = 0; ai < 2; ++ai)
#pragma unroll
            for (int mh = 0; mh < 2; ++mh) {
                f32x4 xv[2][2][2];
#pragma unroll
                for (int m2 = 0; m2 < 2; ++m2) { const size_t off = (size_t)(row0 + ai * 128 + (mh * 2 + m2) * 16) * DM + col0;
#pragma unroll
                    for (int bj = 0; bj < 2; ++bj)
#pragma unroll
                        for (int n = 0; n < 2; ++n) xv[m2][bj][n] = *(const f32x4*)(xin + off + bj * 128 + n * 16); }
                asm volatile("" ::: "memory");
#pragma unroll
                for (int m2 = 0; m2 < 2; ++m2) { const int m = mh * 2 + m2; const size_t off = (size_t)(row0 + ai * 128 + m * 16) * DM + col0;
#pragma unroll
                    for (int bj = 0; bj < 2; ++bj)
#pragma unroll
                        for (int n = 0; n < 2; ++n) *(f32x4*)(out + off + bj * 128 + n * 16) = xv[m2][bj][n] + acc[ai][bj][m][n]; }
                asm volatile("" ::: "memory");
            }
    }
};
struct MergeOrder {
    int G, c, ntile;
    __device__ __forceinline__ bool next(int i, pg8::Unit& u) const { const int tile = c + (i / 5) * G; if (tile >= ntile) return false; u.pm = tile >> 2; u.pn = tile & 3; u.pz = i % 5; return true; }
    __device__ __forceinline__ void a_ready(const pg8::Unit&) const {}
    __device__ __forceinline__ void done(const pg8::Unit&) const {}
};

__device__ __forceinline__ int win_src_col(int j) {
    if (j < 1536) return j;
    if (j < 2048) return 1544 + (j - 1536);
    if (j < 3584) return j + 8;
    if (j < 4096) return 3592 + (j - 3584);
    if (j < 4608) return 4232 + (j - 4096);
    if (j < 5120) return 4816 + (j - 4608);
    if (j < 5184) return 4104 + (j - 5120);
    if (j < 5248) return 4168 + (j - 5184);
    if (j < 5312) return 4744 + (j - 5248);
    if (j < 5320) return 4808 + (j - 5312);
    if (j < 5324) return 1536 + (j - 5320);
    if (j < 5328) return 1540 + (j - 5324);
    if (j < 5336) return 6864 + (j - 5328);
    if (j < 5376) return -1;
    if (j < 5888) return 5328 + (j - 5376);
    if (j < 6912) return 5840 + (j - 5888);
    if (j < 7424) return 6872 + (j - 6912);
    return 7384 + (j - 7424);
}
template <bool REMAP, bool SCALE>
__device__ __forceinline__ void tr_item(const float* W, int ldsrc, const float* scale, bf16_t* WT, int K, int k0, int n0, LAS float* scr, int lane) {
    const int n4 = (lane & 7) * 4;
    const int sc = REMAP ? win_src_col(n0 + n4) : (n0 + n4);
    f32x4 v8[8]; float s8[8];
#pragma unroll
    for (int i = 0; i < 8; ++i) { const int kk = 8 * i + (lane >> 3);
        v8[i] = (f32x4){0.f, 0.f, 0.f, 0.f};
        if (sc >= 0) v8[i] = *(const f32x4*)(W + (size_t)(k0 + kk) * ldsrc + sc);
        s8[i] = SCALE ? scale[k0 + kk] : 1.0f; }
#pragma unroll
    for (int i = 0; i < 8; ++i) { const int kk = 8 * i + (lane >> 3); const f32x4 v = SCALE ? v8[i] * s8[i] : v8[i];
        scr[kk * 33 + n4] = v[0]; scr[kk * 33 + n4 + 1] = v[1]; scr[kk * 33 + n4 + 2] = v[2]; scr[kk * 33 + n4 + 3] = v[3]; }
    LDS_WAIT();
    const int c = lane & 7;
#pragma unroll
    for (int j = 0; j < 4; ++j) { const int nn = (lane >> 3) + 8 * j; const LAS float* s = scr + (8 * c) * 33 + nn;
        u32x4 o; o.x = pk2(s[0 * 33], s[1 * 33]); o.y = pk2(s[2 * 33], s[3 * 33]); o.z = pk2(s[4 * 33], s[5 * 33]); o.w = pk2(s[6 * 33], s[7 * 33]);
        *(u32x4*)(WT + (size_t)(n0 + nn) * K + k0 + 8 * c) = o; }
    LDS_WAIT();
}
__device__ __forceinline__ unsigned pk4_fp8(float a, float b, float c, float d) {
    a = fminf(fmaxf(a, -448.f), 448.f); b = fminf(fmaxf(b, -448.f), 448.f); c = fminf(fmaxf(c, -448.f), 448.f); d = fminf(fmaxf(d, -448.f), 448.f);
    unsigned w = 0u; w = (unsigned)__builtin_amdgcn_cvt_pk_fp8_f32(a, b, (int)w, false); w = (unsigned)__builtin_amdgcn_cvt_pk_fp8_f32(c, d, (int)w, true); return w;
}
__device__ __forceinline__ void tr_item8(const float* W, int ldsrc, const float* scale, float mul, unsigned char* WT8, int K, int k0, int n0, LAS float* scr, int lane) {
    const int n4 = (lane & 7) * 4;
    f32x4 v8[8]; float s8[8];
#pragma unroll
    for (int i = 0; i < 8; ++i) { const int kk = 8 * i + (lane >> 3); v8[i] = *(const f32x4*)(W + (size_t)(k0 + kk) * ldsrc + n0 + n4); s8[i] = scale[k0 + kk] * mul; }
#pragma unroll
    for (int i = 0; i < 8; ++i) { const int kk = 8 * i + (lane >> 3); const f32x4 v = v8[i] * s8[i];
        scr[kk * 33 + n4] = v[0]; scr[kk * 33 + n4 + 1] = v[1]; scr[kk * 33 + n4 + 2] = v[2]; scr[kk * 33 + n4 + 3] = v[3]; }
    LDS_WAIT();
    const int c = lane & 7;
#pragma unroll
    for (int j = 0; j < 4; ++j) { const int nn = (lane >> 3) + 8 * j; const LAS float* s = scr + (8 * c) * 33 + nn;
        u32x2 o; o.x = pk4_fp8(s[0 * 33], s[1 * 33], s[2 * 33], s[3 * 33]); o.y = pk4_fp8(s[4 * 33], s[5 * 33], s[6 * 33], s[7 * 33]);
        *(u32x2*)(WT8 + (size_t)(n0 + nn) * K + k0 + 8 * c) = o; }
    LDS_WAIT();
}
__device__ __forceinline__ void rms_row_to_bf16(const float* xrow, bf16_t* orow, int lane) {
    const f32x4* xr = (const f32x4*)xrow + lane;
    f32x4 v[4]; float s = 0.f;
#pragma unroll
    for (int j = 0; j < 4; ++j) { v[j] = xr[64 * j]; s += (v[j].x * v[j].x + v[j].y * v[j].y) + (v[j].z * v[j].z + v[j].w * v[j].w); }
    const float rstd = rsqrtf(wave_sum(s, lane) * (1.f / DM) + 1e-6f);
    unsigned long long* o8 = (unsigned long long*)orow + lane;
#pragma unroll
    for (int j = 0; j < 4; ++j) o8[64 * j] = (unsigned long long)pk2(v[j].x * rstd, v[j].y * rstd) | ((unsigned long long)pk2(v[j].z * rstd, v[j].w * rstd) << 32);
}
__device__ __forceinline__ void phase_convert(const Ctx& c, int layer) {
    PHASE_TID();
    const Params& p = *c.p;
    LAS float* scr = (LAS float*)(c.lds + wave * 8704);
    const int gw = c.bid * 8 + wave, NGW = c.G * 8;
    bf16_t* WIN = (bf16_t*)(p.ws + WS_WIN); bf16_t* WG = (bf16_t*)(p.ws + WS_WG); bf16_t* WB = (bf16_t*)(p.ws + WS_WB); bf16_t* WO = (bf16_t*)(p.ws + WS_WO); bf16_t* WKV = (bf16_t*)(p.ws + WS_WKV);
    const float* norm_g = p.in[2] + layer * DM;
    for (int r = gw; r < 16 * (PW / 32); r += NGW) { const int kb = r / (PW / 32), nb = r % (PW / 32);
        tr_item<true, true>(p.in[3] + (size_t)layer * DM * IN_COLS, IN_COLS, norm_g, WIN, DM, kb * 64, nb * 32, scr, lane); }
    for (int r = gw; r < 5 * 512; r += NGW) { const int pz = r / 512, q = r % 512, kb = q / 32, nb = q % 32;
#ifndef NO_TR8
        tr_item8(p.in[24] + (size_t)(layer * 5 + pz) * DM * DM, DM, norm_g, 32.0f, (unsigned char*)WG + (size_t)pz * DM * DM, DM, kb * 64, nb * 32, scr, lane); }
#else
        }
#endif
    for (int r = gw ^ 1024; r < 4 * 256; r += NGW) { const int pi = r / 256, pz = pi < 3 ? pi : 4, q = r % 256, kb = q / 32, nb = q % 32;
        tr_item<false, false>(p.in[25] + (size_t)(layer * 5 + pz) * BW * DM, DM, nullptr, WB + (size_t)pz * DM * BW, BW, kb * 64, nb * 32, scr, lane); }
    for (int r = gw ^ 512; r < 256; r += NGW) { const int kb = r / 32, nb = r % 32;
        tr_item<false, true>(p.in[25] + (size_t)(layer * 5 + 3) * BW * DM, DM, p.in[19] + layer * BW, WB + (size_t)3 * DM * BW, BW, kb * 64, nb * 32, scr, lane); }
    for (int r = gw ^ 1536; r < 512; r += NGW) { const int kb = r / 32, nb = r % 32;
        tr_item<false, false>(p.in[26] + (size_t)layer * DM * DM, DM, nullptr, WO, DM, kb * 64, nb * 32, scr, lane); }
    for (int r = gw ^ 512; r < 512; r += NGW) { const int kb = r / 32, nb = r % 32;
        tr_item<false, true>(p.in[21] + (size_t)layer * DM * DM, DM, p.in[20] + layer * DM, WKV, DM, kb * 64, nb * 32, scr, lane); }
    if (layer == 0) {
        bf16_t* MEMN = (bf16_t*)(p.ws + WS_MEMN);
        for (int r = gw; r < BATCH * MEMLEN; r += NGW) rms_row_to_bf16(p.in[1] + (size_t)r * DM, MEMN + (size_t)r * DM, lane);
    }
}
__device__ __forceinline__ void phase_norm(const Ctx& c, const float* xin  ) {
    PHASE_TID();
    bf16_t* H = (bf16_t*)(c.p->ws + WS_H);
    const int gw = c.bid * 8 + wave, NGW = c.G * 8;
    for (int r = gw; r < TG; r += NGW) rms_row_to_bf16(xin + (size_t)r * DM, H + (size_t)r * DM, lane);
}

__device__ __forceinline__ void h8_rows(const Ctx& c) {
    PHASE_TID();
    const bf16_t* H = (const bf16_t*)(c.p->ws + WS_H); unsigned char* P8 = c.p->ws + WS_P;
    for (int r = c.bid * 8 + wave; r < TG; r += c.G * 32) {
        u32x4 a[4][2];
#pragma unroll
        for (int k = 0; k < 4; ++k) { const size_t rr = (size_t)(r + k * c.G * 8); a[k][0] = *(const u32x4*)(H + rr * DM + lane * 16); a[k][1] = *(const u32x4*)(H + rr * DM + lane * 16 + 8); }
        asm volatile("" ::: "memory");
#pragma unroll
        for (int k = 0; k < 4; ++k) { const size_t rr = (size_t)(r + k * c.G * 8); const u32x4 x = a[k][0], y = a[k][1]; u32x4 o;
            o.x = pk4_fp8(bflo(x.x), bfhi(x.x), bflo(x.y), bfhi(x.y)); o.y = pk4_fp8(bflo(x.z), bfhi(x.z), bflo(x.w), bfhi(x.w));
            o.z = pk4_fp8(bflo(y.x), bfhi(y.x), bflo(y.y), bfhi(y.y)); o.w = pk4_fp8(bflo(y.z), bfhi(y.z), bflo(y.w), bfhi(y.w));
            *(u32x4*)(P8 + rr * (size_t)(PW * 2) + lane * 16) = o; }
        asm volatile("" ::: "memory");
    }
}

__device__ __forceinline__ float sg_row16_sum(float v) {
    v += __builtin_bit_cast(float, __builtin_amdgcn_mov_dpp(__builtin_bit_cast(int, v), 0xB1, 0xF, 0xF, true));
    v += __builtin_bit_cast(float, __builtin_amdgcn_mov_dpp(__builtin_bit_cast(int, v), 0x4E, 0xF, 0xF, true));
    v += __builtin_bit_cast(float, __builtin_amdgcn_mov_dpp(__builtin_bit_cast(int, v), 0x141, 0xF, 0xF, true));
    v += __builtin_bit_cast(float, __builtin_amdgcn_mov_dpp(__builtin_bit_cast(int, v), 0x140, 0xF, 0xF, true));
    return v;
}
__device__ __forceinline__ void sg_unit(const Ctx& c, int layer, int lb, int n) {
    PHASE_TID();
    const Params& p = *c.p;
    const bf16_t* P = (const bf16_t*)(p.ws + WS_P); bf16_t* YS = (bf16_t*)(p.ws + WS_YS);
    const float* ln_g = p.in[8] + layer * BW; const float* ln_b = p.in[9] + layer * BW;
    const float* w_s = p.in[10] + (size_t)layer * 4 * 128 * 128; const float* b_s = p.in[11] + layer * 4 * 128;
    LAS float* st = (LAS float*)c.lds;
    LAS bf16_t* Wl = (LAS bf16_t*)(c.lds + 1024);
    LAS bf16_t* vT = (LAS bf16_t*)(c.lds + 1024 + 34816);
    const int r0 = lb * SEQ + n * 128, q = lane >> 4, l15 = lane & 15;
    __syncthreads();
    u32x4 rawA[4][4];
#pragma unroll
    for (int ps = 0; ps < 4; ++ps) { const bf16_t* src = P + (size_t)(r0 + wave * 16 + ps * 4 + q) * PW + C_BV + l15 * 32;
#pragma unroll
        for (int j = 0; j < 4; ++j) rawA[ps][j] = *(const u32x4*)(src + 8 * j); }
    asm volatile("" ::: "memory");
#pragma unroll
    for (int ps = 0; ps < 4; ++ps) { const int t = wave * 16 + ps * 4 + q;
        u32x4 raw[4];
#pragma unroll
        for (int j = 0; j < 4; ++j) raw[j] = rawA[ps][j];
        float x[32]; float sm = 0.f;
#pragma unroll
        for (int j = 0; j < 4; ++j) { x[8 * j + 0] = bflo(raw[j].x); x[8 * j + 1] = bfhi(raw[j].x); x[8 * j + 2] = bflo(raw[j].y); x[8 * j + 3] = bfhi(raw[j].y);
            x[8 * j + 4] = bflo(raw[j].z); x[8 * j + 5] = bfhi(raw[j].z); x[8 * j + 6] = bflo(raw[j].w); x[8 * j + 7] = bfhi(raw[j].w); }
#pragma unroll
        for (int k = 0; k < 32; ++k) { x[k] = fgelu_tanh(x[k]); sm += x[k]; }
        const float mean = sg_row16_sum(sm) * (1.f / BW); float s2 = 0.f;
#pragma unroll
        for (int k = 0; k < 32; ++k) { const float d = x[k] - mean; s2 += d * d; }
        const float var = sg_row16_sum(s2) * (1.f / BW);
        if (l15 == 0) { st[t] = mean; st[128 + t] = rsqrtf(var + 1e-5f); }
    }
    for (int g = 0; g < 4; ++g) {
        __syncthreads();
        {
            const int t = tid >> 2, sb = (tid & 3) * 32; const float* src = w_s + (size_t)(g * 128 + t) * 128 + sb;
#pragma unroll
            for (int j = 0; j < 4; ++j) { const f32x4 a = *(const f32x4*)(src + 8 * j), b = *(const f32x4*)(src + 8 * j + 4); const int s0 = sb + 8 * j;
                u32x4 w; w.x = pk2(s0 + 0 <= t ? a[0] : 0.f, s0 + 1 <= t ? a[1] : 0.f); w.y = pk2(s0 + 2 <= t ? a[2] : 0.f, s0 + 3 <= t ? a[3] : 0.f);
                w.z = pk2(s0 + 4 <= t ? b[0] : 0.f, s0 + 5 <= t ? b[1] : 0.f); w.w = pk2(s0 + 6 <= t ? b[2] : 0.f, s0 + 7 <= t ? b[3] : 0.f);
                *(LAS u32x4*)(Wl + t * 136 + s0) = w; }
        }
#pragma unroll
        for (int j = 0; j < 4; ++j) { const int e = tid + 512 * j, s = e >> 4, cb = (e & 15) * 8;
            const u32x4 raw = *(const u32x4*)(P + (size_t)(r0 + s) * PW + C_BV + g * 128 + cb);
            float x[8]; x[0] = bflo(raw.x); x[1] = bfhi(raw.x); x[2] = bflo(raw.y); x[3] = bfhi(raw.y); x[4] = bflo(raw.z); x[5] = bfhi(raw.z); x[6] = bflo(raw.w); x[7] = bfhi(raw.w);
            const float mean = st[s], rstd = st[128 + s];
#pragma unroll
            for (int k = 0; k < 8; ++k) { const int ch = g * 128 + cb + k; const float y = (fgelu_tanh(x[k]) - mean) * rstd * ln_g[ch] + ln_b[ch]; vT[(cb + k) * 136 + s] = f2bf(y); } }
        __syncthreads();
        f32x4 acc[8];
#pragma unroll
        for (int ct = 0; ct < 8; ++ct) acc[ct] = (f32x4){0.f, 0.f, 0.f, 0.f};
        const int t = wave * 16 + l15; const size_t row = (size_t)(r0 + t); const float bias = b_s[g * 128 + t];
        u32x2 ur[8], gr[8];
#pragma unroll
        for (int ct = 0; ct < 8; ++ct) { const int ch = g * 128 + ct * 16 + 4 * q; ur[ct] = *(const u32x2*)(P + row * PW + C_BU + ch); gr[ct] = *(const u32x2*)(P + row * PW + C_BG + ch); }
        asm volatile("" ::: "memory");
        const int nks = (wave >> 1) + 1;
        for (int ks = 0; ks < nks; ++ks) {
            const bf16x8 bw = ld_frag_l(Wl + (wave * 16 + l15) * 136, ks, q);
#pragma unroll
            for (int ct = 0; ct < 8; ++ct) acc[ct] = mma16(ld_frag_l(vT + (ct * 16 + l15) * 136, ks, q), bw, acc[ct]);
        }
#pragma unroll
        for (int ct = 0; ct < 8; ++ct) { const int ch = g * 128 + ct * 16 + 4 * q;
            const float o0 = fgelu_tanh(bflo(ur[ct].x)) * (acc[ct][0] + bias) * fsilu(bflo(gr[ct].x)), o1 = fgelu_tanh(bfhi(ur[ct].x)) * (acc[ct][1] + bias) * fsilu(bfhi(gr[ct].x));
            const float o2 = fgelu_tanh(bflo(ur[ct].y)) * (acc[ct][2] + bias) * fsilu(bflo(gr[ct].y)), o3 = fgelu_tanh(bfhi(ur[ct].y)) * (acc[ct][3] + bias) * fsilu(bfhi(gr[ct].y));
            u32x2 w; w.x = pk2(o0, o1); w.y = pk2(o2, o3);
            *(u32x2*)(YS + row * YW + 1 * BW + ch) = w; }
        asm volatile("" ::: "memory");
    }
}

__device__ __forceinline__ void mem_unit(const Ctx& c, int layer, int grp, int lb, int head, int qc) {
    PHASE_TID();
    const Params& p = *c.p;
    const bf16_t* P = (const bf16_t*)(p.ws + WS_P); bf16_t* YS = (bf16_t*)(p.ws + WS_YS); const bf16_t* KV = (const bf16_t*)(p.ws + WS_KV);
    const float* qg = p.in[22] + layer * 128; const float* kg = p.in[23] + layer * 128;
    LAS bf16_t* Kn = (LAS bf16_t*)c.lds;
    LAS bf16_t* VT = (LAS bf16_t*)(c.lds + 69632);
    const int q = lane >> 4, l15 = lane & 15, gbatch = grp * GB + lb;
    __syncthreads();
    u32x4 kr8[8], vr8[8];
#pragma unroll
    for (int j = 0; j < 8; ++j) { const int e = tid + 512 * j, m = e >> 4, pc = e & 15; const bf16_t* src = KV + (size_t)(gbatch * MEMLEN + m) * DM + head * 128 + pc * 8;
        kr8[j] = *(const u32x4*)src; vr8[j] = *(const u32x4*)(src + BW); }
    asm volatile("" ::: "memory");
#pragma unroll
    for (int j = 0; j < 8; ++j) { const int e = tid + 512 * j, m = e >> 4, pc = e & 15;
        const u32x4 kr = kr8[j], vr = vr8[j];
        float x[8]; x[0] = bflo(kr.x); x[1] = bfhi(kr.x); x[2] = bflo(kr.y); x[3] = bfhi(kr.y); x[4] = bflo(kr.z); x[5] = bfhi(kr.z); x[6] = bflo(kr.w); x[7] = bfhi(kr.w);
        float ss = 0.f;
#pragma unroll
        for (int k = 0; k < 8; ++k) ss += x[k] * x[k];
        ss += shx(ss, 1, lane); ss += shx(ss, 2, lane); ss += shx(ss, 4, lane); ss += shx(ss, 8, lane);
        const float rstd = rsqrtf(ss * (1.f / 128.f) + 1e-6f);
        u32x4 w; w.x = pk2(x[0] * rstd * kg[pc * 8 + 0], x[1] * rstd * kg[pc * 8 + 1]); w.y = pk2(x[2] * rstd * kg[pc * 8 + 2], x[3] * rstd * kg[pc * 8 + 3]);
        w.z = pk2(x[4] * rstd * kg[pc * 8 + 4], x[5] * rstd * kg[pc * 8 + 5]); w.w = pk2(x[6] * rstd * kg[pc * 8 + 6], x[7] * rstd * kg[pc * 8 + 7]);
        *(LAS u32x4*)(Kn + m * 136 + pc * 8) = w;
        VT[(pc * 8 + 0) * 264 + m] = (bf16_t)(vr.x & 0xffffu); VT[(pc * 8 + 1) * 264 + m] = (bf16_t)(vr.x >> 16);
        VT[(pc * 8 + 2) * 264 + m] = (bf16_t)(vr.y & 0xffffu); VT[(pc * 8 + 3) * 264 + m] = (bf16_t)(vr.y >> 16);
        VT[(pc * 8 + 4) * 264 + m] = (bf16_t)(vr.z & 0xffffu); VT[(pc * 8 + 5) * 264 + m] = (bf16_t)(vr.z >> 16);
        VT[(pc * 8 + 6) * 264 + m] = (bf16_t)(vr.w & 0xffffu); VT[(pc * 8 + 7) * 264 + m] = (bf16_t)(vr.w >> 16); }
    __syncthreads();
    const float qscale = 0.08838834764831845f * 1.4426950408889634f;
    u32x4 qraw[4];
    { const size_t row0 = (size_t)(lb * SEQ + qc * 512 + wave * 16 + l15);
#pragma unroll
      for (int ks = 0; ks < 4; ++ks) qraw[ks] = *(const u32x4*)(P + row0 * PW + C_MQ + head * 128 + 32 * ks + 8 * q); }
#pragma unroll 1
    for (int qt = 0; qt < 4; ++qt) {
        const size_t row = (size_t)(lb * SEQ + qc * 512 + qt * 128 + wave * 16 + l15);
        u32x2 grm[8];
#pragma unroll
        for (int dt = 0; dt < 8; ++dt) grm[dt] = *(const u32x2*)(P + row * PW + C_MG + head * 128 + dt * 16 + 4 * q);
        u32x4 qcur[4];
#pragma unroll
        for (int ks = 0; ks < 4; ++ks) qcur[ks] = qraw[ks];
        { const size_t rown = row + (qt < 3 ? 128 : 0);
#pragma unroll
          for (int ks = 0; ks < 4; ++ks) qraw[ks] = *(const u32x4*)(P + rown * PW + C_MQ + head * 128 + 32 * ks + 8 * q); }
        asm volatile("" ::: "memory");
        bf16x8 qf[4];
        { float x[4][8]; float ss = 0.f;
#pragma unroll
          for (int ks = 0; ks < 4; ++ks) { const u32x4 r = qcur[ks];
              x[ks][0] = bflo(r.x); x[ks][1] = bfhi(r.x); x[ks][2] = bflo(r.y); x[ks][3] = bfhi(r.y); x[ks][4] = bflo(r.z); x[ks][5] = bfhi(r.z); x[ks][6] = bflo(r.w); x[ks][7] = bfhi(r.w);
#pragma unroll
              for (int k = 0; k < 8; ++k) ss += x[ks][k] * x[ks][k]; }
          ss += shx(ss, 16, lane); ss += shx(ss, 32, lane);
          const float rs = rsqrtf(ss * (1.f / 128.f) + 1e-6f) * qscale;
#pragma unroll
          for (int ks = 0; ks < 4; ++ks) { const float* gp = qg + 32 * ks + 8 * q; u32x4 w;
              w.x = pk2m(x[ks][0] * rs * gp[0], x[ks][1] * rs * gp[1]); w.y = pk2m(x[ks][2] * rs * gp[2], x[ks][3] * rs * gp[3]);
              w.z = pk2m(x[ks][4] * rs * gp[4], x[ks][5] * rs * gp[5]); w.w = pk2m(x[ks][6] * rs * gp[6], x[ks][7] * rs * gp[7]);
              qf[ks] = __builtin_bit_cast(bf16x8, w); } }
        f32x4 s[16];
#pragma unroll
        for (int kt = 0; kt < 16; ++kt) { s[kt] = (f32x4){0.f, 0.f, 0.f, 0.f};
#pragma unroll
            for (int ks = 0; ks < 4; ++ks) s[kt] = mma16(ld_frag_l(Kn + (kt * 16 + l15) * 136, ks, q), qf[ks], s[kt]); }
        float mx = -3.0e38f;
#pragma unroll
        for (int kt = 0; kt < 16; ++kt) mx = fmaxf(fmaxf(fmaxf(s[kt][0], s[kt][1]), fmaxf(s[kt][2], s[kt][3])), mx);
        mx = fmaxf(mx, shx(mx, 16, lane)); mx = fmaxf(mx, shx(mx, 32, lane));
        float sum = 0.f;
#pragma unroll
        for (int kt = 0; kt < 16; ++kt) {
#pragma unroll
            for (int i = 0; i < 4; ++i) { const float e = __builtin_amdgcn_exp2f(s[kt][i] - mx); s[kt][i] = e; sum += e; } }
        sum += shx(sum, 16, lane); sum += shx(sum, 32, lane);
        const float inv = frcp(sum);
        f32x4 o[8];
#pragma unroll
        for (int dt = 0; dt < 8; ++dt) o[dt] = (f32x4){0.f, 0.f, 0.f, 0.f};
#pragma unroll
        for (int ks = 0; ks < 8; ++ks) { const bf16x8 pf = pack_frag(s[2 * ks], s[2 * ks + 1]);
#pragma unroll
            for (int dt = 0; dt < 8; ++dt) o[dt] = mma16(ld_frag_perm_l(VT + (dt * 16 + l15) * 264, ks, q), pf, o[dt]); }
#pragma unroll
        for (int dt = 0; dt < 8; ++dt) { const int ch = head * 128 + dt * 16 + 4 * q; const u32x2 gr = grm[dt];
            u32x2 w; w.x = pk2(o[dt][0] * inv * fsilu(bflo(gr.x)), o[dt][1] * inv * fsilu(bfhi(gr.x))); w.y = pk2(o[dt][2] * inv * fsilu(bflo(gr.y)), o[dt][3] * inv * fsilu(bfhi(gr.y)));
            *(u32x2*)(YS + row * YW + 4 * BW + ch) = w; }
        asm volatile("" ::: "memory");
    }
}

__device__ __forceinline__ void ssd_conv8(const bf16_t* prow_col, int tb, const float* cw  , const float* cb, int ch0, float (&y)[8]) {
#pragma unroll
    for (int k = 0; k < 8; ++k) y[k] = cb[ch0 + k];
#pragma unroll
    for (int j = 0; j < 4; ++j) { const int dt = j - 3;
        if (tb + dt >= 0) { const u32x4 r = *(const u32x4*)(prow_col + (ptrdiff_t)dt * PW);
            const f32x4 w0 = *(const f32x4*)(cw + j * 1024 + ch0), w1 = *(const f32x4*)(cw + j * 1024 + ch0 + 4);
            y[0] += w0[0] * bflo(r.x); y[1] += w0[1] * bfhi(r.x); y[2] += w0[2] * bflo(r.y); y[3] += w0[3] * bfhi(r.y);
            y[4] += w1[0] * bflo(r.z); y[5] += w1[1] * bfhi(r.z); y[6] += w1[2] * bflo(r.w); y[7] += w1[3] * bfhi(r.w); } }
#pragma unroll
    for (int k = 0; k < 8; ++k) y[k] = fsilu(y[k]);
}
__device__ __forceinline__ void ssd_conv8x2(const bf16_t* prow_col, int tb0, const float* cw, const float* cb, int ch0, float (&y0)[8], float (&y1)[8]) {
#pragma unroll
    for (int k = 0; k < 8; ++k) { y0[k] = cb[ch0 + k]; y1[k] = y0[k]; }
    f32x4 w[4][2];
#pragma unroll
    for (int j = 0; j < 4; ++j) { w[j][0] = *(const f32x4*)(cw + j * 1024 + ch0); w[j][1] = *(const f32x4*)(cw + j * 1024 + ch0 + 4); }
#pragma unroll
    for (int d = -3; d <= 1; ++d) {
        if (tb0 + d >= 0) { const u32x4 r = *(const u32x4*)(prow_col + (ptrdiff_t)d * PW);
            const float x[8] = {bflo(r.x), bfhi(r.x), bflo(r.y), bfhi(r.y), bflo(r.z), bfhi(r.z), bflo(r.w), bfhi(r.w)};
            if (d + 3 <= 3) {
#pragma unroll
                for (int k = 0; k < 8; ++k) y0[k] += w[d + 3 <= 3 ? d + 3 : 0][k >> 2][k & 3] * x[k]; }
            if (d + 2 >= 0) {
#pragma unroll
                for (int k = 0; k < 8; ++k) y1[k] += w[d + 2 >= 0 ? d + 2 : 0][k >> 2][k & 3] * x[k]; } } }
#pragma unroll
    for (int k = 0; k < 8; ++k) { y0[k] = fsilu(y0[k]); y1[k] = fsilu(y1[k]); }
}
__device__ __forceinline__ void ssd_conv8x4(const bf16_t* prow_col, int tb0, const float* cw, const float* cb, int ch0, float (&y)[4][8]) {
    f32x4 w[4][2];
#pragma unroll
    for (int j = 0; j < 4; ++j) { w[j][0] = *(const f32x4*)(cw + j * 1024 + ch0); w[j][1] = *(const f32x4*)(cw + j * 1024 + ch0 + 4); }
    const f32x4 b0 = *(const f32x4*)(cb + ch0), b1 = *(const f32x4*)(cb + ch0 + 4);
#pragma unroll
    for (int t = 0; t < 4; ++t) { y[t][0] = b0[0]; y[t][1] = b0[1]; y[t][2] = b0[2]; y[t][3] = b0[3]; y[t][4] = b1[0]; y[t][5] = b1[1]; y[t][6] = b1[2]; y[t][7] = b1[3]; }
    u32x4 r[7];
#pragma unroll
    for (int d = -3; d <= 3; ++d) r[d + 3] = (tb0 + d >= 0) ? *(const u32x4*)(prow_col + (ptrdiff_t)d * PW) : (u32x4){0u, 0u, 0u, 0u};
#pragma unroll
    for (int d = -3; d <= 3; ++d) { const u32x4 rr = r[d + 3];
        const float x[8] = {bflo(rr.x), bfhi(rr.x), bflo(rr.y), bfhi(rr.y), bflo(rr.z), bfhi(rr.z), bflo(rr.w), bfhi(rr.w)};
#pragma unroll
        for (int t = 0; t < 4; ++t) { const int j = d - t + 3;
            if (j >= 0 && j <= 3) {
#pragma unroll
                for (int k = 0; k < 8; ++k) y[t][k] += w[j][k >> 2][k & 3] * x[k]; } } }
#pragma unroll
    for (int t = 0; t < 4; ++t)
#pragma unroll
        for (int k = 0; k < 8; ++k) y[t][k] = fsilu(y[t][k]);
}
__device__ __forceinline__ void ssd_rows7(const bf16_t* prow_col, int tb0, u32x4 (&r)[7]) {
#pragma unroll
    for (int d = -3; d <= 3; ++d) r[d + 3] = (tb0 + d >= 0) ? *(const u32x4*)(prow_col + (ptrdiff_t)d * PW) : (u32x4){0u, 0u, 0u, 0u};
}
__device__ __forceinline__ void ssd_conv8x4_r(const u32x4 (&r)[7], const float* cw, const float* cb, int ch0, float (&y)[4][8]) {
    f32x4 w[4][2];
#pragma unroll
    for (int j = 0; j < 4; ++j) { w[j][0] = *(const f32x4*)(cw + j * 1024 + ch0); w[j][1] = *(const f32x4*)(cw + j * 1024 + ch0 + 4); }
    const f32x4 b0 = *(const f32x4*)(cb + ch0), b1 = *(const f32x4*)(cb + ch0 + 4);
#pragma unroll
    for (int t = 0; t < 4; ++t) { y[t][0] = b0[0]; y[t][1] = b0[1]; y[t][2] = b0[2]; y[t][3] = b0[3]; y[t][4] = b1[0]; y[t][5] = b1[1]; y[t][6] = b1[2]; y[t][7] = b1[3]; }
#pragma unroll
    for (int d = -3; d <= 3; ++d) { const u32x4 rr = r[d + 3];
        const float x[8] = {bflo(rr.x), bfhi(rr.x), bflo(rr.y), bfhi(rr.y), bflo(rr.z), bfhi(rr.z), bflo(rr.w), bfhi(rr.w)};
#pragma unroll
        for (int t = 0; t < 4; ++t) { const int j = d - t + 3;
            if (j >= 0 && j <= 3) {
#pragma unroll
                for (int k = 0; k < 8; ++k) y[t][k] += w[j][k >> 2][k & 3] * x[k]; } } }
#pragma unroll
    for (int t = 0; t < 4; ++t)
#pragma unroll
        for (int k = 0; k < 8; ++k) y[t][k] = fsilu(y[t][k]);
}
__device__ __forceinline__ void ssd_dt_tables(const Ctx& c, int layer, int lb, int n, int h0, int nh, LAS float* dtL, LAS float* csL, int tid, bool to_global) {
    const Params& p = *c.p; const bf16_t* P = (const bf16_t*)(p.ws + WS_P); float* SM = (float*)(p.ws + WS_SMALL);
    const int r0 = lb * SEQ + n * 128;
    for (int e = tid; e < 128 * nh; e += 512) { const int s = e / nh, hh = h0 + e % nh;
        const float x = bf2f(P[(size_t)(r0 + s) * PW + C_DDT + hh]) + p.in[17][layer * 8 + hh];
        const float dt = fsoftplus(x); dtL[s * nh + (hh - h0)] = dt; csL[s * nh + (hh - h0)] = dt * (-__expf(p.in[16][layer * 8 + hh])); }
    __syncthreads();
    { const int wv = tid >> 6, ln = tid & 63;
      if (wv < nh) { float a = csL[ln * nh + wv], b = csL[(ln + 64) * nh + wv];
#pragma unroll
          for (int o = 1; o < 64; o <<= 1) { const float ta = __builtin_bit_cast(float, __builtin_amdgcn_ds_bpermute((ln - o) << 2, __builtin_bit_cast(int, a))), tb = __builtin_bit_cast(float, __builtin_amdgcn_ds_bpermute((ln - o) << 2, __builtin_bit_cast(int, b)));
              if (ln >= o) { a += ta; b += tb; } }
          const float tot = __builtin_bit_cast(float, __builtin_amdgcn_ds_bpermute(63 << 2, __builtin_bit_cast(int, a)));
          b += tot; csL[ln * nh + wv] = a; csL[(ln + 64) * nh + wv] = b;
          if (to_global && ln == 63) SM[SM_SSD_CD + (lb * 8 + h0 + wv) * 32 + n] = __expf(b); } }
    __syncthreads();
}
__device__ __forceinline__ void ssd1_unit(const Ctx& c, int layer, int lb, int n, int g) {
    PHASE_TID();
    const Params& p = *c.p; const bf16_t* P = (const bf16_t*)(p.ws + WS_P);
    const float* cw = p.in[14] + (size_t)layer * 4 * 1024; const float* cbias = p.in[15] + layer * 1024;
    LAS float* dtL = (LAS float*)c.lds; LAS float* csL = (LAS float*)(c.lds + 2048);
    LAS bf16_t* bmT = (LAS bf16_t*)(c.lds + 4096);
    LAS bf16_t* xdT = (LAS bf16_t*)(c.lds + 4096 + 34816);
    const int r0 = lb * SEQ + n * 128, q = lane >> 4, l15 = lane & 15;
    __syncthreads();
    ssd_dt_tables(c, layer, lb, n, g * 4, 4, dtL, csL, tid, true);
    for (int e = tid; e < 32 * 48; e += 512) { const int sg4 = e / 48, blk = e % 48, s0 = 4 * sg4; float y[4][8];
        if (blk < 16) { const int ch0 = 512 + g * 128 + blk * 8;
            ssd_conv8x4(P + (size_t)(r0 + s0) * PW + C_DX + ch0, n * 128 + s0, cw, cbias, ch0, y);
#pragma unroll
            for (int k = 0; k < 8; ++k) { u32x2 w; w.x = pk2(y[0][k], y[1][k]); w.y = pk2(y[2][k], y[3][k]); *(LAS u32x2*)(bmT + (blk * 8 + k) * 136 + s0) = w; }
        } else { const int b2 = blk - 16, r = b2 >> 3, ch0 = (g * 4 + r) * 64 + (b2 & 7) * 8;
            ssd_conv8x4(P + (size_t)(r0 + s0) * PW + C_DX + ch0, n * 128 + s0, cw, cbias, ch0, y);
            const float cl = csL[127 * 4 + r]; float f[4];
#pragma unroll
            for (int t = 0; t < 4; ++t) f[t] = dtL[(s0 + t) * 4 + r] * __expf(cl - csL[(s0 + t) * 4 + r]);
#pragma unroll
            for (int k = 0; k < 8; ++k) { u32x2 w; w.x = pk2(y[0][k] * f[0], y[1][k] * f[1]); w.y = pk2(y[2][k] * f[2], y[3][k] * f[3]); *(LAS u32x2*)(xdT + (b2 * 8 + k) * 136 + s0) = w; } }
    }
    __syncthreads();
    f32x4 acc[2][8];
#pragma unroll
    for (int a = 0; a < 2; ++a)
#pragma unroll
        for (int m = 0; m < 8; ++m) acc[a][m] = (f32x4){0.f, 0.f, 0.f, 0.f};
#pragma unroll
    for (int ks = 0; ks < 4; ++ks) {
        const bf16x8 b0 = ld_frag_l(xdT + ((2 * wave) * 16 + l15) * 136, ks, q), b1 = ld_frag_l(xdT + ((2 * wave + 1) * 16 + l15) * 136, ks, q);
#pragma unroll
        for (int m = 0; m < 8; ++m) { const bf16x8 a = ld_frag_l(bmT + (m * 16 + l15) * 136, ks, q); acc[0][m] = mma16(a, b0, acc[0][m]); acc[1][m] = mma16(a, b1, acc[1][m]); }
    }
    bf16_t* ST = (bf16_t*)(p.ws + WS_SSD) + (size_t)(lb * 32 + n) * 8 * 8192;
#pragma unroll
    for (int a = 0; a < 2; ++a) { const int rp = (2 * wave + a) * 16 + l15, hh = g * 4 + (rp >> 6), pp = rp & 63;
#pragma unroll
        for (int m = 0; m < 8; ++m) { u32x2 w; w.x = pk2m(acc[a][m][0], acc[a][m][1]); w.y = pk2m(acc[a][m][2], acc[a][m][3]);
            *(u32x2*)(ST + (size_t)hh * 8192 + pp * 128 + m * 16 + 4 * q) = w; } }
}
__device__ __forceinline__ void ssd_scan(const Ctx& c) {
    PHASE_TID();
    const Params& p = *c.p; const float* SM = (const float*)(p.ws + WS_SMALL);
    for (int e = c.bid * 512 + tid; e < GB * 8 * 4096; e += c.G * 512) {
        const int lb = e >> 15, hh = (e >> 12) & 7, pr = e & 4095;
        unsigned* base = (unsigned*)(p.ws + WS_SSD) + (size_t)(lb * 32) * 8 * 4096 + (size_t)hh * 4096 + pr;
        unsigned v[32]; float cdv[32];
#pragma unroll
        for (int n = 0; n < 32; ++n) { v[n] = base[(size_t)n * 8 * 4096]; cdv[n] = SM[SM_SSD_CD + (lb * 8 + hh) * 32 + n]; }
        float r0 = 0.f, r1 = 0.f;
#pragma unroll
        for (int n = 0; n < 32; ++n) { base[(size_t)n * 8 * 4096] = pk2(r0, r1); r0 = cdv[n] * r0 + bflo(v[n]); r1 = cdv[n] * r1 + bfhi(v[n]); }
    }
}
__device__ __forceinline__ void ssd3_unit(const Ctx& c, int layer, int lb, int n) {
    PHASE_TID();
    const Params& p = *c.p; const bf16_t* P = (const bf16_t*)(p.ws + WS_P); bf16_t* YS = (bf16_t*)(p.ws + WS_YS);
    const float* cw = p.in[14] + (size_t)layer * 4 * 1024; const float* cbias = p.in[15] + layer * 1024;
    const float* dskip = p.in[18] + layer * 8;
    LAS float* dtL = (LAS float*)c.lds; LAS float* csL = (LAS float*)(c.lds + 4096);
    LAS bf16_t* cmL = (LAS bf16_t*)(c.lds + 8192);
    LAS bf16_t* bmL = (LAS bf16_t*)(c.lds + 8192 + 34816);
    LAS bf16_t* xdT = (LAS bf16_t*)(c.lds + 8192 + 34816);
    const int r0 = lb * SEQ + n * 128, q = lane >> 4, l15 = lane & 15;
    const size_t row = (size_t)(r0 + wave * 16 + l15);
    const bf16_t* SP = (const bf16_t*)(p.ws + WS_SSD) + (size_t)(lb * 32 + n) * 8 * 8192;
    __syncthreads();
    ssd_dt_tables(c, layer, lb, n, 0, 8, dtL, csL, tid, false);
    float ssq = 0.f;
    for (int g = 0; g < 2; ++g) {
        __syncthreads();
        {
            u32x4 rr2[2][7];
#pragma unroll
            for (int j2 = 0; j2 < 2; ++j2) { const int e = tid + 512 * j2, s0 = (e >> 5) * 4, blk = e & 31, ch0 = (blk < 16 ? 768 : 512) + g * 128 + (blk & 15) * 8;
                ssd_rows7(P + (size_t)(r0 + s0) * PW + C_DX + ch0, n * 128 + s0, rr2[j2]); }
#pragma unroll
            for (int j2 = 0; j2 < 2; ++j2) { const int e = tid + 512 * j2, s0 = (e >> 5) * 4, blk = e & 31, ch0 = (blk < 16 ? 768 : 512) + g * 128 + (blk & 15) * 8; float y[4][8];
                ssd_conv8x4_r(rr2[j2], cw, cbias, ch0, y);
#pragma unroll
                for (int t = 0; t < 4; ++t) { u32x4 w; w.x = pk2(y[t][0], y[t][1]); w.y = pk2(y[t][2], y[t][3]); w.z = pk2(y[t][4], y[t][5]); w.w = pk2(y[t][6], y[t][7]);
                    *(LAS u32x4*)((blk < 16 ? cmL : bmL) + (s0 + t) * 136 + (blk & 15) * 8) = w; } } }
        __syncthreads();
        bf16x8 cmf[4];
#pragma unroll
        for (int ks = 0; ks < 4; ++ks) cmf[ks] = ld_frag_l(cmL + (wave * 16 + l15) * 136, ks, q);
        f32x4 cbT[8];
#pragma unroll
        for (int st = 0; st < 8; ++st) { cbT[st] = (f32x4){0.f, 0.f, 0.f, 0.f};
            if (st <= wave) {
#pragma unroll
                for (int ks = 0; ks < 4; ++ks) cbT[st] = mma16(ld_frag_l(bmL + (st * 16 + l15) * 136, ks, q), cmf[ks], cbT[st]); } }
        __syncthreads();
        {
            u32x4 rr2[2][7];
#pragma unroll
            for (int j2 = 0; j2 < 2; ++j2) { const int e = tid + 512 * j2, s0 = (e >> 5) * 4, b2 = e & 31, r = b2 >> 3, ch0 = (g * 4 + r) * 64 + (b2 & 7) * 8;
                ssd_rows7(P + (size_t)(r0 + s0) * PW + C_DX + ch0, n * 128 + s0, rr2[j2]); }
#pragma unroll
            for (int j2 = 0; j2 < 2; ++j2) { const int e = tid + 512 * j2, s0 = (e >> 5) * 4, b2 = e & 31, r = b2 >> 3, ch0 = (g * 4 + r) * 64 + (b2 & 7) * 8; float y[4][8];
                ssd_conv8x4_r(rr2[j2], cw, cbias, ch0, y);
                const float f0 = dtL[s0 * 8 + g * 4 + r], f1 = dtL[(s0 + 1) * 8 + g * 4 + r], f2 = dtL[(s0 + 2) * 8 + g * 4 + r], f3 = dtL[(s0 + 3) * 8 + g * 4 + r];
#pragma unroll
                for (int k = 0; k < 8; ++k) { u32x2 w; w.x = pk2(y[0][k] * f0, y[1][k] * f1); w.y = pk2(y[2][k] * f2, y[3][k] * f3); *(LAS u32x2*)(xdT + (b2 * 8 + k) * 136 + s0) = w; } } }
        __syncthreads();
        const int cpos = wave * 16 + l15;
#pragma unroll 1
        for (int r = 0; r < 4; ++r) { const int hh = g * 4 + r; const float csc = csL[cpos * 8 + hh];
            f32x4 yd[4], yo[4];
            bf16x8 spf[4][4]; u32x2 zr4[4];
#pragma unroll
            for (int ks = 0; ks < 4; ++ks)
#pragma unroll
                for (int pt = 0; pt < 4; ++pt) spf[ks][pt] = ld_frag_g(SP + (size_t)hh * 8192 + (pt * 16 + l15) * 128, ks, q);
#pragma unroll
            for (int pt = 0; pt < 4; ++pt) zr4[pt] = *(const u32x2*)(P + row * PW + C_DZ + hh * 64 + pt * 16 + 4 * q);
            asm volatile("" ::: "memory");
#pragma unroll
            for (int pt = 0; pt < 4; ++pt) { yd[pt] = (f32x4){0.f, 0.f, 0.f, 0.f}; yo[pt] = (f32x4){0.f, 0.f, 0.f, 0.f}; }
#pragma unroll
            for (int ks = 0; ks < 4; ++ks) {
                if (2 * ks <= wave) {
                    f32x4 m0, m1;
#pragma unroll
                    for (int i = 0; i < 4; ++i) { const int s0 = 32 * ks + 4 * q + i, s1 = s0 + 16;
                        m0[i] = s0 <= cpos ? cbT[2 * ks][i] * __expf(fminf(csc - csL[s0 * 8 + hh], 0.f)) : 0.f;
                        m1[i] = s1 <= cpos ? cbT[2 * ks + 1][i] * __expf(fminf(csc - csL[s1 * 8 + hh], 0.f)) : 0.f; }
                    const bf16x8 mf = pack_frag(m0, m1);
#pragma unroll
                    for (int pt = 0; pt < 4; ++pt) yd[pt] = mma16(ld_frag_perm_l(xdT + (r * 64 + pt * 16 + l15) * 136, ks, q), mf, yd[pt]);
                }
#pragma unroll
                for (int pt = 0; pt < 4; ++pt) yo[pt] = mma16(spf[ks][pt], cmf[ks], yo[pt]);
            }
            const float ecs = __expf(csc), dsk = dskip[hh] / dtL[cpos * 8 + hh];
#pragma unroll
            for (int pt = 0; pt < 4; ++pt) { const int ch = hh * 64 + pt * 16 + 4 * q;
                const u32x2 zr = zr4[pt];
                float yv[4];
#pragma unroll
                for (int i = 0; i < 4; ++i) yv[i] = yd[pt][i] + ecs * yo[pt][i] + dsk * bf2f(xdT[(r * 64 + pt * 16 + 4 * q + i) * 136 + cpos]);
                yv[0] *= fsilu(bflo(zr.x)); yv[1] *= fsilu(bfhi(zr.x)); yv[2] *= fsilu(bflo(zr.y)); yv[3] *= fsilu(bfhi(zr.y));
                ssq += (yv[0] * yv[0] + yv[1] * yv[1]) + (yv[2] * yv[2] + yv[3] * yv[3]);
                u32x2 w; w.x = pk2(yv[0], yv[1]); w.y = pk2(yv[2], yv[3]);
                *(u32x2*)(YS + row * YW + 3 * BW + ch) = w; }
        }
    }
    ssq += shx(ssq, 16, lane); ssq += shx(ssq, 32, lane);
    if (q == 0) ((float*)(p.ws + WS_SMALL))[SM_SSD_RS + row] = rsqrtf(ssq * (1.f / BW) + 1e-6f);
}

__device__ __forceinline__ float row16_sum(float v) {
    v += __builtin_bit_cast(float, __builtin_amdgcn_mov_dpp(__builtin_bit_cast(int, v), 0xB1, 0xF, 0xF, true));
    v += __builtin_bit_cast(float, __builtin_amdgcn_mov_dpp(__builtin_bit_cast(int, v), 0x4E, 0xF, 0xF, true));
    v += __builtin_bit_cast(float, __builtin_amdgcn_mov_dpp(__builtin_bit_cast(int, v), 0x141, 0xF, 0xF, true));
    v += __builtin_bit_cast(float, __builtin_amdgcn_mov_dpp(__builtin_bit_cast(int, v), 0x140, 0xF, 0xF, true));
    return v;
}
__device__ __forceinline__ void gdn_pre_unit(const Ctx& c, int layer, int lb, int n, int h) {
    PHASE_TID();
    const Params& p = *c.p; const bf16_t* P = (const bf16_t*)(p.ws + WS_P);
    const float* cw = p.in[4] + (size_t)layer * 4 * 1536;
    LAS bf16_t* qL = (LAS bf16_t*)c.lds; LAS bf16_t* kL = (LAS bf16_t*)(c.lds + 17408); LAS bf16_t* vL = (LAS bf16_t*)(c.lds + 34816);
    LAS float* Lm = (LAS float*)(c.lds + 52224);
    LAS float* gcL = (LAS float*)(c.lds + 69632); LAS float* btL = (LAS float*)(c.lds + 69888);
    LAS bf16_t* LbL = (LAS bf16_t*)(c.lds + 70144);
    LAS bf16_t* XT = (LAS bf16_t*)(c.lds + 79360);
    unsigned char* scr = p.ws + WS_GDN + (size_t)((lb * 4 + h) * 64 + n) * GDN_CH_BYTES;
    bf16_t* WK = (bf16_t*)scr; bf16_t* U0T = (bf16_t*)(scr + 16384); bf16_t* QD = (bf16_t*)(scr + 32768); bf16_t* KDT = (bf16_t*)(scr + 49152); bf16_t* QK = (bf16_t*)(scr + 65536);
    const int r0 = lb * SEQ + n * 64, q = lane >> 4, l15 = lane & 15;
    __syncthreads();
    { unsigned z0 = 0u; asm volatile("" : "+v"(z0));
      for (int i = tid; i < 2304; i += 512) *(LAS u32x4*)(c.lds + 79360 + i * 16) = (u32x4){z0, z0, z0, z0}; }
    if (wave == 0) {
        const float a_in = bf2f(P[(size_t)(r0 + lane) * PW + C_AA + h]), b_in = bf2f(P[(size_t)(r0 + lane) * PW + C_AB + h]);
        float gl = -__expf(p.in[5][layer * 4 + h]) * fsoftplus(a_in + p.in[6][layer * 4 + h]);
#pragma unroll
        for (int o = 1; o < 64; o <<= 1) { const float t = __builtin_bit_cast(float, __builtin_amdgcn_ds_bpermute((lane - o) << 2, __builtin_bit_cast(int, gl))); if (lane >= o) gl += t; }
        gcL[lane] = gl; btL[lane] = fsigmoid(b_in);
    }
#define CONV_LOAD(e_, RR_, WW_) do { const int part = (e_) >> 8, s0 = (((e_) >> 4) & 15) * 4, blk = (e_) & 15, ch0 = part * 512 + h * 128 + blk * 8, tb0 = n * 64 + s0; \
        const bf16_t* src = P + (size_t)(r0 + s0) * PW + ch0;        \
        _Pragma("unroll") for (int jj = 0; jj < 4; ++jj) { WW_[jj][0] = *(const f32x4*)(cw + jj * 1536 + ch0); WW_[jj][1] = *(const f32x4*)(cw + jj * 1536 + ch0 + 4); } \
        _Pragma("unroll") for (int d = -3; d <= 3; ++d) RR_[d + 3] = (tb0 + d >= 0) ? *(const u32x4*)(src + (ptrdiff_t)d * PW) : (u32x4){0u, 0u, 0u, 0u}; } while (0)
#define CONV_COMP(e_, RR_, WW_) do { const int part = (e_) >> 8, s0 = (((e_) >> 4) & 15) * 4, blk = (e_) & 15; \
        float y[4][8]; \
        _Pragma("unroll") for (int t = 0; t < 4; ++t) _Pragma("unroll") for (int k = 0; k < 8; ++k) y[t][k] = 0.f; \
        _Pragma("unroll") for (int d = -3; d <= 3; ++d) { const u32x4 rr = RR_[d + 3]; \
            const float x[8] = {bflo(rr.x), bfhi(rr.x), bflo(rr.y), bfhi(rr.y), bflo(rr.z), bfhi(rr.z), bflo(rr.w), bfhi(rr.w)}; \
            _Pragma("unroll") for (int t = 0; t < 4; ++t) { const int jj = d - t + 3; \
                if (jj >= 0 && jj <= 3) { _Pragma("unroll") for (int k = 0; k < 8; ++k) y[t][k] += WW_[jj][k >> 2][k & 3] * x[k]; } } } \
        _Pragma("unroll") for (int t = 0; t < 4; ++t) { float ss = 0.f; \
            _Pragma("unroll") for (int k = 0; k < 8; ++k) { y[t][k] = fsilu(y[t][k]); ss += y[t][k] * y[t][k]; } \
            ss = row16_sum(ss); \
            const float sc = part == 2 ? 1.0f : rsqrtf(ss + 1e-6f) * (part == 0 ? 0.08838834764831845f : 1.0f); \
            u32x4 wv; wv.x = pk2(y[t][0] * sc, y[t][1] * sc); wv.y = pk2(y[t][2] * sc, y[t][3] * sc); wv.z = pk2(y[t][4] * sc, y[t][5] * sc); wv.w = pk2(y[t][6] * sc, y[t][7] * sc); \
            *(LAS u32x4*)((part == 0 ? qL : part == 1 ? kL : vL) + (s0 + t) * 136 + blk * 8) = wv; } } while (0)
    {
        u32x4 rA[7], rB[7]; f32x4 wA[4][2], wB[4][2];
        CONV_LOAD(tid, rA, wA);
        if (tid < 256) CONV_LOAD(tid + 512, rB, wB);
        CONV_COMP(tid, rA, wA);
        if (tid < 256) CONV_COMP(tid + 512, rB, wB);
    }
#undef CONV_LOAD
#undef CONV_COMP
    __syncthreads();
    {
        const int sel = wave >> 2, ct = wave & 3, cc = ct * 16 + l15; const float gcc = gcL[cc], btc = btL[cc];
        bf16x8 bf[4];
#pragma unroll
        for (int ks = 0; ks < 4; ++ks) bf[ks] = ld_frag_l((sel ? qL : kL) + cc * 136, ks, q);
#pragma unroll
        for (int st = 0; st < 4; ++st) { f32x4 d = (f32x4){0.f, 0.f, 0.f, 0.f};
            if (st <= ct) {
#pragma unroll
                for (int ks = 0; ks < 4; ++ks) d = mma16(ld_frag_l(kL + (st * 16 + l15) * 136, ks, q), bf[ks], d); }
            f32x4 o;
#pragma unroll
            for (int i = 0; i < 4; ++i) { const int s = st * 16 + 4 * q + i; const float dec = __expf(fminf(gcc - gcL[s], 0.f));
                o[i] = sel ? (s <= cc ? d[i] * dec : 0.f) : (s < cc ? d[i] * dec * btc : 0.f); }
            if (sel) { u32x2 w; w.x = pk2(o[0], o[1]); w.y = pk2(o[2], o[3]); *(u32x2*)(QK + cc * 64 + st * 16 + 4 * q) = w; }
            else { *(LAS f32x4*)(Lm + cc * 68 + st * 16 + 4 * q) = o; u32x2 w; w.x = pk2(o[0], o[1]); w.y = pk2(o[2], o[3]); *(LAS u32x2*)(LbL + cc * 72 + st * 16 + 4 * q) = w; } }
    }
    __syncthreads();
#pragma unroll
    for (int b = 0; b < 4; ++b) {
        f32x4 U[2] = {(f32x4){0.f, 0.f, 0.f, 0.f}, (f32x4){0.f, 0.f, 0.f, 0.f}};
        if (b > 0) {
#pragma unroll
            for (int ks = 0; ks < (b + 1) / 2; ++ks) { const bf16x8 a = ld_frag_l(LbL + (16 * b + l15) * 72, ks, q);
#pragma unroll
                for (int t = 0; t < 2; ++t) U[t] = mma16(a, ld_frag_l(XT + ((2 * wave + t) * 16 + l15) * 72, ks, q), U[t]); } }
#pragma unroll
        for (int t = 0; t < 2; ++t) { const int col = (2 * wave + t) * 16 + l15; const bool isk = col < 128; const LAS bf16_t* colp = (isk ? kL : vL) + (col & 127);
            float y[4];
#pragma unroll
            for (int i = 0; i < 4; ++i) { const int cc = 16 * b + 4 * q + i; y[i] = btL[cc] * (isk ? __expf(gcL[cc]) : 1.0f) * bf2f(colp[cc * 136]) - U[t][i]; }
#pragma unroll
            for (int qq = 0; qq < 4; ++qq) {
                f32x4 lr[4];
#pragma unroll
                for (int i = 0; i < 4; ++i) lr[i] = *(const LAS f32x4*)(Lm + (16 * b + 4 * q + i) * 68 + 16 * b + 4 * qq);
                if (q == qq) { y[1] -= lr[1][0] * y[0]; y[2] -= lr[2][0] * y[0] + lr[2][1] * y[1]; y[3] -= lr[3][0] * y[0] + lr[3][1] * y[1] + lr[3][2] * y[2]; }
                float bx[4];
#pragma unroll
                for (int i = 0; i < 4; ++i) bx[i] = __builtin_bit_cast(float, __builtin_amdgcn_ds_bpermute((l15 + 16 * qq) << 2, __builtin_bit_cast(int, y[i])));
                if (q > qq) {
#pragma unroll
                    for (int i = 0; i < 4; ++i) y[i] -= (lr[i][0] * bx[0] + lr[i][1] * bx[1]) + (lr[i][2] * bx[2] + lr[i][3] * bx[3]); }
            }
            u32x2 w; w.x = pk2(y[0], y[1]); w.y = pk2(y[2], y[3]);
            *(LAS u32x2*)(XT + col * 72 + 16 * b + 4 * q) = w; }
        __syncthreads();
    }
    {
        const float g63 = gcL[63];
#pragma unroll
        for (int jj = 0; jj < 2; ++jj) { const int e = tid + 512 * jj, v = e >> 3, pc = e & 7;
            *(u32x4*)(U0T + v * 64 + pc * 8) = *(const LAS u32x4*)(XT + (128 + v) * 72 + pc * 8); }
#pragma unroll
        for (int jj = 0; jj < 2; ++jj) { const int e = tid + 512 * jj, cc = e & 63, d0 = (e >> 6) * 8; unsigned short v8[8];
#pragma unroll
            for (int i = 0; i < 8; ++i) v8[i] = XT[(d0 + i) * 72 + cc];
            u32x4 w; w.x = v8[0] | ((unsigned)v8[1] << 16); w.y = v8[2] | ((unsigned)v8[3] << 16); w.z = v8[4] | ((unsigned)v8[5] << 16); w.w = v8[6] | ((unsigned)v8[7] << 16);
            *(u32x4*)(WK + cc * 128 + d0) = w; }
#pragma unroll
        for (int jj = 0; jj < 2; ++jj) { const int e = tid + 512 * jj, s_ = e >> 4, blk = e & 15; const float sc = __expf(gcL[s_]);
            const u32x4 r = *(const LAS u32x4*)(qL + s_ * 136 + blk * 8);
            u32x4 w; w.x = pk2(bflo(r.x) * sc, bfhi(r.x) * sc); w.y = pk2(bflo(r.y) * sc, bfhi(r.y) * sc); w.z = pk2(bflo(r.z) * sc, bfhi(r.z) * sc); w.w = pk2(bflo(r.w) * sc, bfhi(r.w) * sc);
            *(u32x4*)(QD + s_ * 128 + blk * 8) = w; }
#pragma unroll
        for (int jj = 0; jj < 2; ++jj) { const int e = tid + 512 * jj, d = e & 127, s0 = (e >> 7) * 8; float v[8];
#pragma unroll
            for (int i = 0; i < 8; ++i) v[i] = bf2f(kL[(s0 + i) * 136 + d]) * __expf(g63 - gcL[s0 + i]);
            u32x4 w; w.x = pk2(v[0], v[1]); w.y = pk2(v[2], v[3]); w.z = pk2(v[4], v[5]); w.w = pk2(v[6], v[7]);
            *(u32x4*)(KDT + d * 64 + s0) = w; }
        if (tid == 0) ((float*)(p.ws + WS_SMALL))[SM_GDN_CD + (lb * 4 + h) * 64 + n] = __expf(g63);
    }
}

__device__ __forceinline__ void gdn_chain(const Ctx& c, int layer, int lb, int h, int half) {
    PHASE_TID();
    const Params& p = *c.p; bf16_t* YS = (bf16_t*)(p.ws + WS_YS);
    const float* SM = (const float*)(p.ws + WS_SMALL);
    const int q = lane >> 4, l15 = lane & 15, vcol = (half * 4 + (wave & 3)) * 16 + l15;
    const unsigned char* scr0 = p.ws + WS_GDN + (size_t)((lb * 4 + h) * 64) * GDN_CH_BYTES;
    constexpr int BUFB = 62464;
    const bool loader = wave >= 4; const int lt = tid - 256;
#define GDN_LD(r_, nn) do { const unsigned char* sc_ = scr0 + (size_t)(nn) * GDN_CH_BYTES; \
        _Pragma("unroll") for (int j = 0; j < 14; ++j) { const int idx = lt + 256 * j; \
            const size_t so = j < 4 ? (size_t)idx * 16 : j < 8 ? 32768 + (size_t)(idx - 1024) * 16 : j < 12 ? 49152 + (size_t)(idx - 2048) * 16 : 65536 + (size_t)(idx - 3072) * 16; \
            r_[j] = *(const u32x4*)(sc_ + so); } } while (0)
#define GDN_ST(r_, buf) do { ldsp_t b_ = c.lds + (buf) * BUFB; \
        _Pragma("unroll") for (int j = 0; j < 14; ++j) { const int idx = lt + 256 * j; \
            const int lo = j < 4 ? (idx >> 4) * 272 + (idx & 15) * 16 : j < 8 ? 17408 + ((idx - 1024) >> 4) * 272 + (idx & 15) * 16 \
                         : j < 12 ? 34816 + ((idx - 2048) >> 3) * 144 + (idx & 7) * 16 : 53248 + ((idx - 3072) >> 3) * 144 + (idx & 7) * 16; \
            *(LAS u32x4*)(b_ + lo) = r_[j]; } } while (0)
    f32x4 st[8];
#pragma unroll
    for (int d = 0; d < 8; ++d) st[d] = (f32x4){0.f, 0.f, 0.f, 0.f};
    u32x2 u0r[4]; float cdn = 0.f;
    __syncthreads();
    if (loader) {
        u32x4 ra[14], rb[14], rc[14];
        GDN_LD(ra, 0); GDN_LD(rb, 1); GDN_LD(rc, 2);
        GDN_ST(ra, 0); GDN_LD(ra, 3);
        __syncthreads();
#pragma unroll 1
        for (int n = 0; n < 66; n += 3) {
            if (n < 64) { if (n + 1 < 64) { GDN_ST(rb, (n + 1) & 1); if (n + 4 < 64) GDN_LD(rb, n + 4); } __syncthreads(); }
            if (n + 1 < 64) { if (n + 2 < 64) { GDN_ST(rc, (n + 2) & 1); if (n + 5 < 64) GDN_LD(rc, n + 5); } __syncthreads(); }
            if (n + 2 < 64) { if (n + 3 < 64) { GDN_ST(ra, (n + 3) & 1); if (n + 6 < 64) GDN_LD(ra, n + 6); } __syncthreads(); }
        }
        return;
    }
#pragma unroll
    for (int m = 0; m < 4; ++m) u0r[m] = *(const u32x2*)(scr0 + 16384 + (size_t)(vcol * 64 + m * 16 + 4 * q) * 2);
    cdn = SM[SM_GDN_CD + (lb * 4 + h) * 64];
    __syncthreads();
#pragma unroll 1
    for (int n = 0; n < 64; ++n) {
        {
            ldsp_t b = c.lds + (n & 1) * BUFB;
            const LAS bf16_t* wkL = (const LAS bf16_t*)b; const LAS bf16_t* qdL = (const LAS bf16_t*)(b + 17408);
            const LAS bf16_t* kdL = (const LAS bf16_t*)(b + 34816); const LAS bf16_t* qkL = (const LAS bf16_t*)(b + 53248);
            const float cd = cdn;
            f32x4 u0[4];
#pragma unroll
            for (int m = 0; m < 4; ++m) u0[m] = (f32x4){bflo(u0r[m].x), bfhi(u0r[m].x), bflo(u0r[m].y), bfhi(u0r[m].y)};
            if (n < 63) {
                const unsigned char* sn = scr0 + (size_t)(n + 1) * GDN_CH_BYTES;
#pragma unroll
                for (int m = 0; m < 4; ++m) u0r[m] = *(const u32x2*)(sn + 16384 + (size_t)(vcol * 64 + m * 16 + 4 * q) * 2);
                cdn = SM[SM_GDN_CD + (lb * 4 + h) * 64 + n + 1]; }
            bf16x8 sf[4];
#pragma unroll
            for (int ks = 0; ks < 4; ++ks) sf[ks] = pack_frag(st[2 * ks], st[2 * ks + 1]);
            f32x4 x[4], o[4];
#pragma unroll
            for (int m = 0; m < 4; ++m) { x[m] = (f32x4){0.f, 0.f, 0.f, 0.f}; o[m] = (f32x4){0.f, 0.f, 0.f, 0.f};
#pragma unroll
                for (int ks = 0; ks < 4; ++ks) { x[m] = mma16(ld_frag_perm_l(wkL + (m * 16 + l15) * 136, ks, q), sf[ks], x[m]); o[m] = mma16(ld_frag_perm_l(qdL + (m * 16 + l15) * 136, ks, q), sf[ks], o[m]); } }
#pragma unroll
            for (int m = 0; m < 4; ++m) x[m] = u0[m] - x[m];
            bf16x8 uf[2];
#pragma unroll
            for (int k2 = 0; k2 < 2; ++k2) uf[k2] = pack_frag(x[2 * k2], x[2 * k2 + 1]);
#pragma unroll
            for (int d = 0; d < 8; ++d) { st[d] = st[d] * cd;
#pragma unroll
                for (int k2 = 0; k2 < 2; ++k2) st[d] = mma16(ld_frag_perm_l(kdL + (d * 16 + l15) * 72, k2, q), uf[k2], st[d]); }
#pragma unroll
            for (int m = 0; m < 4; ++m)
#pragma unroll
                for (int k2 = 0; k2 < 2; ++k2) o[m] = mma16(ld_frag_perm_l(qkL + (m * 16 + l15) * 72, k2, q), uf[k2], o[m]);
            const size_t rowb = (size_t)(lb * SEQ + n * 64);
#pragma unroll
            for (int m = 0; m < 4; ++m)
#pragma unroll
                for (int i = 0; i < 4; ++i) YS[(rowb + m * 16 + 4 * q + i) * YW + h * 128 + vcol] = f2bfm(o[m][i]);
        }
        __syncthreads();
    }
#undef GDN_LD
#undef GDN_ST
}
__device__ __forceinline__ void gdn_post(const Ctx& c, int layer) {
    PHASE_TID();
    const Params& p = *c.p; const bf16_t* P = (const bf16_t*)(p.ws + WS_P); bf16_t* YS = (bf16_t*)(p.ws + WS_YS);
    const float* ng = p.in[7] + layer * 128;
    const int ch = lane * 8, d0 = ch & 127;
    for (int r = c.bid * 8 + wave; r < TG; r += c.G * 32) {
        u32x4 ov2[4], gr2[4];
#pragma unroll
        for (int k = 0; k < 4; ++k) { const size_t rr = (size_t)(r + k * c.G * 8); ov2[k] = *(const u32x4*)(YS + rr * YW + ch); gr2[k] = *(const u32x4*)(P + rr * PW + C_AG + ch); }
        asm volatile("" ::: "memory");
#pragma unroll
        for (int k = 0; k < 4; ++k) { const size_t rr = (size_t)(r + k * c.G * 8); const u32x4 ov = ov2[k], gr = gr2[k];
            float x[8] = {bflo(ov.x), bfhi(ov.x), bflo(ov.y), bfhi(ov.y), bflo(ov.z), bfhi(ov.z), bflo(ov.w), bfhi(ov.w)};
            const float g8[8] = {bflo(gr.x), bfhi(gr.x), bflo(gr.y), bfhi(gr.y), bflo(gr.z), bfhi(gr.z), bflo(gr.w), bfhi(gr.w)};
            float ss = 0.f;
#pragma unroll
            for (int j = 0; j < 8; ++j) ss += x[j] * x[j];
            ss = row16_sum(ss);
            const float rs = rsqrtf(ss * (1.f / 128.f) + 1e-6f);
#pragma unroll
            for (int j = 0; j < 8; ++j) x[j] = x[j] * rs * ng[d0 + j] * fsilu(g8[j]);
            u32x4 w; w.x = pk2(x[0], x[1]); w.y = pk2(x[2], x[3]); w.z = pk2(x[4], x[5]); w.w = pk2(x[6], x[7]);
            *(u32x4*)(YS + rr * YW + ch) = w; }
        asm volatile("" ::: "memory");
    }
}

__device__ __forceinline__ float row8_sum(float v) {
    v += __builtin_bit_cast(float, __builtin_amdgcn_mov_dpp(__builtin_bit_cast(int, v), 0xB1, 0xF, 0xF, true));
    v += __builtin_bit_cast(float, __builtin_amdgcn_mov_dpp(__builtin_bit_cast(int, v), 0x4E, 0xF, 0xF, true));
    v += __builtin_bit_cast(float, __builtin_amdgcn_mov_dpp(__builtin_bit_cast(int, v), 0x141, 0xF, 0xF, true));
    return v;
}
__device__ __forceinline__ void dsa_prep_unit(const Ctx& c, int layer, int lb, int tt) {
    PHASE_TID();
    const Params& p = *c.p; const bf16_t* P = (const bf16_t*)(p.ws + WS_P);
    bf16_t* DKN = (bf16_t*)(p.ws + WS_DKN) + (size_t)lb * SEQ * 64; bf16_t* DVT = (bf16_t*)(p.ws + WS_DVT) + (size_t)lb * 64 * SEQ;
    bf16_t* DVN = (bf16_t*)(p.ws + WS_VN) + (size_t)lb * SEQ * 64;
    const float* kg = p.in[13] + layer * 64;
    LAS bf16_t* vL = (LAS bf16_t*)c.lds;
    const int t = tid >> 3, pc = tid & 7, tok = tt * 64 + t;
    __syncthreads();
    const bf16_t* src = P + (size_t)(lb * SEQ + tok) * PW;
    const u32x4 kr = *(const u32x4*)(src + C_CK + pc * 8), vr = *(const u32x4*)(src + C_CV + pc * 8);
    const u32x4 ikr = *(const u32x4*)(src + C_CIK + pc * 8);
    float x[8] = {bflo(kr.x), bfhi(kr.x), bflo(kr.y), bfhi(kr.y), bflo(kr.z), bfhi(kr.z), bflo(kr.w), bfhi(kr.w)};
    float ss = 0.f;
#pragma unroll
    for (int k = 0; k < 8; ++k) ss += x[k] * x[k];
    ss = row8_sum(ss);
    const float rs = rsqrtf(ss * (1.f / 64.f) + 1e-6f);
    u32x4 w; w.x = pk2(x[0] * rs * kg[pc * 8 + 0], x[1] * rs * kg[pc * 8 + 1]); w.y = pk2(x[2] * rs * kg[pc * 8 + 2], x[3] * rs * kg[pc * 8 + 3]);
    w.z = pk2(x[4] * rs * kg[pc * 8 + 4], x[5] * rs * kg[pc * 8 + 5]); w.w = pk2(x[6] * rs * kg[pc * 8 + 6], x[7] * rs * kg[pc * 8 + 7]);
    *(u32x4*)(DKN + (size_t)tok * 64 + pc * 8) = w;
    *(u32x4*)(DVN + (size_t)tok * 64 + pc * 8) = vr;
    *(u32x4*)((bf16_t*)(p.ws + WS_IKC) + (size_t)(lb * SEQ + tok) * 64 + pc * 8) = ikr;
    vL[(pc * 8 + 0) * 72 + t] = (bf16_t)(vr.x & 0xffffu); vL[(pc * 8 + 1) * 72 + t] = (bf16_t)(vr.x >> 16);
    vL[(pc * 8 + 2) * 72 + t] = (bf16_t)(vr.y & 0xffffu); vL[(pc * 8 + 3) * 72 + t] = (bf16_t)(vr.y >> 16);
    vL[(pc * 8 + 4) * 72 + t] = (bf16_t)(vr.z & 0xffffu); vL[(pc * 8 + 5) * 72 + t] = (bf16_t)(vr.z >> 16);
    vL[(pc * 8 + 6) * 72 + t] = (bf16_t)(vr.w & 0xffffu); vL[(pc * 8 + 7) * 72 + t] = (bf16_t)(vr.w >> 16);
    __syncthreads();
    { const int d = tid >> 3; *(u32x4*)(DVT + (size_t)d * SEQ + tt * 64 + pc * 8) = *(const LAS u32x4*)(vL + d * 72 + pc * 8); }
}

__device__ __forceinline__ void dsa1_unit(const Ctx& c, int layer, int lb, int qt) {
    PHASE_TID();
    const Params& p = *c.p; const bf16_t* P = (const bf16_t*)(p.ws + WS_P);
    unsigned short* SEL = (unsigned short*)(p.ws + WS_MASK) + (size_t)lb * SEQ * 256;
    unsigned* MASK = (unsigned*)(p.ws + WS_MASK) + (size_t)lb * SEQ * 128;
    LAS unsigned* hist = (LAS unsigned*)c.lds;
    LAS unsigned short* mk16 = (LAS unsigned short*)(c.lds + 16512);
    LAS float* redL = (LAS float*)(c.lds + 24704);
    LAS int* selL = (LAS int*)(c.lds + 25728);
    const int q = lane >> 4, l15 = lane & 15, t0 = qt * 16, tq = t0 + l15, nb = qt + 1;
    __syncthreads();
    if (qt < 16) {
        const int qq = tid >> 5, wl = tid & 31, t = t0 + qq;
        if (wl <= (t >> 5)) MASK[(size_t)t * 128 + wl] = wl < (t >> 5) ? 0xFFFFFFFFu : (0xFFFFFFFFu >> (31 - (t & 31)));
        return;
    }
    const bf16_t* qrow = P + (size_t)(lb * SEQ + tq) * PW;
    LAS bf16_t* iqL = (LAS bf16_t*)(c.lds + 26624);
    LAS h2_t* wqL = (LAS h2_t*)(c.lds + 45568);
    const int qq_ = tid >> 5, pc2_ = tid & 31;
    const u32x4 iqa = *(const u32x4*)(P + (size_t)(lb * SEQ + t0 + qq_) * PW + C_CIQ + pc2_ * 16), iqb = *(const u32x4*)(P + (size_t)(lb * SEQ + t0 + qq_) * PW + C_CIQ + pc2_ * 16 + 8);
    const bf16_t* kbase = (const bf16_t*)(p.ws + WS_IKC) + (size_t)(lb * SEQ) * 64;
    const u32x4 wraw2 = *(const u32x4*)(P + (size_t)(lb * SEQ + t0 + qq_) * PW + C_CIW);
    const int ring = wave < 2 ? wave * 12288 : 46336 + (wave - 2) * 12288;
    const unsigned kvoff = (unsigned)((lane >> 3) * 128 + (((lane & 7) ^ ((lane >> 3) & 7)) * 16));
    const char* kgb = (const char*)kbase;
#define KDMA(pj) do { _Pragma("unroll") for (int hf = 0; hf < 2; ++hf) { int blk = 16 * (pj) + 8 * hf + wave; blk = blk > 255 ? 255 : blk; \
        const char* gb_ = kgb + (size_t)blk * 2048; asm volatile("" : "+s"(gb_)); \
        _Pragma("unroll") for (int jj = 0; jj < 2; ++jj) __builtin_amdgcn_global_load_lds((const unsigned*)(gb_ + jj * 1024 + kvoff), (LAS unsigned*)(c.lds + ring + ((pj) % 3) * 4096 + hf * 2048 + jj * 1024), 16, 0, 0); } } while (0)
    KDMA(0); KDMA(1);
    const int fa0 = (l15 * 8 + (q ^ (l15 & 7))) * 16, fa1 = (l15 * 8 + ((4 + q) ^ (l15 & 7))) * 16;
    *(LAS u32x4*)(iqL + qq_ * 592 + pc2_ * 16) = iqa; *(LAS u32x4*)(iqL + qq_ * 592 + pc2_ * 16 + 8) = iqb;
    __syncthreads();
    {
        const float w8[8] = {bflo(wraw2.x) * 0.022097086912079608f, bfhi(wraw2.x) * 0.022097086912079608f, bflo(wraw2.y) * 0.022097086912079608f, bfhi(wraw2.y) * 0.022097086912079608f,
                             bflo(wraw2.z) * 0.022097086912079608f, bfhi(wraw2.z) * 0.022097086912079608f, bflo(wraw2.w) * 0.022097086912079608f, bfhi(wraw2.w) * 0.022097086912079608f};
        float c0 = 0.f, c1 = 0.f;
#pragma unroll
        for (int h = 0; h < 8; ++h) { const unsigned v = *(const LAS unsigned*)(iqL + qq_ * 592 + h * 64 + pc2_ * 2); c0 += w8[h] * bflo(v); c1 += w8[h] * bfhi(v); }
        *(LAS unsigned*)(iqL + qq_ * 592 + 512 + pc2_ * 2) = pk2(c0, c1);
        if (pc2_ == 0) {
#pragma unroll
            for (int h = 0; h < 8; ++h) wqL[qq_ * 9 + h] = __builtin_amdgcn_cvt_pkrtz(w8[h], w8[h]); }
    }
    __syncthreads();
    const LAS bf16_t* iqrow = iqL + l15 * 592;
    const LAS h2_t* wqrow = wqL + l15 * 9;
    f32x4 sc[32];
    float mn = 3.0e38f, mx = -3.0e38f;
    float nanv = __int_as_float(0x7fc00000); asm volatile("" : "+v"(nanv));
#ifdef SPIN_SC
    const unsigned long long ts0_ = __builtin_amdgcn_s_memrealtime();
#endif
#pragma unroll
    for (int i = 0; i < 32; i += 2) { const int kb = 8 * i + wave;
        if (kb < nb) {
            KDMA(i / 2 + 2);
            asm volatile("s_waitcnt vmcnt(8)" ::: "memory");
            const LAS unsigned char* slot = c.lds + ring + ((i / 2) % 3) * 4096;
            const bf16x8 a00 = *(const LAS bf16x8*)(slot + fa0), a01 = *(const LAS bf16x8*)(slot + fa1), a10 = *(const LAS bf16x8*)(slot + 2048 + fa0), a11 = *(const LAS bf16x8*)(slot + 2048 + fa1);
            bf16x8 f0 = ld_frag_l(iqrow, 0, q), f1 = ld_frag_l(iqrow, 1, q);
            h2_t wn = wqrow[0]; h2_t t16[4] = {(h2_t){0, 0}, (h2_t){0, 0}, (h2_t){0, 0}, (h2_t){0, 0}};
            f32x4 e0 = mma16(a00, f0, (f32x4){0.f, 0.f, 0.f, 0.f}), e1 = mma16(a10, f0, (f32x4){0.f, 0.f, 0.f, 0.f}); e0 = mma16(a01, f1, e0); e1 = mma16(a11, f1, e1);
            f0 = ld_frag_l(iqrow + 64, 0, q); f1 = ld_frag_l(iqrow + 64, 1, q);
#pragma unroll
            for (int h = 0; h < 8; ++h) { const f32x4 d0 = e0, d1 = e1;
                const h2_t wh = wn;
                __builtin_amdgcn_sched_barrier(0);
                __builtin_amdgcn_s_setprio(1);
                e0 = mma16(a00, f0, (f32x4){0.f, 0.f, 0.f, 0.f}); e1 = mma16(a10, f0, (f32x4){0.f, 0.f, 0.f, 0.f}); e0 = mma16(a01, f1, e0); e1 = mma16(a11, f1, e1);
                __builtin_amdgcn_s_setprio(0);
                __builtin_amdgcn_sched_barrier(0);
                if (h < 7) { f0 = ld_frag_l(iqrow + (h + 2) * 64, 0, q); f1 = ld_frag_l(iqrow + (h + 2) * 64, 1, q); wn = wqrow[h + 1]; }
                t16[0] += wh * __builtin_amdgcn_cvt_pkrtz(__builtin_fabsf(d0[0]), __builtin_fabsf(d0[1])); t16[1] += wh * __builtin_amdgcn_cvt_pkrtz(__builtin_fabsf(d0[2]), __builtin_fabsf(d0[3]));
                t16[2] += wh * __builtin_amdgcn_cvt_pkrtz(__builtin_fabsf(d1[0]), __builtin_fabsf(d1[1])); t16[3] += wh * __builtin_amdgcn_cvt_pkrtz(__builtin_fabsf(d1[2]), __builtin_fabsf(d1[3]));
                }
            f32x4 tot0 = e0, tot1 = e1;
            tot0[0] += (float)t16[0][0]; tot0[1] += (float)t16[0][1]; tot0[2] += (float)t16[1][0]; tot0[3] += (float)t16[1][1];
            tot1[0] += (float)t16[2][0]; tot1[1] += (float)t16[2][1]; tot1[2] += (float)t16[3][0]; tot1[3] += (float)t16[3][1];
            const f32x4 nan4 = (f32x4){__int_as_float(0x7fc00000), __int_as_float(0x7fc00000), __int_as_float(0x7fc00000), __int_as_float(0x7fc00000)};
            sc[i] = tot0; sc[i + 1] = (kb + 8 < nb) ? tot1 : nan4;
            if (kb + 8 >= qt) {
#pragma unroll
                for (int e = 0; e < 4; ++e) { if (kb * 16 + 4 * q + e > tq) sc[i][e] = __int_as_float(0x7fc00000); if ((kb + 8) * 16 + 4 * q + e > tq) sc[i + 1][e] = __int_as_float(0x7fc00000); } }
#pragma unroll
            for (int e = 0; e < 4; ++e) { mn = fminf(mn, fminf(sc[i][e], sc[i + 1][e])); mx = fmaxf(mx, fmaxf(sc[i][e], sc[i + 1][e])); }
        } else {
#pragma unroll
            for (int e = 0; e < 4; ++e) { sc[i][e] = nanv; sc[i + 1][e] = nanv; }
        }
    }
    asm volatile("s_waitcnt vmcnt(0)" ::: "memory");
#undef KDMA
#ifdef SPIN_SC
    { const unsigned long long ts1_ = __builtin_amdgcn_s_memrealtime(), dt_ = ts1_ - ts0_; while (__builtin_amdgcn_s_memrealtime() - ts1_ < dt_) __builtin_amdgcn_s_sleep(1); }
#endif
    mn = fminf(mn, shx(mn, 16, lane)); mn = fminf(mn, shx(mn, 32, lane)); mx = fmaxf(mx, shx(mx, 16, lane)); mx = fmaxf(mx, shx(mx, 32, lane));
    if (q == 0) { redL[(wave * 16 + l15) * 2] = mn; redL[(wave * 16 + l15) * 2 + 1] = mx; }
    __syncthreads();
#pragma unroll
    for (int w = 0; w < 8; ++w) { mn = fminf(mn, redL[(w * 16 + l15) * 2]); mx = fmaxf(mx, redL[(w * 16 + l15) * 2 + 1]); }
    const float scale = mx > mn ? 16777215.0f / (mx - mn) : 0.f;
    const float nms = -mn * scale;
#pragma unroll
    for (int i = 0; i < 32; ++i) {
        if (8 * i + wave < nb) {
#pragma unroll
            for (int e = 0; e < 4; ++e)
                sc[i][e] = __int_as_float((int)__builtin_amdgcn_fmed3f(__builtin_fmaf(sc[i][e], scale, nms), -1.0f, 16777215.0f));
        } else sc[i] = (f32x4){__int_as_float(-1), __int_as_float(-1), __int_as_float(-1), __int_as_float(-1)}; }
    for (int i = tid; i < 2048; i += 512) ((LAS unsigned*)mk16)[i] = 0u;
    int pref = 0, krem = 256;
    LAS unsigned* hist1 = (LAS unsigned*)(c.lds + 120320);
    for (int i = tid; i < 16 * 257; i += 512) { hist[i] = 0u; hist1[i] = 0u; }
    __syncthreads();
#pragma unroll 1
    for (int pass = 0; pass < 3; ++pass) { const int shift = 16 - 8 * pass;
        LAS unsigned* hp = (pass & 1) ? hist1 : hist; LAS int* selp = selL + pass * 32;
        if (pass == 1) for (int i = tid; i < 16 * 257; i += 512) hist[i] = 0u;
#pragma unroll
        for (int i = 0; i < 32; ++i) if (8 * i + wave < nb) {
            bool hit[4]; bool anyhit = false;
#pragma unroll
            for (int e = 0; e < 4; ++e) { hit[e] = ((unsigned)__float_as_int(sc[i][e]) >> (shift + 8)) == (unsigned)pref; anyhit |= hit[e]; }
            if (__any(anyhit)) {
#pragma unroll
                for (int e = 0; e < 4; ++e) { const unsigned key = (unsigned)__float_as_int(sc[i][e]);
                    if (hit[e]) __hip_atomic_fetch_add(hp + l15 * 257 + ((key >> shift) & 255u), 1u, __ATOMIC_RELAXED, __HIP_MEMORY_SCOPE_WORKGROUP); } } }
        __syncthreads();
        {
            const int qq = 2 * wave + (lane >> 5), hl = lane & 31; int kr = krem;
            if (pass > 0) kr = selL[(pass - 1) * 32 + qq * 2 + 1];
            unsigned cnt[8]; unsigned s8 = 0;
#pragma unroll
            for (int b = 0; b < 8; ++b) { cnt[b] = hp[qq * 257 + hl * 8 + b]; s8 += cnt[b]; }
            unsigned suf = s8;
#pragma unroll
            for (int o = 1; o < 32; o <<= 1) { const unsigned t2 = (unsigned)__builtin_amdgcn_ds_bpermute((lane + o) << 2, (int)suf); if (hl + o < 32) suf += t2; }
            const unsigned after = suf - s8;
            if (after < (unsigned)kr && (unsigned)kr <= after + s8) { unsigned cum = after; int bsel = 0, knew = 1; bool done = false;
#pragma unroll
                for (int b = 7; b >= 0; --b) { if (!done && cum + cnt[b] >= (unsigned)kr) { bsel = hl * 8 + b; knew = kr - (int)cum; done = true; } cum += cnt[b]; }
                selp[qq * 2] = bsel; selp[qq * 2 + 1] = knew; }
        }
        __syncthreads();
        pref = (pref << 8) | selp[l15 * 2]; krem = selp[l15 * 2 + 1];
    }
#ifdef REP_DSA1_TAIL
#pragma unroll 1
    for (int rep_ = 0; rep_ < 2; ++rep_) { __syncthreads();
#endif
#pragma unroll
    for (int i = 0; i < 32; ++i) { const int kb = 8 * i + wave;
        if (kb < nb) { unsigned nib = 0;
#pragma unroll
            for (int e = 0; e < 4; ++e) { const int key = __float_as_int(sc[i][e]); nib |= (key >= pref ? 1u : 0u) << e; }
            unsigned v = nib << (4 * q); v |= shxu(v, 16, lane); v |= shxu(v, 32, lane);
            if (q == 0) mk16[l15 * 256 + kb] = (unsigned short)v; } }
    __syncthreads();
    if (t0 < QSPLIT) {
        const int qq = tid >> 5, wl = tid & 31, t = t0 + qq; const LAS unsigned* mrow = (const LAS unsigned*)(mk16 + qq * 256);
        for (int w4 = wl; w4 <= (t >> 5); w4 += 32) MASK[(size_t)t * 128 + w4] = mrow[w4];
    } else
    {
        const int qq = tid >> 5, wl = tid & 31, t = t0 + qq; const LAS unsigned* mrow = (const LAS unsigned*)(mk16 + qq * 256);
        unsigned w[4]; int cnt = 0;
#pragma unroll
        for (int j = 0; j < 4; ++j) { w[j] = mrow[wl * 4 + j]; cnt += __builtin_popcount(w[j]); }
        int incl = cnt;
#pragma unroll
        for (int o = 1; o < 32; o <<= 1) { const int v = __builtin_amdgcn_ds_bpermute((lane - o) << 2, incl); if (wl >= o) incl += v; }
        int pos = incl - cnt;
        unsigned short* dst = SEL + (size_t)t * 256;
#pragma unroll
        for (int j = 0; j < 4; ++j) { unsigned ww = w[j];
            while (ww) { const int b = __builtin_ctz(ww); ww &= ww - 1u; if (pos < 256) dst[pos] = (unsigned short)((wl * 4 + j) * 32 + b); ++pos; } }
    }
#ifdef REP_DSA1_TAIL
    }
#endif
}

__device__ __forceinline__ void dsa2_tile(const Ctx& c, int layer, int lb, int jt) {
    PHASE_TID();
    const Params& p = *c.p; const bf16_t* P = (const bf16_t*)(p.ws + WS_P); bf16_t* YS = (bf16_t*)(p.ws + WS_YS);
    const bf16_t* DKN = (const bf16_t*)(p.ws + WS_DKN) + (size_t)lb * SEQ * 64; const bf16_t* DVT = (const bf16_t*)(p.ws + WS_DVT) + (size_t)lb * 64 * SEQ;
    const unsigned* MASK = (const unsigned*)(p.ws + WS_MASK) + (size_t)lb * SEQ * 128;
    const float* qg = p.in[12] + layer * 64;
    constexpr int KVB = 35840;
    const int q = lane >> 4, l15 = lane & 15, qs = wave & 1, hp = wave >> 1, tq = jt * 32 + qs * 16 + l15, tmaxw = jt * 32 + qs * 16 + 15;
    const size_t row = (size_t)(lb * SEQ + tq);
    const int nck = (jt * 32 + 32 + 127) >> 7;
    u32x2 grd[2][4];
#pragma unroll
    for (int hh = 0; hh < 2; ++hh)
#pragma unroll
        for (int d = 0; d < 4; ++d) grd[hh][d] = *(const u32x2*)(P + row * PW + C_CG + (hp * 2 + hh) * 64 + d * 16 + 4 * q);
    u32x4 kreg[2], vreg[2];
#define DSA_LOAD(ck) do { _Pragma("unroll") for (int j = 0; j < 2; ++j) { const int idx = tid + 512 * j; \
        kreg[j] = *(const u32x4*)(DKN + (size_t)((ck) * 128 + (idx >> 3)) * 64 + (idx & 7) * 8); \
        vreg[j] = *(const u32x4*)(DVT + (size_t)(idx >> 4) * SEQ + (ck) * 128 + (idx & 15) * 8); } } while (0)
#define DSA_STORE(buf) do { ldsp_t b_ = c.lds + (buf) * KVB; _Pragma("unroll") for (int j = 0; j < 2; ++j) { const int idx = tid + 512 * j; \
        *(LAS u32x4*)(b_ + (idx >> 3) * 144 + (idx & 7) * 16) = kreg[j]; *(LAS u32x4*)(b_ + 18432 + (idx >> 4) * 272 + (idx & 15) * 16) = vreg[j]; } } while (0)
    DSA_LOAD(0);
    bf16x8 qf[2][2];
#pragma unroll
    for (int hh = 0; hh < 2; ++hh) { const int h = hp * 2 + hh; float x[2][8]; float ss = 0.f;
#pragma unroll
        for (int ks = 0; ks < 2; ++ks) { const u32x4 r = *(const u32x4*)(P + row * PW + C_CQ + h * 64 + 32 * ks + 8 * q);
            x[ks][0] = bflo(r.x); x[ks][1] = bfhi(r.x); x[ks][2] = bflo(r.y); x[ks][3] = bfhi(r.y); x[ks][4] = bflo(r.z); x[ks][5] = bfhi(r.z); x[ks][6] = bflo(r.w); x[ks][7] = bfhi(r.w);
#pragma unroll
            for (int k = 0; k < 8; ++k) ss += x[ks][k] * x[ks][k]; }
        ss += shx(ss, 16, lane); ss += shx(ss, 32, lane);
        const float rs = rsqrtf(ss * (1.f / 64.f) + 1e-6f) * (0.125f * 1.4426950408889634f);
#pragma unroll
        for (int ks = 0; ks < 2; ++ks) { const float* gp = qg + 32 * ks + 8 * q; u32x4 w;
            w.x = pk2m(x[ks][0] * rs * gp[0], x[ks][1] * rs * gp[1]); w.y = pk2m(x[ks][2] * rs * gp[2], x[ks][3] * rs * gp[3]);
            w.z = pk2m(x[ks][4] * rs * gp[4], x[ks][5] * rs * gp[5]); w.w = pk2m(x[ks][6] * rs * gp[6], x[ks][7] * rs * gp[7]);
            qf[hh][ks] = __builtin_bit_cast(bf16x8, w); } }
    const float sl2[2] = {exp2f(-(float)(hp * 2 + 1)) * 1.4426950408889634f, exp2f(-(float)(hp * 2 + 2)) * 1.4426950408889634f};
    f32x4 oacc[2][4]; float mrun[2] = {-3.0e38f, -3.0e38f}, lrun[2] = {0.f, 0.f};
#pragma unroll
    for (int hh = 0; hh < 2; ++hh)
#pragma unroll
        for (int d = 0; d < 4; ++d) oacc[hh][d] = (f32x4){0.f, 0.f, 0.f, 0.f};
    __syncthreads();
    DSA_STORE(0);
    __syncthreads();
    u32x4 mwn = *(const u32x4*)(MASK + (size_t)tq * 128);
#pragma unroll 1
    for (int ck = 0; ck < nck; ++ck) {
        const u32x4 mwc = mwn;
        if (ck + 1 < nck) { DSA_LOAD(ck + 1); mwn = *(const u32x4*)(MASK + (size_t)tq * 128 + (ck + 1) * 4); }
        ldsp_t b = c.lds + (ck & 1) * KVB; const LAS bf16_t* knL = (const LAS bf16_t*)b; const LAS bf16_t* vtL = (const LAS bf16_t*)(b + 18432);
#pragma unroll
        for (int s2 = 0; s2 < 2; ++s2) { const int key0 = ck * 128 + s2 * 64;
            if (key0 <= tmaxw) {
                unsigned w0 = s2 ? mwc.z : mwc.x, w1 = s2 ? mwc.w : mwc.y;
                w0 = key0 <= tq ? w0 : 0u; w1 = key0 + 32 <= tq ? w1 : 0u;
                bf16x8 ka[4][2];
#pragma unroll
                for (int kt = 0; kt < 4; ++kt)
#pragma unroll
                    for (int ks = 0; ks < 2; ++ks) ka[kt][ks] = ld_frag_l(knL + (s2 * 64 + kt * 16 + l15) * 72, ks, q);
                const float dbase = (float)(key0 + 4 * q - tq);
#pragma unroll
                for (int hh = 0; hh < 2; ++hh) {
                    f32x4 sv[4];
#pragma unroll
                    for (int kt = 0; kt < 4; ++kt) { sv[kt] = mma16(ka[kt][0], qf[hh][0], (f32x4){0.f, 0.f, 0.f, 0.f}); sv[kt] = mma16(ka[kt][1], qf[hh][1], sv[kt]); }
                    float tmax = -3.0e38f;
#pragma unroll
                    for (int kt = 0; kt < 4; ++kt)
#pragma unroll
                        for (int e = 0; e < 4; ++e) { const unsigned wsel = kt < 2 ? w0 : w1; const bool on = (wsel >> ((kt & 1) * 16 + 4 * q + e)) & 1u;
                            const float xv = on ? sv[kt][e] + sl2[hh] * (dbase + (float)(kt * 16 + e)) : -3.0e38f; sv[kt][e] = xv; tmax = fmaxf(tmax, xv); }
                    tmax = fmaxf(tmax, shx(tmax, 16, lane)); tmax = fmaxf(tmax, shx(tmax, 32, lane));
                    const float mnew = fmaxf(mrun[hh], tmax), corr = __builtin_amdgcn_exp2f(mrun[hh] - mnew), muse = fmaxf(mnew, -1.0e30f); mrun[hh] = mnew;
                    float ps = 0.f;
#pragma unroll
                    for (int kt = 0; kt < 4; ++kt)
#pragma unroll
                        for (int e = 0; e < 4; ++e) { const float pe = __builtin_amdgcn_exp2f(sv[kt][e] - muse); sv[kt][e] = pe; ps += pe; }
                    lrun[hh] = lrun[hh] * corr + ps;
                    const bf16x8 pf0 = pack_frag(sv[0], sv[1]), pf1 = pack_frag(sv[2], sv[3]);
                    if (!__all(corr == 1.0f)) {
#pragma unroll
                        for (int d = 0; d < 4; ++d) oacc[hh][d] = oacc[hh][d] * corr; }
#pragma unroll
                    for (int d = 0; d < 4; ++d) { oacc[hh][d] = mma16(ld_frag_perm_l(vtL + (d * 16 + l15) * 136, s2 * 2, q), pf0, oacc[hh][d]);
                        oacc[hh][d] = mma16(ld_frag_perm_l(vtL + (d * 16 + l15) * 136, s2 * 2 + 1, q), pf1, oacc[hh][d]); }
                }
            }
        }
        if (ck + 1 < nck) DSA_STORE((ck + 1) & 1);
        __syncthreads();
    }
#undef DSA_LOAD
#undef DSA_STORE
#pragma unroll
    for (int hh = 0; hh < 2; ++hh) { const int h = hp * 2 + hh; float l = lrun[hh]; l += shx(l, 16, lane); l += shx(l, 32, lane); const float inv = frcp(l);
#pragma unroll
        for (int d = 0; d < 4; ++d) { const int ch = h * 64 + d * 16 + 4 * q; const u32x2 gr = grd[hh][d];
            u32x2 w; w.x = pk2(oacc[hh][d][0] * inv * fsilu(bflo(gr.x)), oacc[hh][d][1] * inv * fsilu(bfhi(gr.x))); w.y = pk2(oacc[hh][d][2] * inv * fsilu(bflo(gr.y)), oacc[hh][d][3] * inv * fsilu(bfhi(gr.y)));
            *(u32x2*)(YS + row * YW + 2 * BW + ch) = w; } }
}

__device__ __forceinline__ void dsa2g_unit(const Ctx& c, int layer, int lb, int qb) {
    PHASE_TID();
    const Params& p = *c.p; const bf16_t* P = (const bf16_t*)(p.ws + WS_P); bf16_t* YS = (bf16_t*)(p.ws + WS_YS);
    const bf16_t* DKN = (const bf16_t*)(p.ws + WS_DKN) + (size_t)lb * SEQ * 64; const bf16_t* DVN = (const bf16_t*)(p.ws + WS_VN) + (size_t)lb * SEQ * 64;
    const unsigned short* SEL = (const unsigned short*)(p.ws + WS_MASK) + (size_t)lb * SEQ * 256;
    const float* qg = p.in[12] + layer * 64;
    LAS unsigned short* selW = (LAS unsigned short*)(c.lds + wave * 9216);
    LAS float* PL = (LAS float*)(c.lds + wave * 9216 + 512);
    LAS float* lL = (LAS float*)(c.lds + wave * 9216 + 512 + 8192);
    const int q = lane >> 4, l15 = lane & 15; const bool hv = l15 < 8;
    const float sl2 = hv ? exp2f(-(float)(l15 + 1)) * 1.4426950408889634f : 0.f;
    __syncthreads();
    u32x2 selnext = *(const u32x2*)(SEL + (size_t)(QSPLIT + qb * 64 + wave * 8) * 256 + lane * 4);
    u32x4 qnext[2];
#pragma unroll
    for (int ks = 0; ks < 2; ++ks) qnext[ks] = hv ? *(const u32x4*)(P + (size_t)(lb * SEQ + QSPLIT + qb * 64 + wave * 8) * PW + C_CQ + l15 * 64 + 32 * ks + 8 * q) : (u32x4){0u, 0u, 0u, 0u};
#pragma unroll 1
    for (int k = 0; k < 8; ++k) {
        const int t = QSPLIT + qb * 64 + wave * 8 + k; const size_t row = (size_t)(lb * SEQ + t);
        *(LAS u32x2*)(selW + lane * 4) = selnext;
        const u32x4 qc0 = qnext[0], qc1 = qnext[1];
        if (k < 7) { selnext = *(const u32x2*)(SEL + (size_t)(t + 1) * 256 + lane * 4);
#pragma unroll
            for (int ks = 0; ks < 2; ++ks) qnext[ks] = hv ? *(const u32x4*)(P + (row + 1) * PW + C_CQ + l15 * 64 + 32 * ks + 8 * q) : (u32x4){0u, 0u, 0u, 0u}; }
        u32x4 gr4[2];
#pragma unroll
        for (int tp = 0; tp < 2; ++tp) gr4[tp] = hv ? *(const u32x4*)(P + row * PW + C_CG + l15 * 64 + tp * 32 + 8 * q) : (u32x4){0u, 0u, 0u, 0u};
        bf16x8 qf[2];
        { float x[2][8]; float ss = 0.f;
#pragma unroll
          for (int ks = 0; ks < 2; ++ks) { const u32x4 r = ks ? qc1 : qc0;
              x[ks][0] = bflo(r.x); x[ks][1] = bfhi(r.x); x[ks][2] = bflo(r.y); x[ks][3] = bfhi(r.y); x[ks][4] = bflo(r.z); x[ks][5] = bfhi(r.z); x[ks][6] = bflo(r.w); x[ks][7] = bfhi(r.w);
#pragma unroll
              for (int j = 0; j < 8; ++j) ss += x[ks][j] * x[ks][j]; }
          ss += shx(ss, 16, lane); ss += shx(ss, 32, lane);
          const float rs = rsqrtf(ss * (1.f / 64.f) + 1e-6f) * (0.125f * 1.4426950408889634f);
#pragma unroll
          for (int ks = 0; ks < 2; ++ks) { const float* gp = qg + 32 * ks + 8 * q; u32x4 w;
              w.x = pk2m(x[ks][0] * rs * gp[0], x[ks][1] * rs * gp[1]); w.y = pk2m(x[ks][2] * rs * gp[2], x[ks][3] * rs * gp[3]);
              w.z = pk2m(x[ks][4] * rs * gp[4], x[ks][5] * rs * gp[5]); w.w = pk2m(x[ks][6] * rs * gp[6], x[ks][7] * rs * gp[7]);
              qf[ks] = __builtin_bit_cast(bf16x8, w); } }
        f32x4 s[16];
#pragma unroll
        for (int kg = 0; kg < 16; kg += 8) {
            bf16x8 ka[8][2];
#pragma unroll
            for (int j = 0; j < 8; ++j) { const int idx = selW[(kg + j) * 16 + l15]; const bf16_t* krow = DKN + (size_t)idx * 64; ka[j][0] = ld_frag_g(krow, 0, q); ka[j][1] = ld_frag_g(krow, 1, q); }
            asm volatile("" ::: "memory");
#pragma unroll
            for (int j = 0; j < 8; ++j) { s[kg + j] = mma16(ka[j][0], qf[0], (f32x4){0.f, 0.f, 0.f, 0.f}); s[kg + j] = mma16(ka[j][1], qf[1], s[kg + j]); } }
        const bf16_t* vcol = DVN + 2 * l15;
        unsigned vr[4][2][8];
#define DSG_VGATHER(kh_) do { _Pragma("unroll") for (int k4 = 0; k4 < 4; ++k4) { const int ks = (kh_) + k4; \
                const u32x2 ia = *(const LAS u32x2*)(selW + 32 * ks + 4 * q), ib = *(const LAS u32x2*)(selW + 32 * ks + 16 + 4 * q); \
                const int id[8] = {(int)(ia.x & 0xffffu), (int)(ia.x >> 16), (int)(ia.y & 0xffffu), (int)(ia.y >> 16), (int)(ib.x & 0xffffu), (int)(ib.x >> 16), (int)(ib.y & 0xffffu), (int)(ib.y >> 16)}; \
                _Pragma("unroll") for (int j = 0; j < 8; ++j) _Pragma("unroll") for (int tp = 0; tp < 2; ++tp) vr[k4][tp][j] = *(const unsigned*)(vcol + (size_t)id[j] * 64 + tp * 32); } } while (0)
        DSG_VGATHER(0);
        float mx = -3.0e38f;
#pragma unroll
        for (int kt = 0; kt < 16; ++kt) { const u32x2 iv = *(const LAS u32x2*)(selW + kt * 16 + 4 * q);
            const int i0 = (int)(iv.x & 0xffffu), i1 = (int)(iv.x >> 16), i2 = (int)(iv.y & 0xffffu), i3 = (int)(iv.y >> 16);
            s[kt][0] += sl2 * (float)(i0 - t); s[kt][1] += sl2 * (float)(i1 - t); s[kt][2] += sl2 * (float)(i2 - t); s[kt][3] += sl2 * (float)(i3 - t);
            mx = fmaxf(fmaxf(fmaxf(s[kt][0], s[kt][1]), fmaxf(s[kt][2], s[kt][3])), mx); }
        mx = fmaxf(mx, shx(mx, 16, lane)); mx = fmaxf(mx, shx(mx, 32, lane));
        float sum = 0.f;
#pragma unroll
        for (int kt = 0; kt < 16; ++kt)
#pragma unroll
            for (int i = 0; i < 4; ++i) { const float e = __builtin_amdgcn_exp2f(s[kt][i] - mx); s[kt][i] = e; sum += e; }
        sum += shx(sum, 16, lane); sum += shx(sum, 32, lane);
        f32x4 oA[2], oB[2];
#pragma unroll
        for (int tp = 0; tp < 2; ++tp) { oA[tp] = (f32x4){0.f, 0.f, 0.f, 0.f}; oB[tp] = (f32x4){0.f, 0.f, 0.f, 0.f}; }
#pragma unroll 1
        for (int kh = 0; kh < 8; kh += 4) {
            if (kh) DSG_VGATHER(4);
            asm volatile("" ::: "memory");
#pragma unroll
            for (int k4 = 0; k4 < 4; ++k4) { const int ks = kh + k4;
                f32x4 p0, p1;
                switch (ks) { case 0: p0 = s[0]; p1 = s[1]; break; case 1: p0 = s[2]; p1 = s[3]; break; case 2: p0 = s[4]; p1 = s[5]; break; case 3: p0 = s[6]; p1 = s[7]; break;
                              case 4: p0 = s[8]; p1 = s[9]; break; case 5: p0 = s[10]; p1 = s[11]; break; case 6: p0 = s[12]; p1 = s[13]; break; default: p0 = s[14]; p1 = s[15]; break; }
                const bf16x8 pf = pack_frag(p0, p1);
#pragma unroll
                for (int tp = 0; tp < 2; ++tp) { u32x4 wa, wb;
                    wa.x = (vr[k4][tp][0] & 0xffffu) | (vr[k4][tp][1] << 16); wa.y = (vr[k4][tp][2] & 0xffffu) | (vr[k4][tp][3] << 16);
                    wa.z = (vr[k4][tp][4] & 0xffffu) | (vr[k4][tp][5] << 16); wa.w = (vr[k4][tp][6] & 0xffffu) | (vr[k4][tp][7] << 16);
                    wb.x = (vr[k4][tp][0] >> 16) | (vr[k4][tp][1] & 0xffff0000u); wb.y = (vr[k4][tp][2] >> 16) | (vr[k4][tp][3] & 0xffff0000u);
                    wb.z = (vr[k4][tp][4] >> 16) | (vr[k4][tp][5] & 0xffff0000u); wb.w = (vr[k4][tp][6] >> 16) | (vr[k4][tp][7] & 0xffff0000u);
                    oA[tp] = mma16(__builtin_bit_cast(bf16x8, wa), pf, oA[tp]); oB[tp] = mma16(__builtin_bit_cast(bf16x8, wb), pf, oB[tp]); } }
        }
#undef DSG_VGATHER
        if (hv) { const float inv = frcp(sum);
#pragma unroll
            for (int tp = 0; tp < 2; ++tp) { const int ch = l15 * 64 + tp * 32 + 8 * q; const u32x4 gr = gr4[tp];
                u32x4 w;
                w.x = pk2(oA[tp][0] * inv * fsilu(bflo(gr.x)), oB[tp][0] * inv * fsilu(bfhi(gr.x))); w.y = pk2(oA[tp][1] * inv * fsilu(bflo(gr.y)), oB[tp][1] * inv * fsilu(bfhi(gr.y)));
                w.z = pk2(oA[tp][2] * inv * fsilu(bflo(gr.z)), oB[tp][2] * inv * fsilu(bfhi(gr.z))); w.w = pk2(oA[tp][3] * inv * fsilu(bflo(gr.w)), oB[tp][3] * inv * fsilu(bfhi(gr.w)));
                *(u32x4*)(YS + row * YW + 2 * BW + ch) = w; } }
    }
}

constexpr size_t CTL_QUEUE = 32768;
__device__ __forceinline__ int next_unit(const Ctx& c, int layer, int grp, int stage, int tid) {
    LAS int* slot = (LAS int*)(c.lds + LDS_MISC + 64);
    __syncthreads();
    if (tid == 0) { unsigned* ctr = (unsigned*)(c.p->ws + WS_CTL + CTL_QUEUE) + (size_t)(((layer * NGRP + grp) * 8 + stage) * 64);
        *slot = (int)__hip_atomic_fetch_add(ctr, 1u, __ATOMIC_RELAXED, __HIP_MEMORY_SCOPE_AGENT); }
    __syncthreads();
    return *slot;
}
#define QUEUE_LOOP(stage_, total_) for (int u = next_unit(c, layer, grp, stage_, tid); u < (total_); u = next_unit(c, layer, grp, stage_, tid))
__device__ __forceinline__ void phase_s1(const Ctx& c, int layer, int grp, int rep = 0) {
    PHASE_TID();
    QUEUE_LOOP(0 + 4 * rep, 1536) {
        if (u < 1024) { gdn_pre_unit(c, layer, u >> 8, (u >> 2) & 63, u & 3);
#ifdef REP_U_GDNPRE
            gdn_pre_unit(c, layer, u >> 8, (u >> 2) & 63, u & 3);
#endif
            }
        else if (u < 1280) { const int v = u - 1024; { ssd1_unit(c, layer, v >> 6, (v >> 1) & 31, v & 1);
#ifdef REP_U_SSD1
            ssd1_unit(c, layer, v >> 6, (v >> 1) & 31, v & 1);
#endif
            } }
        else { const int v = u - 1280; { dsa_prep_unit(c, layer, v >> 6, v & 63);
#ifdef REP_U_PREP
            dsa_prep_unit(c, layer, v >> 6, v & 63);
#endif
            } }
    }
}
__device__ __forceinline__ void phase_s2(const Ctx& c, int layer, int grp, int rep = 0) {
    PHASE_TID();
    QUEUE_LOOP(1 + 4 * rep, 32 + 1280) {
        if (u < 32) { gdn_chain(c, layer, u >> 3, (u >> 1) & 3, u & 1);
#ifdef REP_U_CHAIN
            gdn_chain(c, layer, u >> 3, (u >> 1) & 3, u & 1);
#endif
            }
        else { const int v = u - 32;
            if (v < 128) sg_unit(c, layer, v >> 5, v & 31);
            else if (v < 256) { const int w = v - 128; mem_unit(c, layer, grp, w >> 5, (w >> 3) & 3, w & 7);
#ifdef REP_U_MEM
                mem_unit(c, layer, grp, w >> 5, (w >> 3) & 3, w & 7);
#endif
            }
            else { const int w = v - 256; dsa1_unit(c, layer, w & 3, 255 - (w >> 2));
#ifdef REP_U_DSA1
                dsa1_unit(c, layer, w & 3, 255 - (w >> 2));
#endif
            } }
    }
    ssd_scan(c);
}
__device__ __forceinline__ void phase_s3a(const Ctx& c, int layer, int grp, int rep = 0) {
    PHASE_TID();
    constexpr int NGU = (SEQ - QSPLIT) / 64 * GB, NDT = QSPLIT / 32 * GB;
    QUEUE_LOOP(2 + 4 * rep, 128 + NGU + NDT) {
        if (u < 128) ssd3_unit(c, layer, u >> 5, u & 31);
        else if (u < 128 + NGU) { const int v = u - 128; dsa2g_unit(c, layer, v & 3, v >> 2); }
        else { const int v = u - 128 - NGU; dsa2_tile(c, layer, v & 3, QSPLIT / 32 - 1 - (v >> 2)); }
    }
}
__device__ __forceinline__ void phase_s3(const Ctx& c, int layer, int grp) { phase_s3a(c, layer, grp); gdn_post(c, layer);
#ifndef NO_H8
    h8_rows(c);
#endif
}

__global__ void __launch_bounds__(512, 2) hybrid_fwd(Params prm) {
    extern __shared__ __attribute__((aligned(16))) unsigned char lds_raw[];
    Ctx c;
    c.lds = (ldsp_t)lds_raw; c.bid = blockIdx.x; c.wv = __builtin_amdgcn_readfirstlane((int)threadIdx.x >> 6); c.p = &prm;
    for (int u = threadIdx.x; u < (LDS_BYTES - LDS_MISC) / 4; u += 512) ((LAS unsigned*)(c.lds + LDS_MISC))[u] = 0u;
    __syncthreads();
    XcdBarrier bar = xcd_barrier_post((unsigned*)(prm.ws + WS_CTL), (volatile LAS unsigned*)(c.lds + LDS_MISC));
    unsigned char* ws = prm.ws;
    bf16_t* H = (bf16_t*)(ws + WS_H); bf16_t* P = (bf16_t*)(ws + WS_P); bf16_t* YS = (bf16_t*)(ws + WS_YS);
    bf16_t* GS = (bf16_t*)(ws + WS_P);
    bf16_t* MG = (bf16_t*)(ws + WS_GDN);

    for (int layer = 0; layer < DEPTH; ++layer) {
        phase_convert(c, layer);
#ifdef REP_CONV
        xcd_barrier(bar);
        phase_convert(c, layer);
#endif
        if (layer == 0) phase_norm(c, prm.in[0]);
        xcd_barrier(bar);
        for (int grp = 0; grp < NGRP; ++grp) {
            const float* xin = (layer == 0 ? prm.in[0] : (const float*)prm.out) + (size_t)grp * TG * DM;
            float* xout = prm.out + (size_t)grp * TG * DM;
#ifdef REP_NORM
            phase_norm(c, xin);
            xcd_barrier(bar);
#endif
#ifdef REP_BAR
            xcd_barrier(bar); xcd_barrier(bar); xcd_barrier(bar); xcd_barrier(bar);
#endif
#ifdef REP_TEST
            {
                pg8::Gemm g{H, (const bf16_t*)(ws + WS_WIN), TG, 3072, DM, DM, DM, 0, 0}; pg8::StaticOrder S; S.init(TG, 3072, c.G, c.bid);
                EpiStoreBf16<0> E{P, PW, prm.one};
                pg8::gemm_phase<EpiStoreBf16<0>, pg8::StaticOrder>(c.lds, g, S, E, nullptr, c.wv);
            }
            xcd_barrier(bar);
#endif
#if !defined(NO_P1)
#ifdef REP_G1
            for (int rep_ = 0; rep_ < 2; ++rep_)
#endif
            {
                pg8::Gemm g{H, (const bf16_t*)(ws + WS_WIN), TG, PW, DM, DM, DM, 0, 0}; pg8::StaticOrder S; S.init(TG, PW, c.G, c.bid);
                EpiStoreBf16<0, 1> E{P, PW, prm.one};
                pg8::gemm_phase<EpiStoreBf16<0, 1>, pg8::StaticOrder>(c.lds, g, S, E, nullptr, c.wv);
                if (grp == 0) {
                    __syncthreads();
                    pg8::Gemm g2{(const bf16_t*)(ws + WS_MEMN), (const bf16_t*)(ws + WS_WKV), BATCH * MEMLEN, DM, DM, DM, DM, 0, 0}; pg8::StaticOrder S2; S2.init(BATCH * MEMLEN, DM, c.G, (c.bid + 64) & 255);
                    EpiStoreBf16<0> E2{(bf16_t*)(ws + WS_KV), DM, prm.one};
                    pg8::gemm_phase<EpiStoreBf16<0>, pg8::StaticOrder>(c.lds, g2, S2, E2, nullptr, c.wv);
                }
            }
#endif
            xcd_barrier(bar);
            phase_s1(c, layer, grp);
            xcd_barrier(bar);
#ifdef REP_S1
            phase_s1(c, layer, grp, 1);
            xcd_barrier(bar);
#endif
            phase_s2(c, layer, grp);
            xcd_barrier(bar);
#ifdef REP_S2
            phase_s2(c, layer, grp, 1);
            xcd_barrier(bar);
#endif
#ifdef REP_S3
            phase_s3a(c, layer, grp, 1);
            xcd_barrier(bar);
#endif
            phase_s3(c, layer, grp);
            xcd_barrier(bar);
            {
                const int tile = (c.bid & 7) * (c.G / 8) + (c.bid >> 3), pm = tile >> 2, pn = tile & 3;
                EpiGateTile EG{}; EpiMergeTile EY{MG, (const float*)(ws + WS_SMALL) + SM_SSD_RS};
                pg8::gemm_gate_merge<EpiGateTile, EpiMergeTile>(c.lds, (const bf16_t*)(ws + WS_P)  , (const bf16_t*)(ws + WS_WG)  , YS, (const bf16_t*)(ws + WS_WB), pm, pn, EG, EY, c.wv);
#ifdef REP_GY
                __syncthreads();
                pg8::gemm_gate_merge<EpiGateTile, EpiMergeTile>(c.lds, (const bf16_t*)(ws + WS_P)  , (const bf16_t*)(ws + WS_WG)  , YS, (const bf16_t*)(ws + WS_WB), pm, pn, EG, EY, c.wv);
#endif
            }
            xcd_barrier(bar);
#if !defined(NO_P4)
            {
                pg8::Gemm g{MG, (const bf16_t*)(ws + WS_WO), TG, DM, DM, DM, DM, 0, 0}; pg8::StaticOrder S; S.init(TG, DM, c.G, c.bid);
                EpiResid E{xin, xout};
                pg8::gemm_phase<EpiResid, pg8::StaticOrder>(c.lds, g, S, E, nullptr, c.wv);
            }
#endif
            {
                const int nl = grp + 1 < NGRP ? layer : layer + 1, ng = grp + 1 < NGRP ? grp + 1 : 0;
                if (nl < DEPTH) phase_norm(c, (nl == 0 ? prm.in[0] : (const float*)prm.out) + (size_t)ng * TG * DM);
            }
            xcd_barrier(bar);
        }
    }
}
}

extern "C" void kernel_launch(void* const* d_in, const int* in_sizes, int n_in, void* d_out, int out_size, void* d_ws, size_t ws_size, hipStream_t stream) {
    static int grid = 0;
    if (grid == 0) {
        if (n_in != 27 || ws_size < hk::WS_END) { fprintf(stderr, "kernel_launch: expected 27 inputs and >= %zu bytes of workspace, got %d / %zu\n", (size_t)hk::WS_END, n_in, ws_size); grid = -1; return; }
        int dev = 0, cus = 0, per_cu = 0;
        if (hipGetDevice(&dev) != hipSuccess || hipDeviceGetAttribute(&cus, hipDeviceAttributeMultiprocessorCount, dev) != hipSuccess) { grid = -1; return; }
        if (hipFuncSetAttribute((const void*)hk::hybrid_fwd, hipFuncAttributeMaxDynamicSharedMemorySize, hk::LDS_BYTES) != hipSuccess) { fprintf(stderr, "kernel_launch: hipFuncSetAttribute failed\n"); grid = -1; return; }
        if (hipOccupancyMaxActiveBlocksPerMultiprocessor(&per_cu, (const void*)hk::hybrid_fwd, 512, hk::LDS_BYTES) != hipSuccess || per_cu < 1)
            fprintf(stderr, "kernel_launch: occupancy query reports %d workgroups per CU\n", per_cu);
        (void)hipGetLastError();
        if (cus < hk::Ctx::G) { fprintf(stderr, "kernel_launch: built for >= %d CUs, device has %d\n", hk::Ctx::G, cus); grid = -1; return; }
        grid = hk::Ctx::G;
    }
    if (grid < 0) return;
    (void)hipMemsetAsync((char*)d_ws + hk::WS_CTL, 0, hk::CTL_BYTES, stream);
    hk::Params p{};
    for (int i = 0; i < 27; ++i) p.in[i] = (const float*)d_in[i];
    p.out = (float*)d_out; p.ws = (unsigned char*)d_ws; p.one = 1.0f; p.pad = 0;
    hipLaunchKernelGGL(hk::hybrid_fwd, dim3(grid), dim3(512), hk::LDS_BYTES, stream, p);
}
```
